# Optimizing an MI355X kernel written in HIP

```python
import math
import jax, jax.numpy as jnp
from jax import lax
import numpy as np

D_MODEL = 2048
BATCH = 1
SEQ = 8192
DEPTH = 1
DEC_BATCH = 16
DEC_SEQ = 16
PAST_LEN = 1024

CHUNK = 64
N_META = 16
HEAD_DIM = 64
N_Q_HEADS = 32
N_KV_HEADS = 4
GQA_GROUP = N_Q_HEADS // N_KV_HEADS
WINDOW = 128
WIN_CHUNKS = WINDOW // CHUNK
CACHE_ROWS = min(WINDOW, PAST_LEN)
ATTN_WIDTH = N_Q_HEADS * HEAD_DIM
KV_WIDTH = N_KV_HEADS * HEAD_DIM
M_HEADS = 8
M_QK_DIM = 128
M_V_DIM = 256
M_QK_WIDTH = M_HEADS * M_QK_DIM
M_V_WIDTH = M_HEADS * M_V_DIM
EPS = 1e-6
NEG_INF = -1e30
COL_SIZES = (ATTN_WIDTH, KV_WIDTH, KV_WIDTH, ATTN_WIDTH, M_QK_WIDTH, M_QK_WIDTH, M_V_WIDTH, M_V_WIDTH,
             M_HEADS, M_HEADS, M_V_WIDTH, D_MODEL, D_MODEL)
IN_COLS = sum(COL_SIZES)

kernel_name = "swa_sink_mlstm_parallel_gated_stream"


def _rmsnorm(x, g):
    x32 = x.astype(jnp.float32)
    y = x32 * lax.rsqrt(jnp.mean(x32 * x32, axis=-1, keepdims=True) + EPS)
    return (y * g.astype(jnp.float32)).astype(x.dtype)


def _project(xn, w_in, b_i, b_f):
    B, T, _ = xn.shape
    u = xn @ w_in
    split_points = [int(s) for s in np.cumsum(COL_SIZES)[:-1]]
    qa, ka, va, za, qm, km, vm, om, ig, fg, zm, ga, gm = jnp.split(u, split_points, axis=-1)
    q_att = qa.reshape(B, T, N_KV_HEADS, GQA_GROUP, HEAD_DIM)
    k_att = ka.reshape(B, T, N_KV_HEADS, HEAD_DIM)
    v_att = va.reshape(B, T, N_KV_HEADS, HEAD_DIM)
    heads = lambda a, d: a.reshape(B, T, M_HEADS, d).transpose(0, 2, 1, 3).astype(jnp.float32)
    q_m = heads(qm, M_QK_DIM)
    k_m = heads(km, M_QK_DIM) * (M_QK_DIM ** -0.5)
    v_m = heads(vm, M_V_DIM)
    log_i = (ig + b_i).astype(jnp.float32).transpose(0, 2, 1)
    log_f = jax.nn.log_sigmoid((fg + b_f).astype(jnp.float32)).transpose(0, 2, 1)
    return q_att, k_att, v_att, (q_m, k_m, v_m, log_i, log_f), (za, om, zm, ga, gm)


def _attend(q, k, v, sinks, valid=None):
    s = jnp.einsum('...qhgd,...khd->...hgqk', q, k).astype(jnp.float32) * (1.0 / math.sqrt(HEAD_DIM))
    if valid is not None:
        s = jnp.where(valid[..., None, None, :, :], s, NEG_INF)
    sink = jnp.broadcast_to(sinks.reshape(N_KV_HEADS, GQA_GROUP)[:, :, None, None].astype(jnp.float32),
                            s.shape[:-1] + (1,))
    p = jax.nn.softmax(jnp.concatenate([s, sink], axis=-1), axis=-1)[..., :-1].astype(v.dtype)
    return jnp.einsum('...hgqk,...khd->...qhgd', p, v)


def _band(a, n_chunks):
    B = a.shape[0]
    ap = jnp.pad(a, ((0, 0), (WIN_CHUNKS * CHUNK, 0), (0, 0), (0, 0)))
    ap = ap.reshape((B, n_chunks + WIN_CHUNKS, CHUNK) + a.shape[2:])
    return jnp.concatenate([ap[:, j:j + n_chunks] for j in range(WIN_CHUNKS + 1)], axis=2)


def _mlstm_block(carry, blk):
    C, n, m = carry
    q, k, v, log_i, log_f = blk
    L = q.shape[-2]
    b = jnp.cumsum(log_f, axis=-1)
    tril = jnp.tril(jnp.ones((L, L), dtype=bool))
    dmat = jnp.where(tril, b[..., :, None] - b[..., None, :] + log_i[..., None, :], -jnp.inf)
    inter = b + m[..., None]
    m_t = jnp.maximum(inter, jnp.max(dmat, axis=-1))
    w = jnp.exp(dmat - m_t[..., None])
    a = jnp.exp(inter - m_t)
    wqk = w * jnp.einsum('bhtd,bhsd->bhts', q, k)
    num = a[..., None] * jnp.einsum('bhtd,bhde->bhte', q, C) + jnp.einsum('bhts,bhse->bhte', wqk, v)
    den = a * jnp.einsum('bhtd,bhd->bht', q, n) + jnp.sum(wqk, axis=-1)
    h = num / jnp.maximum(jnp.abs(den), jnp.exp(-m_t))[..., None]
    m_new = m_t[..., -1]
    ws = jnp.exp(b[..., -1:] - b + log_i - m_new[..., None])
    a_last = jnp.exp(inter[..., -1] - m_new)
    C_new = a_last[..., None, None] * C + jnp.einsum('bhs,bhsd,bhse->bhde', ws, k, v)
    n_new = a_last[..., None] * n + jnp.einsum('bhs,bhsd->bhd', ws, k)
    return (C_new, n_new, m_new), h


def _mlstm_scan(state, q, k, v, log_i, log_f):
    B, H, T, _ = q.shape
    nb = T // CHUNK
    blocks = lambda a: jnp.moveaxis(a.reshape(a.shape[:2] + (nb, CHUNK) + a.shape[3:]), 2, 0)
    state, h = lax.scan(_mlstm_block, state, (blocks(q), blocks(k), blocks(v), blocks(log_i), blocks(log_f)))
    return state, jnp.moveaxis(h, 0, 2).reshape(B, H, T, M_V_DIM)


def _merge(x, o_att, h_m, gates, g_mh, w_pa, w_pm, w_out):
    za, om, zm, ga, gm = gates
    B, T, _ = x.shape
    hm = h_m.transpose(0, 2, 1, 3)
    hm = hm * lax.rsqrt(jnp.mean(hm * hm, axis=-1, keepdims=True) + EPS)
    hm = (hm.reshape(B, T, M_V_WIDTH) * g_mh.astype(jnp.float32)).astype(x.dtype)
    ya = (o_att * jax.nn.silu(za)) @ w_pa
    ym = (hm * jax.nn.sigmoid(om) * jax.nn.silu(zm)) @ w_pm
    merged = jax.nn.sigmoid(ga) * ya + jax.nn.sigmoid(gm) * ym
    return x + merged @ w_out


def setup_inputs(seed: int = 0) -> dict:
    key = jax.random.key(seed)
    ks = jax.random.split(key, 20)
    f32 = jnp.float32
    nrm = lambda k, shape, s: jax.random.normal(k, shape, f32) * s
    return {
        "x_prompt": nrm(ks[0], (BATCH, SEQ, D_MODEL), 1.0),
        "x_sample": nrm(ks[1], (DEC_BATCH, DEC_SEQ, D_MODEL), 1.0),
        "cache_k": nrm(ks[2], (DEPTH, DEC_BATCH, CACHE_ROWS, N_KV_HEADS, HEAD_DIM), 1.0),
        "cache_v": nrm(ks[3], (DEPTH, DEC_BATCH, CACHE_ROWS, N_KV_HEADS, HEAD_DIM), 1.0),
        "state_C": nrm(ks[4], (DEPTH, DEC_BATCH, M_HEADS, M_QK_DIM, M_V_DIM), 0.05),
        "state_n": nrm(ks[5], (DEPTH, DEC_BATCH, M_HEADS, M_QK_DIM), 0.1),
        "state_m": jax.random.uniform(ks[6], (DEPTH, DEC_BATCH, M_HEADS), f32, 0.0, 2.0),
        "meta_tokens": nrm(ks[7], (N_META, D_MODEL), 1.0),
        "g_norm": 1.0 + nrm(ks[8], (DEPTH, D_MODEL), 0.05),
        "w_in": nrm(ks[9], (DEPTH, D_MODEL, IN_COLS), D_MODEL ** -0.5),
        "b_igate": nrm(ks[10], (DEPTH, M_HEADS), 0.1),
        "b_fgate": 3.0 + nrm(ks[11], (DEPTH, M_HEADS), 0.1),
        "attn_sinks": nrm(ks[12], (DEPTH, N_Q_HEADS), 0.5),
        "g_mhnorm": 1.0 + nrm(ks[13], (DEPTH, M_V_WIDTH), 0.05),
        "w_pa": nrm(ks[14], (DEPTH, ATTN_WIDTH, D_MODEL), ATTN_WIDTH ** -0.5),
        "w_pm": nrm(ks[15], (DEPTH, M_V_WIDTH, D_MODEL), M_V_WIDTH ** -0.5),
        "w_out": nrm(ks[16], (DEPTH, D_MODEL, D_MODEL), D_MODEL ** -0.5),
        "g_final": 1.0 + nrm(ks[17], (D_MODEL,), 0.05),
    }


def reference(x_prompt, x_sample, cache_k, cache_v, state_C, state_n, state_m, meta_tokens, g_norm, w_in,
              b_igate, b_fgate, attn_sinks, g_mhnorm, w_pa, w_pm, w_out, g_final):
    f32 = jnp.float32
    B, S, _ = x_prompt.shape
    DB, DS, _ = x_sample.shape
    n_chunks = S // CHUNK
    band_valid = (jnp.arange(n_chunks)[:, None] - WIN_CHUNKS + jnp.arange(WIN_CHUNKS + 1)[None, :]) >= 0
    band_valid = jnp.repeat(band_valid, CHUNK, axis=1)
    valid_p = jnp.concatenate([jnp.ones((n_chunks, N_META), dtype=bool), band_valid], axis=1)[:, None, :]

    xm = meta_tokens.astype(x_prompt.dtype)
    xp, xs = x_prompt, x_sample
    kp_l, vp_l, Cp_l, np_l, mp_l = [], [], [], [], []
    ks_l, vs_l, Cs_l, ns_l, ms_l = [], [], [], [], []
    for l in range(DEPTH):
        wl = (w_in[l], b_igate[l], b_fgate[l])
        mix = (g_mhnorm[l], w_pa[l], w_pm[l], w_out[l])

        q_meta, k_meta, v_meta, cell_meta, gates_meta = _project(_rmsnorm(xm, g_norm[l])[None], *wl)
        zero = (jnp.zeros((1, M_HEADS, M_QK_DIM, M_V_DIM), f32), jnp.zeros((1, M_HEADS, M_QK_DIM), f32),
                jnp.zeros((1, M_HEADS), f32))
        meta_state, h_meta = _mlstm_block(zero, cell_meta)
        k_meta, v_meta = k_meta[0], v_meta[0]

        qa, ka, va, cell_p, gates_p = _project(_rmsnorm(xp, g_norm[l]), *wl)
        keys_p = jnp.concatenate([jnp.broadcast_to(k_meta, (B, n_chunks) + k_meta.shape), _band(ka, n_chunks)], axis=2)
        vals_p = jnp.concatenate([jnp.broadcast_to(v_meta, (B, n_chunks) + v_meta.shape), _band(va, n_chunks)], axis=2)
        o_p = _attend(qa.reshape(B, n_chunks, CHUNK, N_KV_HEADS, GQA_GROUP, HEAD_DIM), keys_p, vals_p,
                      attn_sinks[l], valid_p)
        init_p = tuple(jnp.broadcast_to(a, (B,) + a.shape[1:]) for a in meta_state)
        st_p, h_p = _mlstm_scan(init_p, *cell_p)
        xp_next = _merge(xp, o_p.reshape(B, S, ATTN_WIDTH), h_p, gates_p, *mix)
        kp_l.append(ka[:, S - CACHE_ROWS:])
        vp_l.append(va[:, S - CACHE_ROWS:])
        Cp_l.append(st_p[0]); np_l.append(st_p[1]); mp_l.append(st_p[2])

        qs, ksn, vsn, cell_s, gates_s = _project(_rmsnorm(xs, g_norm[l]), *wl)
        kwin = jnp.concatenate([cache_k[l].astype(ksn.dtype), ksn], axis=1)
        vwin = jnp.concatenate([cache_v[l].astype(vsn.dtype), vsn], axis=1)
        keys_s = jnp.concatenate([jnp.broadcast_to(k_meta, (DB,) + k_meta.shape), kwin], axis=1)
        vals_s = jnp.concatenate([jnp.broadcast_to(v_meta, (DB,) + v_meta.shape), vwin], axis=1)
        o_s = _attend(qs, keys_s, vals_s, attn_sinks[l])
        carry_s = (state_C[l].astype(f32), state_n[l].astype(f32), state_m[l].astype(f32))
        st_s, h_s = _mlstm_block(carry_s, cell_s)
        xs_next = _merge(xs, o_s.reshape(DB, DS, ATTN_WIDTH), h_s, gates_s, *mix)
        ks_l.append(kwin[:, -CACHE_ROWS:])
        vs_l.append(vwin[:, -CACHE_ROWS:])
        Cs_l.append(st_s[0]); ns_l.append(st_s[1]); ms_l.append(st_s[2])

        if l + 1 < DEPTH:
            o_meta = _attend(q_meta[0], k_meta, v_meta, attn_sinks[l])
            xm = _merge(xm[None], o_meta.reshape(1, N_META, ATTN_WIDTH), h_meta, gates_meta, *mix)[0]
        xp, xs = xp_next, xs_next

    return (_rmsnorm(xp, g_final), _rmsnorm(xs, g_final),
            jnp.stack(kp_l), jnp.stack(vp_l), jnp.stack(Cp_l), jnp.stack(np_l), jnp.stack(mp_l),
            jnp.stack(ks_l), jnp.stack(vs_l), jnp.stack(Cs_l), jnp.stack(ns_l), jnp.stack(ms_l))
```

```cpp
#include <hip/hip_runtime.h>
#include <hip/hip_cooperative_groups.h>
#include <cstdio>
#include <cstdint>
namespace cg = cooperative_groups;

#ifndef REP1
#define REP1 1
#endif
#ifndef REP3
#define REP3 1
#endif
#ifndef REP0
#define REP0 1
#endif
#ifndef REP2
#define REP2 1
#endif
#ifndef REP4
#define REP4 1
#endif
#ifndef PSEL
#define PSEL 7
#endif
#ifndef REP56
#define REP56 1
#endif
#ifndef REPSYNC
#define REPSYNC 0
#endif
#ifndef N_LAUNCH
#define N_LAUNCH 1
#endif

#define LAS __attribute__((address_space(3)))
typedef unsigned short bf16_t;
typedef short bf16x8 __attribute__((ext_vector_type(8)));
typedef short s16x4 __attribute__((ext_vector_type(4)));
typedef float f32x4 __attribute__((ext_vector_type(4)));
typedef float f32x2 __attribute__((ext_vector_type(2)));
typedef unsigned u32x4 __attribute__((ext_vector_type(4)));
typedef unsigned u32x2 __attribute__((ext_vector_type(2)));
#define DI __device__ __forceinline__

constexpr int DM = 2048;
constexpr int ROW_S = 8192, ROW_M = 8448, MROWS = 8464, MPAD = 8704, MOUT = 8448;
constexpr int NU = 16896, NW = 17152;
constexpr size_t UT = (size_t)8704 * 256;
__device__ __forceinline__ size_t uoff(int row, int col) { return (size_t)(col >> 8) * UT + (size_t)row * 256 + (col & 255); }
constexpr int QA = 0, KA = 2048, VA = 2304, ZA = 2560, QM = 4608, KM = 5632, VM = 6656, OM = 8704, ZM = 10752, GA = 12800, GM = 14848;
constexpr int NCH = 64;
constexpr float EPS = 1e-6f;
constexpr size_t O_KP = 17301504, O_VP = 17334272, O_CP = 17367040, O_NP = 17629184, O_MP = 17630208,
                 O_KS = 17630216, O_VS = 18154504, O_CS = 18678792, O_NS = 22873096, O_MS = 22889480;
constexpr size_t WS_WIN = 4096;
constexpr size_t WS_WP = WS_WIN + (size_t)NW * 2048 * 2;
constexpr size_t WS_WOUT = WS_WP + (size_t)4096 * 2048 * 2;
constexpr size_t WS_XN = WS_WOUT + (size_t)2048 * 2048 * 2;
constexpr size_t WS_U = WS_XN + (size_t)MPAD * 2048 * 2;
constexpr size_t WS_GATE = WS_U + (size_t)MPAD * NU * 2;
constexpr size_t WS_UP = WS_GATE + (size_t)MPAD * 16 * 4;
constexpr size_t WS_CST = WS_UP + (size_t)8 * NCH * 256 * 128 * 4;
constexpr size_t WS_NP = WS_CST + (size_t)8 * NCH * 256 * 128 * 2;
constexpr size_t WS_NS = WS_NP + (size_t)8 * NCH * 128 * 4;
constexpr size_t WS_BS = WS_NS + (size_t)8 * NCH * 128 * 4;
constexpr size_t WS_ML = WS_BS + 4096;
constexpr size_t WS_MS = WS_ML + 4096;
constexpr size_t WS_C0 = WS_MS + 4096;
constexpr size_t WS_N0 = WS_C0 + (size_t)8 * 128 * 256 * 4;
constexpr size_t WS_M0 = WS_N0 + 4096;
constexpr size_t WS_SSQ = WS_M0 + 4096;
constexpr size_t WS_BAR = WS_SSQ + (size_t)MOUT * 32 * 4;
constexpr size_t WS_CNT = WS_BAR + 16384;
constexpr size_t WS_END = WS_CNT + 4096;
constexpr int LDS_BYTES = 131072 + 2048;

struct Params {
    const float *xp, *xs, *ck, *cv, *sC, *sn, *sm, *meta, *gnorm, *win, *bi, *bf, *sinks, *gmh, *wpa, *wpm, *wout, *gfinal;
    float* out; unsigned char* ws; int ph_lo, ph_hi;
};

DI float bf2f(unsigned short b) { return __uint_as_float(((unsigned)b) << 16); }
DI float bflo(unsigned w) { return __uint_as_float(w << 16); }
DI float bfhi(unsigned w) { return __uint_as_float(w & 0xffff0000u); }
DI unsigned pk2(float lo, float hi) { unsigned r; asm volatile("v_cvt_pk_bf16_f32 %0, %1, %2" : "=v"(r) : "v"(lo), "v"(hi)); return r; }
DI float sigmoidf_(float x) { return 1.0f / (1.0f + __expf(-x)); }
DI float siluf_(float x) { return x / (1.0f + __expf(-x)); }
DI float logsigmoidf_(float x) { return fminf(x, 0.f) - log1pf(__expf(-fabsf(x))); }
DI float wsum(float v) {
#pragma unroll
    for (int o = 1; o < 64; o <<= 1) v += __shfl_xor(v, o);
    return v;
}
DI float wmax(float v) {
#pragma unroll
    for (int o = 1; o < 64; o <<= 1) v = fmaxf(v, __shfl_xor(v, o));
    return v;
}
DI float scan_add(float v, int lane) {
#pragma unroll
    for (int o = 1; o < 64; o <<= 1) { float t = __shfl_up(v, o); if (lane >= o) v += t; }
    return v;
}
DI float scan_max(float v, int lane) {
#pragma unroll
    for (int o = 1; o < 64; o <<= 1) { float t = __shfl_up(v, o); if (lane >= o) v = fmaxf(v, t); }
    return v;
}
#define LDS_WAIT() asm volatile("s_waitcnt lgkmcnt(0)" ::: "memory")
#define MFMA16(a, b, c) __builtin_amdgcn_mfma_f32_16x16x32_bf16((a), (b), (c), 0, 0, 0)

#define XB_TMO      128
#define XB_XCNT(j)  (256  + 64 * (j))
#define XB_XSUB(j)  (1280 + 64 * (j))
#define XB_XGEN(j)  (2304 + 64 * (j))
#define XB_TOP      3328
#define XB_TOPGEN   3392
#define XCD_BAR_WORDS 3456
#define XB_SPIN_CAP (1u << 18)
DI unsigned xb_ld(unsigned* p)              { return __hip_atomic_load(p, __ATOMIC_RELAXED, __HIP_MEMORY_SCOPE_AGENT); }
DI unsigned xb_add(unsigned* p, unsigned v) { return __hip_atomic_fetch_add(p, v, __ATOMIC_RELAXED, __HIP_MEMORY_SCOPE_AGENT); }
DI unsigned xb_xcc_id() { return (unsigned)__builtin_amdgcn_s_getreg((3 << 11) | 20) & 0xFu; }
#define XB_SPIN(cond, bar) do { unsigned _sp = 0; while (cond) { __builtin_amdgcn_s_sleep(1); \
    if ((++_sp & 255u) == 0u) { if (xb_ld(&(bar)[XB_TMO])) break; if (_sp > XB_SPIN_CAP) { atomicAdd(&(bar)[XB_TMO], 1u); break; } } } } while (0)
struct XcdBarrier { unsigned* bar; unsigned x; volatile LAS unsigned* st; };
DI XcdBarrier xcd_barrier_post(unsigned* bar, volatile LAS unsigned* st) {
    XcdBarrier b; b.bar = bar; b.x = xb_xcc_id(); b.st = st;
    if (threadIdx.x == 0) (void)xb_add(&bar[XB_XCNT(b.x)], 1u);
    return b;
}
DI void xcd_barrier_complete(unsigned* bar, unsigned x, unsigned& nloc, unsigned& nx) {
    const unsigned G = gridDim.x * gridDim.y * gridDim.z;
    unsigned sum, cnt, mine, sp = 0u;
    for (;;) {
        sum = 0u; cnt = 0u; mine = 0u;
#pragma unroll
        for (unsigned j = 0; j < 16; ++j) { const unsigned c = xb_ld(&bar[XB_XCNT(j)]); sum += c; cnt += (c > 0u) ? 1u : 0u; mine = (j == x) ? c : mine; }
        if (sum == G) break;
        __builtin_amdgcn_s_sleep(1);
        if ((++sp & 255u) == 0u) { if (xb_ld(&bar[XB_TMO])) break; if (sp > XB_SPIN_CAP) { atomicAdd(&bar[XB_TMO], 1u); break; } }
    }
    nloc = mine > 0u ? mine : 1u; nx = cnt > 0u ? cnt : 1u;
}
DI void xcd_barrier(const XcdBarrier& b) {
    asm volatile("s_waitcnt vmcnt(0)" ::: "memory");
    __syncthreads();
    if (threadIdx.x == 0) {
        unsigned* bar = b.bar;
        __builtin_amdgcn_s_waitcnt(0);
        unsigned nloc = b.st[0], nx = b.st[1];
        if (nloc == 0u) { xcd_barrier_complete(bar, b.x, nloc, nx); b.st[0] = nloc; b.st[1] = nx; }
        const unsigned old = xb_add(&bar[XB_XSUB(b.x)], 1u);
        const unsigned gen = old / nloc;
        if (old + 1u == (gen + 1u) * nloc) {
            __builtin_amdgcn_fence(__ATOMIC_RELEASE, "agent");
            asm volatile("s_waitcnt vmcnt(0)" ::: "memory");
            const unsigned og = xb_add(&bar[XB_TOP], 1u);
            const unsigned tg = og / nx;
            if (og + 1u == (tg + 1u) * nx) xb_add(&bar[XB_TOPGEN], 1u);
            else XB_SPIN(xb_ld(&bar[XB_TOPGEN]) == tg, bar);
            __builtin_amdgcn_fence(__ATOMIC_ACQUIRE, "agent");
            xb_add(&bar[XB_XGEN(b.x)], 1u);
            asm volatile("s_waitcnt vmcnt(0)" ::: "memory");
        } else {
            XB_SPIN(xb_ld(&bar[XB_XGEN(b.x)]) == gen, bar);
            __builtin_amdgcn_fence(__ATOMIC_ACQUIRE, "agent");
            asm volatile("s_waitcnt vmcnt(0)" ::: "memory");
        }
    }
    __syncthreads();
}

namespace pg8 {
constexpr int BM = 256, BK = 64, HALF = 128, HTB = HALF * BK * 2, STAGE_BYTES = 8 * HTB, NXCD = 8, WGM = 8;
DI int lds_byte(int r, int c) { const int st = (r >> 4) * 2 + (c >> 5), rr = r & 15, cc = c & 31, ob = rr * 64 + cc * 2; return st * 1024 + (ob ^ (((ob >> 9) & 1) << 5)); }
DI void stage_rc(int b, int& R, int& C) { const int st = b / 1024, sb = b % 1024, swz = sb ^ (((sb >> 9) & 1) << 5); R = (st >> 1) * 16 + swz / 64; C = (st & 1) * 32 + (swz % 64) / 2; }
DI int perm32(int rho) { const int n = rho >> 4, i = rho & 15; return 8 * (i >> 2) + 4 * n + (i & 3); }

struct Unit { int pm, pn, sub; };

struct Order {
    int nM, nN, nwg, G, c, pair;
    const char *A0, *A1, *B0, *B1; size_t a_tstep, b_tstep;
    DI void init(int nM_, int nN_, int G_, int c_, int pair_) { nM = nM_; nN = nN_; nwg = nM * nN; G = G_; c = c_; pair = pair_; }
    DI bool next(int i, Unit& u) const {
        const int t = pair ? (i >> 1) : i; u.sub = pair ? (i & 1) : 0;
        const long L = (long)t * G + c; if (L >= nwg) return false;
        int wgid = (int)L; { const int q = nwg / NXCD, r = nwg % NXCD, xcd = wgid % NXCD, off = wgid / NXCD; wgid = (xcd < r ? xcd * (q + 1) : r * (q + 1) + (xcd - r) * q) + off; }
        const int nig = WGM * nN, gid = wgid / nig, fm = gid * WGM, gsz = (nM - fm) < WGM ? (nM - fm) : WGM;
        u.pm = fm + ((wgid % nig) % gsz); u.pn = (wgid % nig) / gsz; return true;
    }
    DI const char* a_ptr(const Unit& u) const { return (u.sub ? A1 : A0) + (size_t)u.pm * a_tstep; }
    DI const char* b_ptr(const Unit& u) const { return (u.sub ? B1 : B0) + (size_t)u.pn * b_tstep; }
};

template <class Epi>
DI void gemm_phase(LAS unsigned char* lds, const int K, const int lda, const size_t a_kblk, const Order& S, const Epi& E) {
#define PG8_AK(x) ((size_t)((x) >> 2) * a_kblk + (size_t)((x) & 3) * 128)
    const int tid = threadIdx.x, wid = __builtin_amdgcn_readfirstlane(tid >> 6), lane = tid & 63, wr = wid >> 2, wc = wid & 3, fr = lane & 15, fq = lane >> 4;
    const int nt = K / BK;
    unsigned voffA[2], voffB[2];
#pragma unroll
    for (int i = 0; i < 2; ++i) { int R, C; stage_rc(tid * 16 + i * 8192, R, C); const int Rb = Epi::PERM ? ((R & ~31) + perm32(R & 31)) : R;
        voffA[i] = (unsigned)(R * lda + C) * 2u; voffB[i] = (unsigned)(Rb * K + C) * 2u; }
    const size_t kstep = (size_t)(BK * 2);
    const size_t hstepA = (size_t)HALF * lda * 2, hstepB = (size_t)HALF * K * 2;
    const unsigned ldsw = (unsigned)wid * 1024u;
    const int aoff = lds_byte(wr * 64 + fr, fq * 8), boff = lds_byte(wc * 32 + fr, fq * 8);
#define PG8_SA(b, h) (((b) * 2 + (h)) * HTB)
#define PG8_SB(b, h) ((4 + (b) * 2 + (h)) * HTB)
#define PG8_STAGE(bufoff, gbase, voff) do { _Pragma("unroll") for (int _i = 0; _i < 2; ++_i) \
        __builtin_amdgcn_global_load_lds((const unsigned*)((const char*)(gbase) + (voff)[_i]), (LAS unsigned*)(lds + (bufoff) + ldsw + _i * 8192), 16, 0, 0); } while (0)
#define PG8_LDA(dst, b, h) do { _Pragma("unroll") for (int m = 0; m < 4; ++m) _Pragma("unroll") for (int k = 0; k < 2; ++k) dst[m][k] = *(const LAS bf16x8*)(lds + PG8_SA(b, h) + aoff + m * 2048 + k * 1024); } while (0)
#define PG8_LDB(dst, b, h) do { _Pragma("unroll") for (int n = 0; n < 2; ++n) _Pragma("unroll") for (int k = 0; k < 2; ++k) dst[n][k] = *(const LAS bf16x8*)(lds + PG8_SB(b, h) + boff + n * 2048 + k * 1024); } while (0)
#define PG8_MMA(ai, bj, At, Bt) do { __builtin_amdgcn_s_setprio(1); _Pragma("unroll") for (int m = 0; m < 4; ++m) _Pragma("unroll") for (int n = 0; n < 2; ++n) _Pragma("unroll") for (int k = 0; k < 2; ++k) \
        acc[ai][bj][m][n] = __builtin_amdgcn_mfma_f32_16x16x32_bf16(Bt[n][k], At[m][k], acc[ai][bj][m][n], 0, 0, 0); __builtin_amdgcn_s_setprio(0); } while (0)
#define PG8_WAIT_V(n) asm volatile("s_waitcnt vmcnt(" #n ")" ::: "memory")
#define PG8_WAIT_L(n) asm volatile("s_waitcnt lgkmcnt(" #n ")" ::: "memory")
#define PG8_BAR __builtin_amdgcn_s_barrier()
#define PG8_SCHED __builtin_amdgcn_sched_barrier(0)
    Unit cur, nxt; int ui = 0;
    if (!S.next(0, cur)) return;
    f32x4 acc[2][2][4][2];
#pragma unroll
    for (int a = 0; a < 2; ++a)
#pragma unroll
        for (int b = 0; b < 2; ++b)
#pragma unroll
            for (int m = 0; m < 4; ++m)
#pragma unroll
                for (int n = 0; n < 2; ++n) acc[a][b][m][n] = (f32x4){0.f, 0.f, 0.f, 0.f};
    bf16x8 At[4][2], B0[2][2], B1[2][2];
    const char* cA = S.a_ptr(cur); const char* cB = S.b_ptr(cur);
    PG8_STAGE(PG8_SB(0, 0), cB, voffB); PG8_STAGE(PG8_SA(0, 0), cA, voffA); PG8_STAGE(PG8_SB(0, 1), cB + hstepB, voffB); PG8_STAGE(PG8_SA(0, 1), cA + hstepA, voffA);
    if (wr == 1) PG8_BAR;
    PG8_WAIT_V(4); PG8_BAR;
    PG8_STAGE(PG8_SB(1, 0), cB + kstep, voffB); PG8_STAGE(PG8_SA(1, 0), cA + kstep, voffA); PG8_STAGE(PG8_SB(1, 1), cB + hstepB + kstep, voffB);
    PG8_WAIT_V(6); PG8_BAR;
    for (;;) {
        const bool has_next = S.next(ui + 1, nxt);
        const char* nA = has_next ? S.a_ptr(nxt) : cA; const char* nB = has_next ? S.b_ptr(nxt) : cB;
        for (int t = 0; t < nt; t += 2) {
            const bool last = (t == nt - 2);
            const char* a1 = cA + PG8_AK(t + 1);
            const char* a2 = last ? nA : cA + PG8_AK(t + 2); const char* b2 = last ? nB : cB + (size_t)(t + 2) * kstep;
            const char* a3 = a2 + kstep; const char* b3 = b2 + kstep;
            PG8_LDB(B0, 0, 0); PG8_SCHED; PG8_LDA(At, 0, 0); PG8_STAGE(PG8_SA(1, 1), a1 + hstepA, voffA);
            PG8_WAIT_L(8); PG8_BAR; PG8_WAIT_L(0); PG8_MMA(0, 0, At, B0); PG8_BAR; PG8_SCHED;
            PG8_LDB(B1, 0, 1); PG8_STAGE(PG8_SB(0, 0), b2, voffB);
            PG8_BAR; PG8_WAIT_L(0); PG8_MMA(0, 1, At, B1); PG8_BAR;
            PG8_LDA(At, 0, 1); PG8_STAGE(PG8_SA(0, 0), a2, voffA);
            PG8_BAR; PG8_WAIT_L(0); PG8_MMA(1, 0, At, B0); PG8_BAR; PG8_SCHED;
            PG8_STAGE(PG8_SB(0, 1), b2 + hstepB, voffB);
            PG8_WAIT_V(6); PG8_BAR; PG8_MMA(1, 1, At, B1); PG8_BAR;
            PG8_LDB(B0, 1, 0); PG8_SCHED; PG8_LDA(At, 1, 0); PG8_STAGE(PG8_SA(0, 1), a2 + hstepA, voffA);
            PG8_WAIT_L(8); PG8_BAR; PG8_WAIT_L(0); PG8_MMA(0, 0, At, B0); PG8_BAR; PG8_SCHED;
            PG8_LDB(B1, 1, 1); PG8_STAGE(PG8_SB(1, 0), b3, voffB);
            PG8_BAR; PG8_WAIT_L(0); PG8_MMA(0, 1, At, B1); PG8_BAR;
            PG8_LDA(At, 1, 1); PG8_STAGE(PG8_SA(1, 0), a3, voffA);
            PG8_BAR; PG8_WAIT_L(0); PG8_MMA(1, 0, At, B0); PG8_BAR; PG8_SCHED;
            PG8_STAGE(PG8_SB(1, 1), b3 + hstepB, voffB);
            PG8_WAIT_V(6); PG8_BAR; PG8_MMA(1, 1, At, B1); PG8_BAR;
        }
        if constexpr (!Epi::AFTER_DRAIN) E(acc, cur, wr, wc, fr, fq);
        if (!has_next) break;
#pragma unroll
        for (int a = 0; a < 2; ++a)
#pragma unroll
            for (int b = 0; b < 2; ++b)
#pragma unroll
                for (int m = 0; m < 4; ++m)
#pragma unroll
                    for (int n = 0; n < 2; ++n) acc[a][b][m][n] = (f32x4){0.f, 0.f, 0.f, 0.f};
        cur = nxt; cA = nA; cB = nB; ++ui;
    }
    PG8_WAIT_V(0);
    if (wr == 0) PG8_BAR;
    PG8_BAR;
    if constexpr (Epi::AFTER_DRAIN) E(acc, cur, wr, wc, fr, fq);
#undef PG8_AK
#undef PG8_SA
#undef PG8_SB
#undef PG8_STAGE
#undef PG8_LDA
#undef PG8_LDB
#undef PG8_MMA
#undef PG8_WAIT_V
#undef PG8_WAIT_L
#undef PG8_BAR
#undef PG8_SCHED
}

struct EpiU {
    static constexpr bool PERM = true, AFTER_DRAIN = false;
    bf16_t* U; float* gate; float* out;
    DI void operator()(const f32x4 (&acc)[2][2][4][2], const Unit& u, int wr, int wc, int fr, int fq) const {
        const int row0 = u.pm * BM + wr * 64 + fr, pn = u.pn;
        if (pn == 66) {
            if (wc == 0 && fq < 2) {
#pragma unroll
                for (int ai = 0; ai < 2; ++ai)
#pragma unroll
                    for (int m = 0; m < 4; ++m) { float* g = gate + (size_t)(row0 + ai * HALF + m * 16) * 16 + 8 * fq;
                        *(f32x4*)g = acc[ai][0][m][0]; *(f32x4*)(g + 4) = acc[ai][0][m][1]; }
            }
            return;
        }
        const float scale = (pn < 8) ? 0.18033688011112042f : ((pn >= 22 && pn < 26) ? 0.08838834764831845f : 1.0f);
        const int col0 = pn * BM + wc * 32 + 8 * fq;
#pragma unroll
        for (int ai = 0; ai < 2; ++ai)
#pragma unroll
            for (int m = 0; m < 4; ++m) { bf16_t* rowp = U + (size_t)pn * UT + (size_t)(row0 + ai * HALF + m * 16) * 256 + (wc * 32 + 8 * fq);
#pragma unroll
                for (int bj = 0; bj < 2; ++bj) { const f32x4 v0 = acc[ai][bj][m][0] * scale, v1 = acc[ai][bj][m][1] * scale;
                    u32x4 w; w.x = pk2(v0[0], v0[1]); w.y = pk2(v0[2], v0[3]); w.z = pk2(v1[0], v1[1]); w.w = pk2(v1[2], v1[3]);
                    *(u32x4*)(rowp + bj * HALF) = w; } }
        if (pn == 8 || pn == 9) {
#pragma unroll
            for (int ai = 0; ai < 2; ++ai)
#pragma unroll
                for (int m = 0; m < 4; ++m) { const int r = row0 + ai * HALF + m * 16; float* dst = nullptr;
                    if (r >= 8064 && r < 8192) dst = out + (pn == 8 ? O_KP : O_VP) + (size_t)(r - 8064) * 256;
                    else if (r >= 8192 && r < 8448) { const int b = (r - 8192) >> 4, t = (r - 8192) & 15; dst = out + (pn == 8 ? O_KS : O_VS) + (size_t)(b * 128 + 112 + t) * 256; }
                    if (dst) {
#pragma unroll
                        for (int bj = 0; bj < 2; ++bj) { const int c = bj * HALF + wc * 32 + 8 * fq; *(f32x4*)(dst + c) = acc[ai][bj][m][0]; *(f32x4*)(dst + c + 4) = acc[ai][bj][m][1]; } } }
        }
    }
};
struct EpiMerge {
    static constexpr bool PERM = true, AFTER_DRAIN = false;
    const bf16_t* U; bf16_t* MG;
    DI void operator()(const f32x4 (&acc)[2][2][4][2], const Unit& u, int wr, int wc, int fr, int fq) const {
        const int row0 = u.pm * BM + wr * 64 + fr, col0 = u.pn * BM + wc * 32 + 8 * fq; const int gcol = u.sub ? GM : GA;
#pragma unroll
        for (int ai = 0; ai < 2; ++ai)
#pragma unroll
            for (int m = 0; m < 4; ++m) { const int r = row0 + ai * HALF + m * 16;
#pragma unroll
                for (int bj = 0; bj < 2; ++bj) { const int c = col0 + bj * HALF;
                    const u32x4 g = *(const u32x4*)(U + uoff(r, gcol + c));
                    const f32x4 a0 = acc[ai][bj][m][0], a1 = acc[ai][bj][m][1];
                    float v[8];
                    v[0] = sigmoidf_(bflo(g.x)) * a0[0]; v[1] = sigmoidf_(bfhi(g.x)) * a0[1]; v[2] = sigmoidf_(bflo(g.y)) * a0[2]; v[3] = sigmoidf_(bfhi(g.y)) * a0[3];
                    v[4] = sigmoidf_(bflo(g.z)) * a1[0]; v[5] = sigmoidf_(bfhi(g.z)) * a1[1]; v[6] = sigmoidf_(bflo(g.w)) * a1[2]; v[7] = sigmoidf_(bfhi(g.w)) * a1[3];
                    bf16_t* dst = MG + (size_t)r * DM + c;
                    if (u.sub) { const u32x4 o = *(const u32x4*)dst;
                        v[0] += bflo(o.x); v[1] += bfhi(o.x); v[2] += bflo(o.y); v[3] += bfhi(o.y); v[4] += bflo(o.z); v[5] += bfhi(o.z); v[6] += bflo(o.w); v[7] += bfhi(o.w); }
                    u32x4 w; w.x = pk2(v[0], v[1]); w.y = pk2(v[2], v[3]); w.z = pk2(v[4], v[5]); w.w = pk2(v[6], v[7]);
                    *(u32x4*)dst = w; } }
    }
};
struct EpiOut {
    static constexpr bool PERM = false, AFTER_DRAIN = true;
    const float *xp, *gfin; float* out; float* ssq; unsigned* cnt;
    DI void operator()(f32x4 (&acc)[2][2][4][2], const Unit& u, int wr, int wc, int fr, int fq) const {
        const int row0 = u.pm * BM + wr * 64 + fr, col0 = u.pn * BM + wc * 32 + 4 * fq;
#pragma unroll
        for (int ai = 0; ai < 2; ++ai)
#pragma unroll
            for (int m = 0; m < 4; ++m) { const int r = row0 + ai * HALF + m * 16; const float* xrow = xp + (size_t)r * DM; float ss = 0.f;
#pragma unroll
                for (int bj = 0; bj < 2; ++bj)
#pragma unroll
                    for (int n = 0; n < 2; ++n) { const int c = col0 + bj * HALF + n * 16; const f32x4 o = *(const f32x4*)(xrow + c) + acc[ai][bj][m][n];
                        acc[ai][bj][m][n] = o; ss += (o[0] * o[0] + o[1] * o[1]) + (o[2] * o[2] + o[3] * o[3]); }
                ss += __shfl_xor(ss, 16); ss += __shfl_xor(ss, 32);
                if (fq == 0) __hip_atomic_store(ssq + (size_t)r * 32 + u.pn * 4 + wc, ss, __ATOMIC_RELAXED, __HIP_MEMORY_SCOPE_AGENT); }
        asm volatile("s_waitcnt vmcnt(0)" ::: "memory");
        unsigned* c = cnt + 16 * u.pm;
        if ((threadIdx.x & 63) == 0) __hip_atomic_fetch_add(c, 1u, __ATOMIC_RELAXED, __HIP_MEMORY_SCOPE_AGENT);
        { unsigned sp = 0; while ((unsigned)__builtin_amdgcn_readfirstlane(__hip_atomic_load(c, __ATOMIC_RELAXED, __HIP_MEMORY_SCOPE_AGENT)) < 64u) { __builtin_amdgcn_s_sleep(1); if (++sp > (1u << 22)) break; } }
        __builtin_amdgcn_fence(__ATOMIC_ACQUIRE, "agent");
        asm volatile("s_waitcnt vmcnt(0)" ::: "memory");
        f32x4 gv[2][2];
#pragma unroll
        for (int bj = 0; bj < 2; ++bj)
#pragma unroll
            for (int n = 0; n < 2; ++n) gv[bj][n] = *(const f32x4*)(gfin + col0 + bj * HALF + n * 16);
#pragma unroll
        for (int ai = 0; ai < 2; ++ai)
#pragma unroll
            for (int m = 0; m < 4; ++m) { const int r = row0 + ai * HALF + m * 16;
                const f32x4 p0 = *(const f32x4*)(ssq + (size_t)r * 32 + 8 * fq), p1 = *(const f32x4*)(ssq + (size_t)r * 32 + 8 * fq + 4);
                float tot = ((p0[0] + p0[1]) + (p0[2] + p0[3])) + ((p1[0] + p1[1]) + (p1[2] + p1[3]));
                tot += __shfl_xor(tot, 16); tot += __shfl_xor(tot, 32);
                const float rstd = rsqrtf(tot * (1.f / DM) + EPS); float* orow = out + (size_t)r * DM;
#pragma unroll
                for (int bj = 0; bj < 2; ++bj)
#pragma unroll
                    for (int n = 0; n < 2; ++n) { f32x4 o = acc[ai][bj][m][n] * rstd; o = o * gv[bj][n]; *(f32x4*)(orow + col0 + bj * HALF + n * 16) = o; } }
    }
};
}

DI int win_src_col(int n) { return n < 10752 ? n : (n < 16896 ? n + 16 : (n < 16912 ? 10752 + (n - 16896) : -1)); }

DI void p0_transpose_item(const float* W, int Nsrc, int srccol4, bf16_t* WT, int dstrow0, int k0, LAS float* scr, int lane) {
    f32x4 r[8];
#pragma unroll
    for (int i = 0; i < 8; ++i) { const int kk = (lane >> 3) + 8 * i; r[i] = (srccol4 >= 0) ? *(const f32x4*)(W + (size_t)(k0 + kk) * Nsrc + srccol4) : (f32x4){0.f, 0.f, 0.f, 0.f}; }
#pragma unroll
    for (int i = 0; i < 8; ++i) { const int kk = (lane >> 3) + 8 * i; LAS float* d = scr + kk * 33 + 4 * (lane & 7); d[0] = r[i][0]; d[1] = r[i][1]; d[2] = r[i][2]; d[3] = r[i][3]; }
    LDS_WAIT();
    const int c = lane & 7;
#pragma unroll
    for (int j = 0; j < 4; ++j) { const int n = (lane >> 3) + 8 * j; const LAS float* s = scr + (8 * c) * 33 + n;
        u32x4 o; o.x = pk2(s[0 * 33], s[1 * 33]); o.y = pk2(s[2 * 33], s[3 * 33]); o.z = pk2(s[4 * 33], s[5 * 33]); o.w = pk2(s[6 * 33], s[7 * 33]);
        *(u32x4*)(WT + (size_t)(dstrow0 + n) * 2048 + k0 + 8 * c) = o; }
    LDS_WAIT();
}

DI void p0_prologue(const Params& p, LAS unsigned char* lds) {
    const int tid = threadIdx.x, lane = tid & 63, wave = tid >> 6;
    const int gw = blockIdx.x * 8 + wave, NGW = gridDim.x * 8;
    bf16_t* WIN = (bf16_t*)(p.ws + WS_WIN); bf16_t* WP = (bf16_t*)(p.ws + WS_WP); bf16_t* WOUT = (bf16_t*)(p.ws + WS_WOUT); bf16_t* XN = (bf16_t*)(p.ws + WS_XN);
    LAS float* scr = (LAS float*)(lds + wave * 16384);
    constexpr int I_IN = 32 * (NW / 32), I_SQ = 32 * 64;
    for (int it = gw; it < I_IN + 3 * I_SQ; it += NGW) {
        int r = it;
        if (r < I_IN) { const int nb = r % (NW / 32), kb = r / (NW / 32); p0_transpose_item(p.win, 16912, win_src_col(nb * 32 + 4 * (lane & 7)), WIN, nb * 32, kb * 64, scr, lane); continue; }
        r -= I_IN; const int which = r / I_SQ; r -= which * I_SQ; const int nb = r % 64, kb = r / 64;
        const float* W = which == 0 ? p.wpa : (which == 1 ? p.wpm : p.wout);
        bf16_t* WT = which == 2 ? WOUT : WP; const int drow = (which == 1 ? 2048 : 0) + nb * 32;
        p0_transpose_item(W, 2048, nb * 32 + 4 * (lane & 7), WT, drow, kb * 64, scr, lane);
    }
    for (int m = gw; m < MPAD; m += NGW) {
        u32x2* o8 = (u32x2*)(XN + (size_t)m * DM) + lane;
        if (m >= MROWS) {
#pragma unroll
            for (int j = 0; j < 8; ++j) o8[64 * j] = (u32x2){0u, 0u};
            continue; }
        const float* xrow = m < ROW_S ? p.xp + (size_t)m * DM : (m < ROW_M ? p.xs + (size_t)(m - ROW_S) * DM : p.meta + (size_t)(m - ROW_M) * DM);
        const f32x4* xr = (const f32x4*)xrow + lane; const f32x4* gr = (const f32x4*)p.gnorm + lane;
        f32x4 v[8]; float s = 0.f;
#pragma unroll
        for (int j = 0; j < 8; ++j) { v[j] = xr[64 * j]; s += (v[j][0] * v[j][0] + v[j][1] * v[j][1]) + (v[j][2] * v[j][2] + v[j][3] * v[j][3]); }
        const float rstd = rsqrtf(wsum(s) * (1.f / DM) + EPS);
#pragma unroll
        for (int j = 0; j < 8; ++j) { const f32x4 g = gr[64 * j]; u32x2 w; w.x = pk2(v[j][0] * rstd * g[0], v[j][1] * rstd * g[1]); w.y = pk2(v[j][2] * rstd * g[2], v[j][3] * rstd * g[3]); o8[64 * j] = w; }
    }
    const int gt = blockIdx.x * 512 + tid, NGT = gridDim.x * 512;
    for (int i = gt; i < 2 * 16 * 112 * 64; i += NGT) {
        const int kv = i / (16 * 112 * 64); int r = i - kv * (16 * 112 * 64); const int b = r / (112 * 64); r -= b * (112 * 64);
        const f32x4* src = (const f32x4*)((kv ? p.cv : p.ck) + (size_t)(b * 128 + 16) * 256) + r;
        f32x4* dst = (f32x4*)(p.out + (kv ? O_VS : O_KS) + (size_t)(b * 128) * 256) + r;
        *dst = *src;
    }
}

DI u32x4 attn_fetch8(const Params& p, const bf16_t* U, int kind, int bidx, int g, int key, int ch, int colbase, const float* cache) {
    u32x4 z = (u32x4){0u, 0u, 0u, 0u};
    if (key < 16) return *(const u32x4*)(U + uoff(ROW_M + key, colbase + g * 64 + 8 * ch));
    if (kind == 0) {
        const int row = 64 * (bidx - 2) + (key - 16);
        if (key < 208 && row >= 0) return *(const u32x4*)(U + uoff(row, colbase + g * 64 + 8 * ch));
        return z;
    } else {
        if (key < 144) { const float* s = cache + ((size_t)(bidx * 128 + (key - 16)) * 4 + g) * 64 + 8 * ch; const f32x4 a = *(const f32x4*)s, b = *(const f32x4*)(s + 4);
            u32x4 w; w.x = pk2(a[0], a[1]); w.y = pk2(a[2], a[3]); w.z = pk2(b[0], b[1]); w.w = pk2(b[2], b[3]); return w; }
        if (key < 160) return *(const u32x4*)(U + uoff(ROW_S + 16 * bidx + (key - 144), colbase + g * 64 + 8 * ch));
        return z;
    }
}
DI void attn_item(const Params& p, LAS unsigned char* lds, int kind, int bidx, int g, int dry) {
    int tid_ = threadIdx.x; asm volatile("" : "+v"(tid_)); const int tid = tid_, lane = tid & 63, wave = tid >> 6, lr = lane & 15, q = lane >> 4;
    bf16_t* U = (bf16_t*)(p.ws + WS_U);
    LAS bf16_t* KAl = (LAS bf16_t*)lds; LAS unsigned* VAd = (LAS unsigned*)(lds + 32256); LAS bf16_t* VAl = (LAS bf16_t*)(lds + 32256);
    const int hq = 8 * g + wave; const float sink = p.sinks[hq] * 1.4426950408889634f;
    const int npair = kind == 0 ? 2 : 1, qrow0 = kind == 0 ? 64 * bidx : ROW_S + 16 * bidx;
    const int hi_t = kind == 0 ? 13 : 10; const int lo_t = kind == 0 ? 1 + (bidx < 2 ? 4 * (2 - bidx) : 0) : 1;
    u32x4 kreg[4], va[2], vb[2];
#pragma unroll
    for (int i = 0; i < 4; ++i) { const int ci = tid + 512 * i; kreg[i] = (u32x4){0u, 0u, 0u, 0u}; if (ci < 224 * 8) kreg[i] = attn_fetch8(p, U, kind, bidx, g, ci >> 3, ci & 7, KA, p.ck); }
#pragma unroll
    for (int i = 0; i < 2; ++i) { const int ci = tid + 512 * i; va[i] = (u32x4){0u, 0u, 0u, 0u}; vb[i] = va[i];
        if (ci < 112 * 8) { const int kp = ci % 112, ch = ci / 112; va[i] = attn_fetch8(p, U, kind, bidx, g, 2 * kp, ch, VA, p.cv); vb[i] = attn_fetch8(p, U, kind, bidx, g, 2 * kp + 1, ch, VA, p.cv); } }
#pragma unroll
    for (int i = 0; i < 4; ++i) { const int ci = tid + 512 * i; if (ci < 224 * 8) *(LAS u32x4*)(KAl + (ci >> 3) * 72 + 8 * (ci & 7)) = kreg[i]; }
#pragma unroll
    for (int i = 0; i < 2; ++i) { const int ci = tid + 512 * i;
        if (ci < 112 * 8) { const int kp = ci % 112, ch = ci / 112; const u32x4 a = va[i], b = vb[i];
            LAS unsigned* d = VAd + (8 * ch) * 116 + kp;
            d[0 * 116] = (a.x & 0xffffu) | (b.x << 16); d[1 * 116] = (a.x >> 16) | (b.x & 0xffff0000u);
            d[2 * 116] = (a.y & 0xffffu) | (b.y << 16); d[3 * 116] = (a.y >> 16) | (b.y & 0xffff0000u);
            d[4 * 116] = (a.z & 0xffffu) | (b.z << 16); d[5 * 116] = (a.z >> 16) | (b.z & 0xffff0000u);
            d[6 * 116] = (a.w & 0xffffu) | (b.w << 16); d[7 * 116] = (a.w >> 16) | (b.w & 0xffff0000u); } }
    __syncthreads();
    for (int pr = 0; pr < npair; ++pr) {
        const int tA = 2 * pr, tB = kind == 0 ? 2 * pr + 1 : 0;
        const size_t rowA = (size_t)(qrow0 + 16 * tA + lr) * 256 + (size_t)(hq >> 2) * UT + (hq & 3) * 64, rowB = (size_t)(qrow0 + 16 * tB + lr) * 256 + (size_t)(hq >> 2) * UT + (hq & 3) * 64;
        constexpr size_t ZOFF = (size_t)(ZA >> 8) * UT;
        bf16x8 qa[2], qb[2]; u32x2 za[4], zb[4];
#pragma unroll
        for (int ks = 0; ks < 2; ++ks) { qa[ks] = *(const bf16x8*)(U + rowA + 32 * ks + 8 * q); qb[ks] = *(const bf16x8*)(U + rowB + 32 * ks + 8 * q); }
#pragma unroll
        for (int dt = 0; dt < 4; ++dt) { za[dt] = *(const u32x2*)(U + rowA + ZOFF + 16 * dt + 4 * q); zb[dt] = *(const u32x2*)(U + rowB + ZOFF + 16 * dt + 4 * q); }
        f32x4 accA[14], accB[14];
        float mxA = -1e30f, mxB = -1e30f;
#pragma unroll
        for (int kt = 0; kt < 14; ++kt) {
            if (kt == 0 || (kt >= lo_t && kt < hi_t)) {
                accA[kt] = (f32x4){0.f, 0.f, 0.f, 0.f}; accB[kt] = accA[kt];
#pragma unroll
                for (int ks = 0; ks < 2; ++ks) { const bf16x8 a = *(const LAS bf16x8*)(KAl + (16 * kt + lr) * 72 + 32 * ks + 8 * q); accA[kt] = MFMA16(a, qa[ks], accA[kt]); accB[kt] = MFMA16(a, qb[ks], accB[kt]); }
                mxA = fmaxf(mxA, fmaxf(fmaxf(accA[kt][0], accA[kt][1]), fmaxf(accA[kt][2], accA[kt][3])));
                mxB = fmaxf(mxB, fmaxf(fmaxf(accB[kt][0], accB[kt][1]), fmaxf(accB[kt][2], accB[kt][3])));
            } else { accA[kt] = (f32x4){-1e30f, -1e30f, -1e30f, -1e30f}; accB[kt] = accA[kt]; }
        }
        mxA = fmaxf(mxA, __shfl_xor(mxA, 16)); mxA = fmaxf(mxA, __shfl_xor(mxA, 32)); mxB = fmaxf(mxB, __shfl_xor(mxB, 16)); mxB = fmaxf(mxB, __shfl_xor(mxB, 32));
        const float MA = fmaxf(mxA, sink), MB = fmaxf(mxB, sink); float sumA = 0.f, sumB = 0.f;
#pragma unroll
        for (int kt = 0; kt < 14; ++kt)
#pragma unroll
            for (int j = 0; j < 4; ++j) { const float ea = __builtin_amdgcn_exp2f(accA[kt][j] - MA), eb = __builtin_amdgcn_exp2f(accB[kt][j] - MB); accA[kt][j] = ea; accB[kt][j] = eb; sumA += ea; sumB += eb; }
        sumA += __shfl_xor(sumA, 16); sumA += __shfl_xor(sumA, 32); sumB += __shfl_xor(sumB, 16); sumB += __shfl_xor(sumB, 32);
        const float invA = 1.0f / (sumA + __builtin_amdgcn_exp2f(sink - MA)), invB = 1.0f / (sumB + __builtin_amdgcn_exp2f(sink - MB));
        bf16x8 pA[7], pB[7];
#pragma unroll
        for (int u = 0; u < 7; ++u) { u32x4 w; w.x = pk2(accA[2 * u][0], accA[2 * u][1]); w.y = pk2(accA[2 * u][2], accA[2 * u][3]);
            w.z = pk2(accA[2 * u + 1][0], accA[2 * u + 1][1]); w.w = pk2(accA[2 * u + 1][2], accA[2 * u + 1][3]); pA[u] = __builtin_bit_cast(bf16x8, w);
            w.x = pk2(accB[2 * u][0], accB[2 * u][1]); w.y = pk2(accB[2 * u][2], accB[2 * u][3]);
            w.z = pk2(accB[2 * u + 1][0], accB[2 * u + 1][1]); w.w = pk2(accB[2 * u + 1][2], accB[2 * u + 1][3]); pB[u] = __builtin_bit_cast(bf16x8, w); }
        f32x4 oA[4], oB[4];
#pragma unroll
        for (int dt = 0; dt < 4; ++dt) { oA[dt] = (f32x4){0.f, 0.f, 0.f, 0.f}; oB[dt] = oA[dt];
#pragma unroll
            for (int u = 0; u < 7; ++u) { const LAS bf16_t* vp = VAl + (16 * dt + lr) * 232 + 32 * u + 4 * q;
                const s16x4 lo = *(const LAS s16x4*)vp, hi = *(const LAS s16x4*)(vp + 16);
                const bf16x8 a = __builtin_shufflevector(lo, hi, 0, 1, 2, 3, 4, 5, 6, 7); oA[dt] = MFMA16(a, pA[u], oA[dt]); oB[dt] = MFMA16(a, pB[u], oB[dt]); } }
#pragma unroll
        for (int dt = 0; dt < 4; ++dt) { const int col = hq * 64 + 16 * dt + 4 * q;
            { const u32x2 z = za[dt]; u32x2 w; w.x = pk2(oA[dt][0] * invA * siluf_(bflo(z.x)), oA[dt][1] * invA * siluf_(bfhi(z.x))); w.y = pk2(oA[dt][2] * invA * siluf_(bflo(z.y)), oA[dt][3] * invA * siluf_(bfhi(z.y)));
              if (dry) *(u32x2*)((bf16_t*)(p.ws + WS_XN) + (size_t)(qrow0 + 16 * tA + lr) * DM + col) = w; else *(u32x2*)(U + rowA + 16 * dt + 4 * q) = w; }
            if (kind == 0) { const u32x2 z = zb[dt]; u32x2 w; w.x = pk2(oB[dt][0] * invB * siluf_(bflo(z.x)), oB[dt][1] * invB * siluf_(bfhi(z.x))); w.y = pk2(oB[dt][2] * invB * siluf_(bflo(z.y)), oB[dt][3] * invB * siluf_(bfhi(z.y)));
              if (dry) *(u32x2*)((bf16_t*)(p.ws + WS_XN) + (size_t)(qrow0 + 16 * tB + lr) * DM + col) = w; else *(u32x2*)(U + rowB + 16 * dt + 4 * q) = w; } }
    }
    __syncthreads();
}

constexpr int ML_T2 = 69632, ML_SC = 104448;
DI void mlstm_vt_load(const bf16_t* U, int R0, int h, int tid, u32x4 (&a)[4], u32x4 (&b)[4]) {
#pragma unroll
    for (int it = 0; it < 4; ++it) { const int ci = tid + 512 * it, sp = ci & 63, ch = ci >> 6;
        const bf16_t* s = U + uoff(R0 + 2 * sp, VM + h * 256 + 8 * ch); a[it] = *(const u32x4*)s; b[it] = *(const u32x4*)(s + 256); }
}
DI void mlstm_vt_store(LAS unsigned char* lds, int tid, const u32x4 (&av)[4], const u32x4 (&bv)[4]) {
    LAS unsigned* VTd = (LAS unsigned*)lds;
#pragma unroll
    for (int it = 0; it < 4; ++it) { const int ci = tid + 512 * it, sp = ci & 63, ch = ci >> 6; const u32x4 a = av[it], b = bv[it];
        LAS unsigned* d = VTd + (8 * ch) * 68 + sp;
        d[0 * 68] = (a.x & 0xffffu) | (b.x << 16); d[1 * 68] = (a.x >> 16) | (b.x & 0xffff0000u);
        d[2 * 68] = (a.y & 0xffffu) | (b.y << 16); d[3 * 68] = (a.y >> 16) | (b.y & 0xffff0000u);
        d[4 * 68] = (a.z & 0xffffu) | (b.z << 16); d[5 * 68] = (a.z >> 16) | (b.z & 0xffff0000u);
        d[6 * 68] = (a.w & 0xffffu) | (b.w << 16); d[7 * 68] = (a.w >> 16) | (b.w & 0xffff0000u); }
}

DI void mlstm_sum_item(const Params& p, LAS unsigned char* lds, int h, int j) {
    int tid_ = threadIdx.x; asm volatile("" : "+v"(tid_)); const int tid = tid_, lane = tid & 63, wave = tid >> 6, lr = lane & 15, q = lane >> 4;
    const bf16_t* U = (const bf16_t*)(p.ws + WS_U); const float* GATE = (const float*)(p.ws + WS_GATE);
    LAS float* wS = (LAS float*)(lds + ML_SC);
    const int R0 = 128 * j;
    u32x4 vta[4], vtb[4], ka[2], kb[2];
    mlstm_vt_load(U, R0, h, tid, vta, vtb);
#pragma unroll
    for (int it = 0; it < 2; ++it) { const int ci = tid + 512 * it, sp = ci & 63, ch = ci >> 6;
        const bf16_t* s = U + uoff(R0 + 2 * sp, KM + h * 128 + 8 * ch); ka[it] = *(const u32x4*)s; kb[it] = *(const u32x4*)(s + 256); }
    if (wave == 0) {
        const float bi = p.bi[h], bfb = p.bf[h];
        const float gi0 = GATE[(size_t)(R0 + lane) * 16 + h] + bi, gi1 = GATE[(size_t)(R0 + 64 + lane) * 16 + h] + bi;
        const float lf0 = logsigmoidf_(GATE[(size_t)(R0 + lane) * 16 + 8 + h] + bfb), lf1 = logsigmoidf_(GATE[(size_t)(R0 + 64 + lane) * 16 + 8 + h] + bfb);
        const float c0 = scan_add(lf0, lane); const float tot0 = __shfl(c0, 63); const float c1 = scan_add(lf1, lane) + tot0; const float blast = __shfl(c1, 63);
        const float x0 = blast - c0 + gi0, x1 = blast - c1 + gi1; const float ml = wmax(fmaxf(x0, x1));
        wS[lane] = __expf(x0 - ml); wS[64 + lane] = __expf(x1 - ml);
        if (lane == 0) { ((float*)(p.ws + WS_BS))[h * NCH + j] = blast; ((float*)(p.ws + WS_ML))[h * NCH + j] = ml; }
    }
    mlstm_vt_store(lds, tid, vta, vtb);
    __syncthreads();
    {
        LAS unsigned* KTd = (LAS unsigned*)(lds + ML_T2);
#pragma unroll
        for (int it = 0; it < 2; ++it) { const int ci = tid + 512 * it, sp = ci & 63, ch = ci >> 6;
            const u32x4 a = ka[it], b = kb[it]; const float w0 = wS[2 * sp], w1 = wS[2 * sp + 1];
            LAS unsigned* d = KTd + (8 * ch) * 68 + sp;
            d[0 * 68] = pk2(bflo(a.x) * w0, bflo(b.x) * w1); d[1 * 68] = pk2(bfhi(a.x) * w0, bfhi(b.x) * w1);
            d[2 * 68] = pk2(bflo(a.y) * w0, bflo(b.y) * w1); d[3 * 68] = pk2(bfhi(a.y) * w0, bfhi(b.y) * w1);
            d[4 * 68] = pk2(bflo(a.z) * w0, bflo(b.z) * w1); d[5 * 68] = pk2(bfhi(a.z) * w0, bfhi(b.z) * w1);
            d[6 * 68] = pk2(bflo(a.w) * w0, bflo(b.w) * w1); d[7 * 68] = pk2(bfhi(a.w) * w0, bfhi(b.w) * w1); }
    }
    __syncthreads();
    const LAS bf16_t* VT = (const LAS bf16_t*)lds; const LAS bf16_t* KT = (const LAS bf16_t*)(lds + ML_T2);
    if (tid < 128) {
        float s = 0.f;
#pragma unroll 4
        for (int c = 0; c < 16; ++c) { const u32x4 w = *(const LAS u32x4*)(KT + tid * 136 + 8 * c);
            s += (bflo(w.x) + bfhi(w.x)) + (bflo(w.y) + bfhi(w.y)) + (bflo(w.z) + bfhi(w.z)) + (bflo(w.w) + bfhi(w.w)); }
        ((float*)(p.ws + WS_NP))[(size_t)(h * NCH + j) * 128 + tid] = s;
    }
    f32x4 acc[2][8];
#pragma unroll
    for (int i = 0; i < 2; ++i)
#pragma unroll
        for (int dt = 0; dt < 8; ++dt) acc[i][dt] = (f32x4){0.f, 0.f, 0.f, 0.f};
#pragma unroll
    for (int ks = 0; ks < 4; ++ks) {
        bf16x8 a[2];
#pragma unroll
        for (int i = 0; i < 2; ++i) a[i] = *(const LAS bf16x8*)(VT + (16 * (2 * wave + i) + lr) * 136 + 32 * ks + 8 * q);
#pragma unroll
        for (int dt = 0; dt < 8; ++dt) { const bf16x8 b = *(const LAS bf16x8*)(KT + (16 * dt + lr) * 136 + 32 * ks + 8 * q);
#pragma unroll
            for (int i = 0; i < 2; ++i) acc[i][dt] = MFMA16(a[i], b, acc[i][dt]); }
    }
    float* UP = (float*)(p.ws + WS_UP) + (size_t)(h * NCH + j) * 256 * 128;
#pragma unroll
    for (int i = 0; i < 2; ++i)
#pragma unroll
        for (int dt = 0; dt < 8; ++dt)
#pragma unroll
            for (int jj = 0; jj < 4; ++jj) UP[(size_t)(16 * (2 * wave + i) + 4 * q + jj) * 128 + 16 * dt + lr] = acc[i][dt][jj];
    __syncthreads();
}

DI void mlstm_small_item(const Params& p, LAS unsigned char* lds, int b, int h, int dry) {
    int tid_ = threadIdx.x; asm volatile("" : "+v"(tid_)); const int tid = tid_, lane = tid & 63, wave = tid >> 6;
    bf16_t* U = (bf16_t*)(p.ws + WS_U); const float* GATE = (const float*)(p.ws + WS_GATE);
    const bool meta = (b == 16); const int R0 = meta ? ROW_M : ROW_S + 16 * b;
    LAS float* qT = (LAS float*)lds; LAS float* kwT = (LAS float*)(lds + 8192); LAS float* kS = (LAS float*)(lds + 16384);
    LAS float* Wm = (LAS float*)(lds + 24832); LAS float* sc = (LAS float*)(lds + 25856); LAS float* red = (LAS float*)(lds + 26624);
    LAS float* am = sc, *cm = sc + 16, *bb = sc + 32, *wsS = sc + 48, *misc = sc + 64, *qnS = sc + 80;
    const float* Cin = p.sC + (size_t)(b * 8 + h) * 128 * 256; const float* nin = p.sn + (size_t)(b * 8 + h) * 128;
    float* Cout = meta ? (float*)(p.ws + WS_C0) + (size_t)h * 128 * 256 : p.out + O_CS + (size_t)(b * 8 + h) * 128 * 256;
    float* nout = meta ? (float*)(p.ws + WS_N0) + h * 128 : p.out + O_NS + (size_t)(b * 8 + h) * 128;
#pragma unroll
    for (int i = 0; i < 4; ++i) { const int idx = tid + 512 * i, t = idx >> 7, d = idx & 127;
        qT[d * 16 + t] = bf2f(U[uoff(R0 + t, QM + h * 128 + d)]); kS[t * 132 + d] = bf2f(U[uoff(R0 + t, KM + h * 128 + d)]); }
    if (wave == 0) {
        const bool act = lane < 16; const int tl = act ? lane : 15;
        const float gi = GATE[(size_t)(R0 + tl) * 16 + h] + p.bi[h];
        const float lf = act ? logsigmoidf_(GATE[(size_t)(R0 + tl) * 16 + 8 + h] + p.bf[h]) : 0.f;
        const float c = scan_add(lf, lane); const float a = act ? gi - c : -3e38f; const float pm = scan_max(a, lane);
        const float mprev = meta ? 0.f : p.sm[b * 8 + h]; const float cmv = fmaxf(mprev, pm);
        const float b15 = __shfl(c, 15), cm15 = __shfl(cmv, 15); const float mnew = b15 + cm15;
        if (act) { am[lane] = a; cm[lane] = cmv; bb[lane] = c; wsS[lane] = __expf(b15 + a - mnew); }
        if (lane == 0) { misc[0] = __expf(b15 + mprev - mnew); misc[1] = mnew; misc[2] = mprev;
            if (meta) ((float*)(p.ws + WS_M0))[h] = mnew; else p.out[O_MS + b * 8 + h] = mnew; }
    }
    __syncthreads();
#pragma unroll
    for (int i = 0; i < 4; ++i) { const int idx = tid + 512 * i, s = idx >> 7, d = idx & 127; kwT[d * 16 + s] = kS[s * 132 + d] * wsS[s]; }
    if (tid < 256) { const int t = tid >> 4, s = tid & 15; float dot = 0.f;
        for (int d = 0; d < 128; ++d) dot += qT[d * 16 + t] * kS[s * 132 + d];
        Wm[t * 16 + s] = (s <= t) ? dot * __expf(am[s] - cm[t]) : 0.f;
    } else if (tid < 272) { const int t = tid - 256; float dot = 0.f;
        if (!meta) for (int d = 0; d < 128; ++d) dot += qT[d * 16 + t] * nin[d];
        qnS[t] = dot; }
    __syncthreads();
    const int e = tid & 255, dh = tid >> 8;
    float v[16];
#pragma unroll
    for (int s = 0; s < 16; ++s) v[s] = bf2f(U[uoff(R0 + s, VM + h * 256 + e)]);
    float acc[16];
#pragma unroll
    for (int t = 0; t < 16; ++t) acc[t] = 0.f;
    const float alast = misc[0], mprev = misc[2];
    for (int d0 = dh * 64; d0 < dh * 64 + 64; d0 += 16) {
        float cb[16];
#pragma unroll
        for (int dd = 0; dd < 16; ++dd) cb[dd] = meta ? 0.f : Cin[(size_t)(d0 + dd) * 256 + e];
#pragma unroll
        for (int dd = 0; dd < 16; ++dd) { const int d = d0 + dd; const float c = cb[dd];
            float cn = alast * c;
#pragma unroll
            for (int i = 0; i < 4; ++i) { const f32x4 q4 = *(const LAS f32x4*)(qT + d * 16 + 4 * i), k4 = *(const LAS f32x4*)(kwT + d * 16 + 4 * i);
#pragma unroll
                for (int jj = 0; jj < 4; ++jj) { acc[4 * i + jj] += q4[jj] * c; cn += k4[jj] * v[4 * i + jj]; } }
            Cout[(size_t)d * 256 + e] = cn; }
    }
#pragma unroll
    for (int t = 0; t < 16; ++t) red[(dh * 16 + t) * 256 + e] = acc[t];
    if (tid < 128) { float nn = alast * (meta ? 0.f : nin[tid]);
#pragma unroll
        for (int s = 0; s < 16; ++s) nn += kwT[tid * 16 + s];
        nout[tid] = nn; }
    __syncthreads();
    if (!meta) {
#pragma unroll
        for (int tl = 0; tl < 8; ++tl) { const int t = dh * 8 + tl;
            const float inter = red[t * 256 + e] + red[(16 + t) * 256 + e]; const float sc_t = __expf(mprev - cm[t]);
            float num = sc_t * inter, den = sc_t * qnS[t];
#pragma unroll
            for (int s = 0; s < 16; ++s) { const float w = Wm[t * 16 + s]; num += w * v[s]; den += w; }
            const float mt = bb[t] + cm[t];
            red[t * 256 + e] = num / fmaxf(fabsf(den), __expf(-mt)); }
    }
    __syncthreads();
    if (!meta) {
#pragma unroll
        for (int r = 0; r < 2; ++r) { const int t = 2 * wave + r; float hv[4]; float ss = 0.f;
#pragma unroll
            for (int i = 0; i < 4; ++i) { hv[i] = red[t * 256 + lane + 64 * i]; ss += hv[i] * hv[i]; }
            const float rstd = rsqrtf(wsum(ss) * (1.f / 256.f) + EPS);
#pragma unroll
            for (int i = 0; i < 4; ++i) { const int ee = lane + 64 * i; const size_t ro = (size_t)(R0 + t) * 256 + (size_t)h * UT + ee;
                const float o = bf2f(U[ro + (size_t)(OM >> 8) * UT]), z = bf2f(U[ro + (size_t)(ZM >> 8) * UT]);
                const float val = hv[i] * rstd * p.gmh[h * 256 + ee] * sigmoidf_(o) * siluf_(z);
                if (!dry) U[ro + (size_t)(OM >> 8) * UT] = (bf16_t)(pk2(val, 0.f) & 0xffffu); } }
    }
    __syncthreads();
}

DI void mlstm_scan(const Params& p) {
    const float* BS = (const float*)(p.ws + WS_BS); const float* MLv = (const float*)(p.ws + WS_ML); float* MS = (float*)(p.ws + WS_MS);
    const float* NPv = (const float*)(p.ws + WS_NP); float* NS = (float*)(p.ws + WS_NS);
    const float* C0 = (const float*)(p.ws + WS_C0); const float* N0 = (const float*)(p.ws + WS_N0); const float* M0 = (const float*)(p.ws + WS_M0);
    for (int gid = blockIdx.x * 512 + threadIdx.x; gid < 8 * 256 * 64; gid += gridDim.x * 512) {
        const int h = gid >> 14, e = (gid >> 6) & 255, d = 2 * (gid & 63);
        const bool isn = (e == 0);
        float m = M0[h];
        float cx = C0[((size_t)h * 128 + d) * 256 + e], cy = C0[((size_t)h * 128 + d + 1) * 256 + e];
        float nx = isn ? N0[h * 128 + d] : 0.f, ny = isn ? N0[h * 128 + d + 1] : 0.f;
        const float* UP = (const float*)(p.ws + WS_UP) + (size_t)h * NCH * 256 * 128 + (size_t)e * 128 + d;
        unsigned* CS = (unsigned*)((bf16_t*)(p.ws + WS_CST) + (size_t)h * NCH * 256 * 128 + (size_t)e * 128 + d);
        for (int k0 = 0; k0 < NCH; k0 += 8) {
            f32x2 u[8];
#pragma unroll
            for (int i = 0; i < 8; ++i) u[i] = *(const f32x2*)(UP + (size_t)(k0 + i) * 256 * 128);
#pragma unroll
            for (int i = 0; i < 8; ++i) { const int k = k0 + i;
                CS[(size_t)k * 256 * 64] = pk2(cx, cy);
                if (isn) { NS[(size_t)(h * NCH + k) * 128 + d] = nx; NS[(size_t)(h * NCH + k) * 128 + d + 1] = ny; if (d == 0) MS[h * NCH + k] = m; }
                const float bs = BS[h * NCH + k], ml = MLv[h * NCH + k]; const float mn = fmaxf(bs + m, ml);
                const float a = __expf(bs + m - mn), bsc = __expf(ml - mn);
                cx = a * cx + bsc * u[i][0]; cy = a * cy + bsc * u[i][1];
                if (isn) { nx = a * nx + bsc * NPv[(size_t)(h * NCH + k) * 128 + d]; ny = a * ny + bsc * NPv[(size_t)(h * NCH + k) * 128 + d + 1]; }
                m = mn; }
        }
        p.out[O_CP + ((size_t)h * 128 + d) * 256 + e] = cx; p.out[O_CP + ((size_t)h * 128 + d + 1) * 256 + e] = cy;
        if (isn) { p.out[O_NP + h * 128 + d] = nx; p.out[O_NP + h * 128 + d + 1] = ny; if (d == 0) p.out[O_MP + h] = m; }
    }
}

DI void mlstm_out_item(const Params& p, LAS unsigned char* lds, int h, int j, int dry) {
    int tid_ = threadIdx.x; asm volatile("" : "+v"(tid_)); const int tid = tid_, lane = tid & 63, wave = __builtin_amdgcn_readfirstlane(tid >> 6), lr = lane & 15, q = lane >> 4;
    bf16_t* U = (bf16_t*)(p.ws + WS_U); const float* GATE = (const float*)(p.ws + WS_GATE);
    LAS float* aS = (LAS float*)(lds + ML_SC), *cmS = aS + 128, *bS = aS + 256, *nK = aS + 384;
    const int R0 = 128 * j; const float mk = ((const float*)(p.ws + WS_MS))[h * NCH + j];
    u32x4 vta[4], vtb[4], kn[4];
    mlstm_vt_load(U, R0, h, tid, vta, vtb);
#pragma unroll
    for (int it = 0; it < 4; ++it) { const int ci = tid + 512 * it, row = ci >> 4, ch = ci & 15; kn[it] = *(const u32x4*)(U + uoff(R0 + row, KM + h * 128 + 8 * ch)); }
    const int t = 16 * wave + lr; const size_t rowoff = (size_t)(R0 + t) * 256;
    bf16x8 qf[4];
#pragma unroll
    for (int ks = 0; ks < 4; ++ks) qf[ks] = *(const bf16x8*)(U + rowoff + (size_t)((QM >> 8) + (h >> 1)) * UT + (h & 1) * 128 + 32 * ks + 8 * q);
    if (wave == 0) {
        const float bi = p.bi[h], bfb = p.bf[h];
        const float gi0 = GATE[(size_t)(R0 + lane) * 16 + h] + bi, gi1 = GATE[(size_t)(R0 + 64 + lane) * 16 + h] + bi;
        const float lf0 = logsigmoidf_(GATE[(size_t)(R0 + lane) * 16 + 8 + h] + bfb), lf1 = logsigmoidf_(GATE[(size_t)(R0 + 64 + lane) * 16 + 8 + h] + bfb);
        const float c0 = scan_add(lf0, lane); const float tot0 = __shfl(c0, 63); const float c1 = scan_add(lf1, lane) + tot0;
        const float a0 = gi0 - c0, a1 = gi1 - c1;
        const float p0 = scan_max(a0, lane); const float t0 = __shfl(p0, 63); const float p1 = fmaxf(scan_max(a1, lane), t0);
        aS[lane] = a0; aS[64 + lane] = a1; cmS[lane] = fmaxf(mk, p0); cmS[64 + lane] = fmaxf(mk, p1); bS[lane] = c0; bS[64 + lane] = c1;
    } else if (wave < 3) { const int d = tid - 64; nK[d] = ((const float*)(p.ws + WS_NS))[(size_t)(h * NCH + j) * 128 + d]; }
    mlstm_vt_store(lds, tid, vta, vtb);
    {
        LAS bf16_t* KNw = (LAS bf16_t*)(lds + ML_T2);
#pragma unroll
        for (int it = 0; it < 4; ++it) { const int ci = tid + 512 * it, row = ci >> 4, ch = ci & 15; *(LAS u32x4*)(KNw + row * 136 + 8 * ch) = kn[it]; }
    }
    __syncthreads();
    const LAS bf16_t* VT = (const LAS bf16_t*)lds; const LAS bf16_t* KN = (const LAS bf16_t*)(lds + ML_T2);
    const float cmt = cmS[t], bt = bS[t]; const float scale = __expf(mk - cmt), flo = __expf(-(bt + cmt));
    float qn = 0.f;
#pragma unroll
    for (int ks = 0; ks < 4; ++ks)
#pragma unroll
        for (int i = 0; i < 8; ++i) qn += bf2f((unsigned short)qf[ks][i]) * nK[32 * ks + 8 * q + i];
    qn += __shfl_xor(qn, 16); qn += __shfl_xor(qn, 32);
    f32x4 acc[16];
    const bf16_t* CS = (const bf16_t*)(p.ws + WS_CST) + (size_t)(h * NCH + j) * 256 * 128;
#pragma unroll
    for (int et = 0; et < 16; ++et) acc[et] = (f32x4){0.f, 0.f, 0.f, 0.f};
#pragma unroll
    for (int ks = 0; ks < 4; ++ks)
#pragma unroll
        for (int eh = 0; eh < 2; ++eh) {
            bf16x8 ca[8];
#pragma unroll
            for (int et = 0; et < 8; ++et) ca[et] = *(const bf16x8*)(CS + (size_t)(16 * (8 * eh + et) + lr) * 128 + 32 * ks + 8 * q);
#pragma unroll
            for (int et = 0; et < 8; ++et) acc[8 * eh + et] = MFMA16(ca[et], qf[ks], acc[8 * eh + et]);
        }
#pragma unroll
    for (int et = 0; et < 16; ++et) acc[et] = acc[et] * scale;
    asm volatile("" ::: "memory");
    float dsum = 0.f; bf16x8 wf[4];
#pragma unroll
    for (int u = 0; u < 4; ++u) {
        u32x4 w = (u32x4){0u, 0u, 0u, 0u};
#pragma unroll
        for (int hh = 0; hh < 2; ++hh) { const int st = 2 * u + hh;
            if (st <= wave) {
                f32x4 s4 = (f32x4){0.f, 0.f, 0.f, 0.f};
#pragma unroll
                for (int ks = 0; ks < 4; ++ks) { const bf16x8 a = *(const LAS bf16x8*)(KN + (16 * st + lr) * 136 + 32 * ks + 8 * q); s4 = MFMA16(a, qf[ks], s4); }
                float wv[4];
#pragma unroll
                for (int jj = 0; jj < 4; ++jj) { const int s = 16 * st + 4 * q + jj; const float wg = (s <= t) ? __expf(aS[s] - cmt) : 0.f; wv[jj] = s4[jj] * wg; dsum += wv[jj]; }
                if (hh == 0) { w.x = pk2(wv[0], wv[1]); w.y = pk2(wv[2], wv[3]); } else { w.z = pk2(wv[0], wv[1]); w.w = pk2(wv[2], wv[3]); }
            } }
        wf[u] = __builtin_bit_cast(bf16x8, w);
    }
#pragma unroll
    for (int u = 0; u < 4; ++u) {
        if (2 * u <= wave) {
#pragma unroll
            for (int et = 0; et < 16; ++et) { const LAS bf16_t* vp = VT + (16 * et + lr) * 136 + 32 * u + 4 * q;
                const s16x4 lo = *(const LAS s16x4*)vp, hi = *(const LAS s16x4*)(vp + 16);
                acc[et] = MFMA16(__builtin_shufflevector(lo, hi, 0, 1, 2, 3, 4, 5, 6, 7), wf[u], acc[et]); } }
    }
    asm volatile("" ::: "memory");
    dsum += __shfl_xor(dsum, 16); dsum += __shfl_xor(dsum, 32);
    const float den = scale * qn + dsum; const float inv = 1.0f / fmaxf(fabsf(den), flo);
    float ss = 0.f;
#pragma unroll
    for (int et = 0; et < 16; ++et) { acc[et] = acc[et] * inv; ss += (acc[et][0] * acc[et][0] + acc[et][1] * acc[et][1]) + (acc[et][2] * acc[et][2] + acc[et][3] * acc[et][3]); }
    ss += __shfl_xor(ss, 16); ss += __shfl_xor(ss, 32);
    const float rstd = rsqrtf(ss * (1.f / 256.f) + EPS);
#pragma unroll
    for (int et = 0; et < 16; ++et) { const int e = 16 * et + 4 * q; bf16_t* op = U + rowoff + (size_t)((OM >> 8) + h) * UT + e;
        const u32x2 o = *(const u32x2*)op, z = *(const u32x2*)(U + rowoff + (size_t)((ZM >> 8) + h) * UT + e); const f32x4 g = *(const f32x4*)(p.gmh + h * 256 + e);
        u32x2 w; w.x = pk2(acc[et][0] * rstd * g[0] * sigmoidf_(bflo(o.x)) * siluf_(bflo(z.x)), acc[et][1] * rstd * g[1] * sigmoidf_(bfhi(o.x)) * siluf_(bfhi(z.x)));
        w.y = pk2(acc[et][2] * rstd * g[2] * sigmoidf_(bflo(o.y)) * siluf_(bflo(z.y)), acc[et][3] * rstd * g[3] * sigmoidf_(bfhi(o.y)) * siluf_(bfhi(z.y)));
        if (dry) *(u32x2*)((bf16_t*)(p.ws + WS_XN) + (size_t)(R0 + t) * DM + h * 256 + e) = w; else *(u32x2*)op = w; }
    __syncthreads();
}

DI void skinny_core(f32x4 (&acc)[2][4], const bf16_t* A, size_t lda, size_t wstride, const bf16_t* Bt, int row0, int col0, int wave, int lr, int q) {
    const bf16_t* ap = A + (size_t)(row0 + lr) * lda + wstride * wave + 8 * q;
    const bf16_t* bp = Bt + (size_t)(col0 + lr) * 2048 + 256 * wave + 8 * q;
#pragma unroll 4
    for (int ks = 0; ks < 8; ++ks) {
        bf16x8 a[2], b[4];
#pragma unroll
        for (int rt = 0; rt < 2; ++rt) a[rt] = *(const bf16x8*)(ap + (size_t)rt * 16 * lda + 32 * ks);
#pragma unroll
        for (int ct = 0; ct < 4; ++ct) b[ct] = *(const bf16x8*)(bp + (size_t)ct * 16 * 2048 + 32 * ks);
#pragma unroll
        for (int rt = 0; rt < 2; ++rt)
#pragma unroll
            for (int ct = 0; ct < 4; ++ct) acc[rt][ct] = MFMA16(b[ct], a[rt], acc[rt][ct]);
    }
}
DI void skinny_put(LAS float* red, const f32x4 (&acc)[2][4], int slot, int lr, int q) {
#pragma unroll
    for (int rt = 0; rt < 2; ++rt)
#pragma unroll
        for (int ct = 0; ct < 4; ++ct) *(LAS f32x4*)(red + ((size_t)slot * 32 + 16 * rt + lr) * 64 + 16 * ct + 4 * q) = acc[rt][ct];
}
DI void skinny_merge(const Params& p, LAS unsigned char* lds) {
    const int tid = threadIdx.x, lane = tid & 63, wave = tid >> 6, lr = lane & 15, q = lane >> 4;
    const bf16_t* U = (const bf16_t*)(p.ws + WS_U); const bf16_t* WP = (const bf16_t*)(p.ws + WS_WP); bf16_t* MG = (bf16_t*)(p.ws + WS_XN);
    LAS float* red = (LAS float*)lds;
    for (int tile = blockIdx.x; tile < 256; tile += gridDim.x) {
        const int row0 = ROW_S + 32 * (tile >> 5), col0 = 64 * (tile & 31);
        f32x4 aa[2][4], am[2][4];
#pragma unroll
        for (int rt = 0; rt < 2; ++rt)
#pragma unroll
            for (int ct = 0; ct < 4; ++ct) { aa[rt][ct] = (f32x4){0.f, 0.f, 0.f, 0.f}; am[rt][ct] = (f32x4){0.f, 0.f, 0.f, 0.f}; }
        skinny_core(aa, U + (size_t)(QA >> 8) * UT, 256, UT, WP, row0, col0, wave, lr, q);
        skinny_core(am, U + (size_t)(OM >> 8) * UT, 256, UT, WP + (size_t)2048 * 2048, row0, col0, wave, lr, q);
        skinny_put(red, aa, wave * 2, lr, q); skinny_put(red, am, wave * 2 + 1, lr, q);
        __syncthreads();
        const int row = tid >> 4, c4 = (tid & 15) * 4;
        f32x4 ya = (f32x4){0.f, 0.f, 0.f, 0.f}, ym = ya;
#pragma unroll
        for (int w = 0; w < 8; ++w) { ya += *(const LAS f32x4*)(red + ((size_t)(2 * w) * 32 + row) * 64 + c4); ym += *(const LAS f32x4*)(red + ((size_t)(2 * w + 1) * 32 + row) * 64 + c4); }
        const size_t r = row0 + row; const int col = col0 + c4;
        const u32x2 ga = *(const u32x2*)(U + uoff((int)r, GA + col)), gm = *(const u32x2*)(U + uoff((int)r, GM + col));
        u32x2 w; w.x = pk2(sigmoidf_(bflo(ga.x)) * ya[0] + sigmoidf_(bflo(gm.x)) * ym[0], sigmoidf_(bfhi(ga.x)) * ya[1] + sigmoidf_(bfhi(gm.x)) * ym[1]);
        w.y = pk2(sigmoidf_(bflo(ga.y)) * ya[2] + sigmoidf_(bflo(gm.y)) * ym[2], sigmoidf_(bfhi(ga.y)) * ya[3] + sigmoidf_(bfhi(gm.y)) * ym[3]);
        *(u32x2*)(MG + r * DM + col) = w;
        __syncthreads();
    }
}
DI void skinny_out(const Params& p, LAS unsigned char* lds) {
    const int tid = threadIdx.x, lane = tid & 63, wave = tid >> 6, lr = lane & 15, q = lane >> 4;
    const bf16_t* MG = (const bf16_t*)(p.ws + WS_XN); const bf16_t* WO = (const bf16_t*)(p.ws + WS_WOUT); float* ssq = (float*)(p.ws + WS_SSQ);
    unsigned* cnt = (unsigned*)(p.ws + WS_CNT) + 16 * 32;
    LAS float* red = (LAS float*)lds;
    for (int tile = blockIdx.x; tile < 256; tile += gridDim.x) {
        const int row0 = ROW_S + 32 * (tile >> 5), col0 = 64 * (tile & 31);
        f32x4 aa[2][4];
#pragma unroll
        for (int rt = 0; rt < 2; ++rt)
#pragma unroll
            for (int ct = 0; ct < 4; ++ct) aa[rt][ct] = (f32x4){0.f, 0.f, 0.f, 0.f};
        skinny_core(aa, MG, DM, 256, WO, row0, col0, wave, lr, q);
        skinny_put(red, aa, wave, lr, q);
        __syncthreads();
        const int row = tid >> 4, c4 = (tid & 15) * 4;
        f32x4 y = (f32x4){0.f, 0.f, 0.f, 0.f};
#pragma unroll
        for (int w = 0; w < 8; ++w) y += *(const LAS f32x4*)(red + ((size_t)w * 32 + row) * 64 + c4);
        const size_t r = row0 + row; const int col = col0 + c4;
        const f32x4 o = *(const f32x4*)(p.xs + (r - ROW_S) * DM + col) + y;
        float ss = (o[0] * o[0] + o[1] * o[1]) + (o[2] * o[2] + o[3] * o[3]);
        ss += __shfl_xor(ss, 1); ss += __shfl_xor(ss, 2); ss += __shfl_xor(ss, 4); ss += __shfl_xor(ss, 8);
        if ((tid & 15) == 0) __hip_atomic_store(ssq + r * 32 + (tile & 31), ss, __ATOMIC_RELAXED, __HIP_MEMORY_SCOPE_AGENT);
        asm volatile("s_waitcnt vmcnt(0)" ::: "memory");
        unsigned* c = cnt + 16 * (tile >> 5);
        if (lane == 0) __hip_atomic_fetch_add(c, 1u, __ATOMIC_RELAXED, __HIP_MEMORY_SCOPE_AGENT);
        { unsigned sp = 0; while ((unsigned)__builtin_amdgcn_readfirstlane(__hip_atomic_load(c, __ATOMIC_RELAXED, __HIP_MEMORY_SCOPE_AGENT)) < 256u) { __builtin_amdgcn_s_sleep(1); if (++sp > (1u << 22)) break; } }
        __builtin_amdgcn_fence(__ATOMIC_ACQUIRE, "agent");
        asm volatile("s_waitcnt vmcnt(0)" ::: "memory");
        const f32x2 pp = *(const f32x2*)(ssq + r * 32 + 2 * (tid & 15));
        float tot = pp[0] + pp[1];
        tot += __shfl_xor(tot, 1); tot += __shfl_xor(tot, 2); tot += __shfl_xor(tot, 4); tot += __shfl_xor(tot, 8);
        const float rstd = rsqrtf(tot * (1.f / DM) + EPS);
        f32x4 yo = o * rstd; yo = yo * *(const f32x4*)(p.gfinal + col);
        *(f32x4*)(p.out + r * DM + col) = yo;
        __syncthreads();
    }
}

DI void final_norm(const Params& p) {
    const int lane = threadIdx.x & 63, gw = blockIdx.x * 8 + (threadIdx.x >> 6), NGW = gridDim.x * 8;
    const float* ssq = (const float*)(p.ws + WS_SSQ);
    for (int r = gw; r < MOUT; r += NGW) {
        const float s = wsum(lane < 32 ? ssq[(size_t)r * 32 + lane] : 0.f);
        const float rstd = rsqrtf(s * (1.f / DM) + EPS);
        f32x4* o = (f32x4*)(p.out + (size_t)r * DM) + lane; const f32x4* g = (const f32x4*)p.gfinal + lane;
#pragma unroll
        for (int j = 0; j < 8; ++j) { f32x4 v = o[64 * j]; const f32x4 gg = g[64 * j]; v = v * rstd; v = v * gg; o[64 * j] = v; }
    }
}

__global__ void __launch_bounds__(512, 2) mega(Params p) {
    extern __shared__ __attribute__((aligned(16))) unsigned char lds_raw[];
    LAS unsigned char* lds = (LAS unsigned char*)lds_raw;
    cg::grid_group grid = cg::this_grid();
    const int lo = p.ph_lo, hi = p.ph_hi;
#define IN(k) (lo <= (k) && (k) < hi)
#define SEAM(k) do { if (IN(k) && IN((k) + 1)) xcd_barrier(bar); } while (0)
    volatile LAS unsigned* bst = (volatile LAS unsigned*)(lds + 131072 + 1024);
    if (threadIdx.x < 2) bst[threadIdx.x] = 0u;
    __syncthreads();
    XcdBarrier bar = xcd_barrier_post((unsigned*)(p.ws + WS_BAR), bst);
    if (hi > 1000) grid.sync();
    bf16_t* U = (bf16_t*)(p.ws + WS_U);
    if (IN(0)) for (int rep = 0; rep < REP0; ++rep) p0_prologue(p, lds);
    SEAM(0);
    if (IN(1)) for (int rep = 0; rep < REP1; ++rep) {
        pg8::Order S; S.init(MPAD / 256, NW / 256, gridDim.x, blockIdx.x, 0);
        S.A0 = S.A1 = (const char*)(p.ws + WS_XN); S.B0 = S.B1 = (const char*)(p.ws + WS_WIN); S.a_tstep = (size_t)256 * DM * 2; S.b_tstep = (size_t)256 * 2048 * 2;
        pg8::EpiU E{U, (float*)(p.ws + WS_GATE), p.out};
        pg8::gemm_phase<pg8::EpiU>(lds, 2048, DM, 512, S, E);
    }
    SEAM(1);
    if (IN(2)) {
        for (int rep = 0; rep < REP2; ++rep) { const int dry = rep + 1 < REP2;
        for (int it = blockIdx.x; it < 1224; it += gridDim.x) {
            if (it < 512) { if (!dry || (PSEL & 1)) attn_item(p, lds, 0, it >> 2, it & 3, dry); }
            else if (it < 576) { if (!dry || (PSEL & 1)) attn_item(p, lds, 1, (it - 512) >> 2, (it - 512) & 3, dry); }
            else if (it < 1088) { if (!dry || (PSEL & 2)) mlstm_sum_item(p, lds, (it - 576) & 7, (it - 576) >> 3); }
            else { if (!dry || (PSEL & 4)) mlstm_small_item(p, lds, (it - 1088) >> 3, (it - 1088) & 7, dry); }
        } }
    }
    SEAM(2);
    if (IN(3)) for (int rep = 0; rep < REP3; ++rep) mlstm_scan(p);
    for (int rep = 0; rep < REPSYNC; ++rep) xcd_barrier(bar);
    SEAM(3);
    if (IN(4)) for (int rep = 0; rep < REP4; ++rep) { for (int it = blockIdx.x; it < 512; it += gridDim.x) mlstm_out_item(p, lds, it & 7, it >> 3, rep + 1 < REP4); }
    SEAM(4);
    if (IN(5)) for (int rep = 0; rep < REP56; ++rep) {
        pg8::Order S; S.init(ROW_S / 256, DM / 256, gridDim.x, blockIdx.x, 1);
        S.A0 = (const char*)(U + (size_t)(QA >> 8) * UT); S.A1 = (const char*)(U + (size_t)(OM >> 8) * UT); S.B0 = (const char*)(p.ws + WS_WP); S.B1 = S.B0 + (size_t)2048 * 2048 * 2;
        S.a_tstep = (size_t)256 * 256 * 2; S.b_tstep = (size_t)256 * 2048 * 2;
        pg8::EpiMerge E{U, (bf16_t*)(p.ws + WS_XN)};
        pg8::gemm_phase<pg8::EpiMerge>(lds, 2048, 256, UT * 2, S, E);
        skinny_merge(p, lds);
    }
    SEAM(5);
    if (IN(6)) for (int rep = 0; rep < REP56; ++rep) {
        pg8::Order S; S.init(ROW_S / 256, DM / 256, gridDim.x, blockIdx.x, 0);
        S.A0 = S.A1 = (const char*)(p.ws + WS_XN); S.B0 = S.B1 = (const char*)(p.ws + WS_WOUT); S.a_tstep = (size_t)256 * DM * 2; S.b_tstep = (size_t)256 * 2048 * 2;
        pg8::EpiOut E{p.xp, p.gfinal, p.out, (float*)(p.ws + WS_SSQ), (unsigned*)(p.ws + WS_CNT)};
        pg8::gemm_phase<pg8::EpiOut>(lds, 2048, DM, 512, S, E);
        skinny_out(p, lds);
    }
#undef IN
#undef SEAM
}

extern "C" void kernel_launch(void* const* d_in, const int* in_sizes, int n_in, void* d_out, int out_size, void* d_ws, size_t ws_size, hipStream_t stream) {
    static int grid = 0;
    if (grid == 0) {
        if (n_in != 18 || out_size != 22889608 || ws_size < WS_END) { fprintf(stderr, "kernel_launch: unexpected shapes (n_in %d out %d ws %zu need %zu)\n", n_in, out_size, ws_size, (size_t)WS_END); grid = -1; return; }
        int dev = 0, cus = 0, per_cu = 0;
        hipGetDevice(&dev); hipDeviceGetAttribute(&cus, hipDeviceAttributeMultiprocessorCount, dev);
        if (hipFuncSetAttribute((const void*)mega, hipFuncAttributeMaxDynamicSharedMemorySize, LDS_BYTES) != hipSuccess) { fprintf(stderr, "kernel_launch: hipFuncSetAttribute failed\n"); grid = -1; return; }
        if (hipOccupancyMaxActiveBlocksPerMultiprocessor(&per_cu, (const void*)mega, 512, LDS_BYTES) != hipSuccess || per_cu < 1) { fprintf(stderr, "kernel_launch: occupancy query says %d\n", per_cu); (void)hipGetLastError(); }
        grid = cus > 0 ? cus : 256;
        if (grid != 256) { fprintf(stderr, "kernel_launch: this build needs a 256-CU device (one out-GEMM unit per workgroup); got %d\n", grid); grid = -1; return; }
    }
    if (grid < 0) return;
    Params p{};
    p.xp = (const float*)d_in[0]; p.xs = (const float*)d_in[1]; p.ck = (const float*)d_in[2]; p.cv = (const float*)d_in[3];
    p.sC = (const float*)d_in[4]; p.sn = (const float*)d_in[5]; p.sm = (const float*)d_in[6]; p.meta = (const float*)d_in[7];
    p.gnorm = (const float*)d_in[8]; p.win = (const float*)d_in[9]; p.bi = (const float*)d_in[10]; p.bf = (const float*)d_in[11];
    p.sinks = (const float*)d_in[12]; p.gmh = (const float*)d_in[13]; p.wpa = (const float*)d_in[14]; p.wpm = (const float*)d_in[15];
    p.wout = (const float*)d_in[16]; p.gfinal = (const float*)d_in[17];
    p.out = (float*)d_out; p.ws = (unsigned char*)d_ws;
#if N_LAUNCH == 1
    p.ph_lo = 0; p.ph_hi = 8;
    if (hipMemsetAsync((char*)d_ws + WS_BAR, 0, 16384 + 4096, stream) != hipSuccess) { fprintf(stderr, "kernel_launch: memset failed\n"); return; }
    void* args[] = {&p};
    hipError_t e = hipLaunchCooperativeKernel((const void*)mega, dim3(grid), dim3(512), args, LDS_BYTES, stream);
    if (e != hipSuccess) fprintf(stderr, "cooperative launch failed: %s (grid %d)\n", hipGetErrorString(e), grid);
#else
    for (int ph = 0; ph < 8; ++ph) { p.ph_lo = ph; p.ph_hi = ph + 1; hipLaunchKernelGGL(mega, dim3(grid), dim3(512), LDS_BYTES, stream, p); }
#endif
}
```

```cpp
#include <hip/hip_runtime.h>
#include <hip/hip_cooperative_groups.h>
#include <cstdio>
#include <cstdint>
namespace cg = cooperative_groups;

#ifndef REP1
#define REP1 1
#endif
#ifndef REP3
#define REP3 1
#endif
#ifndef REP0
#define REP0 1
#endif
#ifndef REP2
#define REP2 1
#endif
#ifndef REP4
#define REP4 1
#endif
#ifndef PSEL
#define PSEL 7
#endif
#ifndef TPROBE
#define TPROBE -1
#endif
#ifndef REP56
#define REP56 1
#endif
#ifndef REPSYNC
#define REPSYNC 0
#endif
#ifndef N_LAUNCH
#define N_LAUNCH 1
#endif

#define LAS __attribute__((address_space(3)))
typedef unsigned short bf16_t;
typedef short bf16x8 __attribute__((ext_vector_type(8)));
typedef short s16x4 __attribute__((ext_vector_type(4)));
typedef float f32x4 __attribute__((ext_vector_type(4)));
typedef float f32x2 __attribute__((ext_vector_type(2)));
typedef unsigned u32x4 __attribute__((ext_vector_type(4)));
typedef unsigned u32x2 __attribute__((ext_vector_type(2)));
#define DI __device__ __forceinline__

constexpr int DM = 2048;
constexpr int ROW_S = 8192, ROW_M = 8448, MROWS = 8464, MPAD = 8704, MOUT = 8448;
constexpr int NU = 16896, NW = 17152;
constexpr size_t UT = (size_t)8704 * 256;
__device__ __forceinline__ size_t uoff(int row, int col) { return (size_t)(col >> 8) * UT + (size_t)row * 256 + (col & 255); }
constexpr int QA = 0, KA = 2048, VA = 2304, ZA = 2560, QM = 4608, KM = 5632, VM = 6656, OM = 8704, ZM = 10752, GA = 12800, GM = 14848;
constexpr int NCH = 64;
constexpr float EPS = 1e-6f;
constexpr size_t O_KP = 17301504, O_VP = 17334272, O_CP = 17367040, O_NP = 17629184, O_MP = 17630208,
                 O_KS = 17630216, O_VS = 18154504, O_CS = 18678792, O_NS = 22873096, O_MS = 22889480;
constexpr size_t WS_WIN = 4096;
constexpr size_t WS_WP = WS_WIN + (size_t)NW * 2048 * 2;
constexpr size_t WS_WOUT = WS_WP + (size_t)4096 * 2048 * 2;
constexpr size_t WS_XN = WS_WOUT + (size_t)2048 * 2048 * 2;
constexpr size_t WS_U = WS_XN + (size_t)MPAD * 2048 * 2;
constexpr size_t WS_GATE = WS_U + (size_t)MPAD * NU * 2;
constexpr size_t WS_UP = WS_GATE + (size_t)MPAD * 16 * 4;
constexpr size_t WS_CST = WS_UP + (size_t)8 * NCH * 256 * 128 * 4;
constexpr size_t WS_NP = WS_CST + (size_t)8 * NCH * 256 * 128 * 2;
constexpr size_t WS_NS = WS_NP + (size_t)8 * NCH * 128 * 4;
constexpr size_t WS_BS = WS_NS + (size_t)8 * NCH * 128 * 4;
constexpr size_t WS_ML = WS_BS + 4096;
constexpr size_t WS_MS = WS_ML + 4096;
constexpr size_t WS_C0 = WS_MS + 4096;
constexpr size_t WS_N0 = WS_C0 + (size_t)8 * 128 * 256 * 4;
constexpr size_t WS_M0 = WS_N0 + 4096;
constexpr size_t WS_SSQ = WS_M0 + 4096;
constexpr size_t WS_BAR = WS_SSQ + (size_t)MOUT * 32 * 4;
constexpr size_t WS_END = WS_BAR + 16384;
constexpr int LDS_BYTES = 131072 + 2048;

struct Params {
    const float *xp, *xs, *ck, *cv, *sC, *sn, *sm, *meta, *gnorm, *win, *bi, *bf, *sinks, *gmh, *wpa, *wpm, *wout, *gfinal;
    float* out; unsigned char* ws; int ph_lo, ph_hi;
};

DI float bf2f(unsigned short b) { return __uint_as_float(((unsigned)b) << 16); }
DI float bflo(unsigned w) { return __uint_as_float(w << 16); }
DI float bfhi(unsigned w) { return __uint_as_float(w & 0xffff0000u); }
DI unsigned pk2(float lo, float hi) { unsigned r; asm volatile("v_cvt_pk_bf16_f32 %0, %1, %2\n\ts_nop 1" : "=v"(r) : "v"(lo), "v"(hi)); return r; }
DI unsigned f2bf_c(float f) { const unsigned u = __float_as_uint(f); return (u + 0x7fffu + ((u >> 16) & 1u)) >> 16; }
DI float sigmoidf_(float x) { return 1.0f / (1.0f + __expf(-x)); }
DI float siluf_(float x) { return x / (1.0f + __expf(-x)); }
DI float logsigmoidf_(float x) { return fminf(x, 0.f) - log1pf(__expf(-fabsf(x))); }
DI float wsum(float v) {
#pragma unroll
    for (int o = 1; o < 64; o <<= 1) v += __shfl_xor(v, o);
    return v;
}
DI float wmax(float v) {
#pragma unroll
    for (int o = 1; o < 64; o <<= 1) v = fmaxf(v, __shfl_xor(v, o));
    return v;
}
DI float scan_add(float v, int lane) {
#pragma unroll
    for (int o = 1; o < 64; o <<= 1) { float t = __shfl_up(v, o); if (lane >= o) v += t; }
    return v;
}
DI float scan_max(float v, int lane) {
#pragma unroll
    for (int o = 1; o < 64; o <<= 1) { float t = __shfl_up(v, o); if (lane >= o) v = fmaxf(v, t); }
    return v;
}
#define ROWPTR(m) ((m) < ROW_S ? p.xp + (size_t)(m) * DM : ((m) < ROW_M ? p.xs + (size_t)((m) - ROW_S) * DM : p.meta + (size_t)((m) - ROW_M) * DM))
DI s16x4 tr_read(const LAS bf16_t* p) { return __builtin_amdgcn_ds_read_tr16_b64_v4i16((LAS s16x4*)p); }
#define LDS_WAIT() asm volatile("s_waitcnt lgkmcnt(0)" ::: "memory")
#define MFMA16(a, b, c) __builtin_amdgcn_mfma_f32_16x16x32_bf16((a), (b), (c), 0, 0, 0)

#define XB_TMO      128
#define XB_XCNT(j)  (256  + 64 * (j))
#define XB_XSUB(j)  (1280 + 64 * (j))
#define XB_XGEN(j)  (2304 + 64 * (j))
#define XB_TOP      3328
#define XB_TOPGEN   3392
#define XCD_BAR_WORDS 3456
#define XB_SPIN_CAP (1u << 18)
DI unsigned xb_ld(unsigned* p)              { return __hip_atomic_load(p, __ATOMIC_RELAXED, __HIP_MEMORY_SCOPE_AGENT); }
DI unsigned xb_add(unsigned* p, unsigned v) { return __hip_atomic_fetch_add(p, v, __ATOMIC_RELAXED, __HIP_MEMORY_SCOPE_AGENT); }
DI unsigned xb_xcc_id() { return (unsigned)__builtin_amdgcn_s_getreg((3 << 11) | 20) & 0xFu; }
#define XB_SPIN(cond, bar) do { unsigned _sp = 0; while (cond) { __builtin_amdgcn_s_sleep(1); \
    if ((++_sp & 255u) == 0u) { if (xb_ld(&(bar)[XB_TMO])) break; if (_sp > XB_SPIN_CAP) { atomicAdd(&(bar)[XB_TMO], 1u); break; } } } } while (0)
struct XcdBarrier { unsigned* bar; unsigned x; volatile LAS unsigned* st; };
DI XcdBarrier xcd_barrier_post(unsigned* bar, volatile LAS unsigned* st) {
    XcdBarrier b; b.bar = bar; b.x = xb_xcc_id(); b.st = st;
    if (threadIdx.x == 0) (void)xb_add(&bar[XB_XCNT(b.x)], 1u);
    return b;
}
DI void xcd_barrier_complete(unsigned* bar, unsigned x, unsigned& nloc, unsigned& nx) {
    const unsigned G = gridDim.x * gridDim.y * gridDim.z;
    unsigned sum, cnt, mine, sp = 0u;
    for (;;) {
        sum = 0u; cnt = 0u; mine = 0u;
#pragma unroll
        for (unsigned j = 0; j < 16; ++j) { const unsigned c = xb_ld(&bar[XB_XCNT(j)]); sum += c; cnt += (c > 0u) ? 1u : 0u; mine = (j == x) ? c : mine; }
        if (sum == G) break;
        __builtin_amdgcn_s_sleep(1);
        if ((++sp & 255u) == 0u) { if (xb_ld(&bar[XB_TMO])) break; if (sp > XB_SPIN_CAP) { atomicAdd(&bar[XB_TMO], 1u); break; } }
    }
    nloc = mine > 0u ? mine : 1u; nx = cnt > 0u ? cnt : 1u;
}
DI void xcd_barrier(const XcdBarrier& b) {
    asm volatile("s_waitcnt vmcnt(0)" ::: "memory");
    __syncthreads();
    if (threadIdx.x == 0) {
        unsigned* bar = b.bar;
        __builtin_amdgcn_s_waitcnt(0);
        unsigned nloc = b.st[0], nx = b.st[1];
        if (nloc == 0u) { xcd_barrier_complete(bar, b.x, nloc, nx); b.st[0] = nloc; b.st[1] = nx; }
        const unsigned old = xb_add(&bar[XB_XSUB(b.x)], 1u);
        const unsigned gen = old / nloc;
        if (old + 1u == (gen + 1u) * nloc) {
            __builtin_amdgcn_fence(__ATOMIC_RELEASE, "agent");
            asm volatile("s_waitcnt vmcnt(0)" ::: "memory");
            const unsigned og = xb_add(&bar[XB_TOP], 1u);
            const unsigned tg = og / nx;
            if (og + 1u == (tg + 1u) * nx) xb_add(&bar[XB_TOPGEN], 1u);
            else XB_SPIN(xb_ld(&bar[XB_TOPGEN]) == tg, bar);
            __builtin_amdgcn_fence(__ATOMIC_ACQUIRE, "agent");
            xb_add(&bar[XB_XGEN(b.x)], 1u);
            asm volatile("s_waitcnt vmcnt(0)" ::: "memory");
        } else {
            XB_SPIN(xb_ld(&bar[XB_XGEN(b.x)]) == gen, bar);
            __builtin_amdgcn_fence(__ATOMIC_ACQUIRE, "agent");
            asm volatile("s_waitcnt vmcnt(0)" ::: "memory");
        }
    }
    __syncthreads();
}

namespace pg8 {
constexpr int BM = 256, BK = 64, HALF = 128, HTB = HALF * BK * 2, STAGE_BYTES = 8 * HTB, NXCD = 8, WGM = 4;
DI int lds_byte(int r, int c) { const int st = (r >> 4) * 2 + (c >> 5), rr = r & 15, cc = c & 31, ob = rr * 64 + cc * 2; return st * 1024 + (ob ^ (((ob >> 9) & 1) << 5)); }
DI void stage_rc(int b, int& R, int& C) { const int st = b / 1024, sb = b % 1024, swz = sb ^ (((sb >> 9) & 1) << 5); R = (st >> 1) * 16 + swz / 64; C = (st & 1) * 32 + (swz % 64) / 2; }
DI int perm32(int rho) { const int n = rho >> 4, i = rho & 15; return 8 * (i >> 2) + 4 * n + (i & 3); }

struct Unit { int pm, pn, sub; };

struct Order {
    int nM, nN, nwg, G, c, pair;
    const char *A0, *A1, *B0, *B1; size_t a_tstep, b_tstep;
    DI void init(int nM_, int nN_, int G_, int c_, int pair_) { nM = nM_; nN = nN_; nwg = nM * nN; G = G_; c = c_; pair = pair_; }
    DI bool next(int i, Unit& u) const {
        const int t = pair ? (i >> 1) : i; u.sub = pair ? (i & 1) : 0;
        const long L = (long)t * G + c; if (L >= nwg) return false;
        int wgid = (int)L; { const int q = nwg / NXCD, r = nwg % NXCD, xcd = wgid % NXCD, off = wgid / NXCD; wgid = (xcd < r ? xcd * (q + 1) : r * (q + 1) + (xcd - r) * q) + off; }
        const int nig = WGM * nN, gid = wgid / nig, fm = gid * WGM, gsz = (nM - fm) < WGM ? (nM - fm) : WGM;
        u.pm = fm + ((wgid % nig) % gsz); u.pn = (wgid % nig) / gsz; return true;
    }
    DI const char* a_ptr(const Unit& u) const { return (u.sub ? A1 : A0) + (size_t)u.pm * a_tstep; }
    DI const char* b_ptr(const Unit& u) const { return (u.sub ? B1 : B0) + (size_t)u.pn * b_tstep; }
};

template <class Epi>
DI void gemm_phase(LAS unsigned char* lds, const int K, const int lda, const size_t a_kblk, const Order& S, const Epi& E) {
#define PG8_AK(x) ((size_t)((x) >> 2) * a_kblk + (size_t)((x) & 3) * 128)
    const int tid = threadIdx.x, wid = __builtin_amdgcn_readfirstlane(tid >> 6), lane = tid & 63, wr = wid >> 2, wc = wid & 3, fr = lane & 15, fq = lane >> 4;
    const int nt = K / BK;
    unsigned voffA[2], voffB[2];
#pragma unroll
    for (int i = 0; i < 2; ++i) { int R, C; stage_rc(tid * 16 + i * 8192, R, C); const int Rb = Epi::PERM ? ((R & ~31) + perm32(R & 31)) : R;
        voffA[i] = (unsigned)(R * lda + C) * 2u; voffB[i] = (unsigned)(Rb * K + C) * 2u; }
    const size_t kstep = (size_t)(BK * 2);
    const size_t hstepA = (size_t)HALF * lda * 2, hstepB = (size_t)HALF * K * 2;
    const unsigned ldsw = (unsigned)wid * 1024u;
    const int aoff = lds_byte(wr * 64 + fr, fq * 8), boff = lds_byte(wc * 32 + fr, fq * 8);
#define PG8_SA(b, h) (((b) * 2 + (h)) * HTB)
#define PG8_SB(b, h) ((4 + (b) * 2 + (h)) * HTB)
#define PG8_STAGE(bufoff, gbase, voff) do { _Pragma("unroll") for (int _i = 0; _i < 2; ++_i) \
        __builtin_amdgcn_global_load_lds((const unsigned*)((const char*)(gbase) + (voff)[_i]), (LAS unsigned*)(lds + (bufoff) + ldsw + _i * 8192), 16, 0, 0); } while (0)
#define PG8_LDA(dst, b, h) do { _Pragma("unroll") for (int m = 0; m < 4; ++m) _Pragma("unroll") for (int k = 0; k < 2; ++k) dst[m][k] = *(const LAS bf16x8*)(lds + PG8_SA(b, h) + aoff + m * 2048 + k * 1024); } while (0)
#define PG8_LDB(dst, b, h) do { _Pragma("unroll") for (int n = 0; n < 2; ++n) _Pragma("unroll") for (int k = 0; k < 2; ++k) dst[n][k] = *(const LAS bf16x8*)(lds + PG8_SB(b, h) + boff + n * 2048 + k * 1024); } while (0)
#define PG8_MMA(ai, bj, At, Bt) do { __builtin_amdgcn_s_setprio(1); _Pragma("unroll") for (int m = 0; m < 4; ++m) _Pragma("unroll") for (int n = 0; n < 2; ++n) _Pragma("unroll") for (int k = 0; k < 2; ++k) \
        acc[ai][bj][m][n] = __builtin_amdgcn_mfma_f32_16x16x32_bf16(Bt[n][k], At[m][k], acc[ai][bj][m][n], 0, 0, 0); __builtin_amdgcn_s_setprio(0); } while (0)
#define PG8_WAIT_V(n) asm volatile("s_waitcnt vmcnt(" #n ")" ::: "memory")
#define PG8_WAIT_L(n) asm volatile("s_waitcnt lgkmcnt(" #n ")" ::: "memory")
#define PG8_BAR __builtin_amdgcn_s_barrier()
#define PG8_SCHED __builtin_amdgcn_sched_barrier(0)
    Unit cur, nxt; int ui = 0;
    if (!S.next(0, cur)) return;
    f32x4 acc[2][2][4][2];
#pragma unroll
    for (int a = 0; a < 2; ++a)
#pragma unroll
        for (int b = 0; b < 2; ++b)
#pragma unroll
            for (int m = 0; m < 4; ++m)
#pragma unroll
                for (int n = 0; n < 2; ++n) acc[a][b][m][n] = (f32x4){0.f, 0.f, 0.f, 0.f};
    bf16x8 At[4][2], B0[2][2], B1[2][2];
    const char* cA = S.a_ptr(cur); const char* cB = S.b_ptr(cur);
    PG8_STAGE(PG8_SB(0, 0), cB, voffB); PG8_STAGE(PG8_SB(0, 1), cB + hstepB, voffB); PG8_STAGE(PG8_SA(0, 0), cA, voffA); PG8_STAGE(PG8_SA(0, 1), cA + hstepA, voffA);
    if (wr == 1) PG8_BAR;
    PG8_WAIT_V(2); PG8_BAR;
    PG8_STAGE(PG8_SB(1, 0), cB + kstep, voffB); PG8_STAGE(PG8_SA(1, 0), cA + kstep, voffA); PG8_STAGE(PG8_SB(1, 1), cB + hstepB + kstep, voffB);
    PG8_WAIT_V(6); PG8_BAR;
    for (;;) {
        const bool has_next = S.next(ui + 1, nxt);
        const char* nA = has_next ? S.a_ptr(nxt) : cA; const char* nB = has_next ? S.b_ptr(nxt) : cB;
        for (int t = 0; t < nt; t += 2) {
            const bool last = (t == nt - 2);
            const char* a1 = cA + PG8_AK(t + 1);
            const char* a2 = last ? nA : cA + PG8_AK(t + 2); const char* b2 = last ? nB : cB + (size_t)(t + 2) * kstep;
            const char* a3 = a2 + kstep; const char* b3 = b2 + kstep;
            PG8_LDB(B0, 0, 0); PG8_LDB(B1, 0, 1); PG8_SCHED; PG8_LDA(At, 0, 0); PG8_STAGE(PG8_SA(1, 1), a1 + hstepA, voffA);
            PG8_WAIT_V(8); PG8_WAIT_L(0); PG8_BAR; PG8_MMA(0, 0, At, B0); PG8_MMA(0, 1, At, B1); PG8_BAR; PG8_SCHED;
            PG8_LDA(At, 0, 1); PG8_STAGE(PG8_SB(0, 0), b2, voffB); PG8_STAGE(PG8_SB(0, 1), b2 + hstepB, voffB); PG8_STAGE(PG8_SA(0, 0), a2, voffA);
            PG8_WAIT_V(8); PG8_WAIT_L(0); PG8_BAR; PG8_MMA(1, 0, At, B0); PG8_MMA(1, 1, At, B1); PG8_BAR; PG8_SCHED;
            PG8_LDB(B0, 1, 0); PG8_LDB(B1, 1, 1); PG8_SCHED; PG8_LDA(At, 1, 0); PG8_STAGE(PG8_SA(0, 1), a2 + hstepA, voffA);
            PG8_WAIT_V(8); PG8_WAIT_L(0); PG8_BAR; PG8_MMA(0, 0, At, B0); PG8_MMA(0, 1, At, B1); PG8_BAR; PG8_SCHED;
            PG8_LDA(At, 1, 1); PG8_STAGE(PG8_SB(1, 0), b3, voffB); PG8_STAGE(PG8_SB(1, 1), b3 + hstepB, voffB); PG8_STAGE(PG8_SA(1, 0), a3, voffA);
            PG8_WAIT_V(8); PG8_WAIT_L(0); PG8_BAR; PG8_MMA(1, 0, At, B0); PG8_MMA(1, 1, At, B1); PG8_BAR; PG8_SCHED;
        }
        if (wr == 0) PG8_BAR;
        E(acc, cur, wr, wc, fr, fq);
        if (!has_next) break;
#pragma unroll
        for (int a = 0; a < 2; ++a)
#pragma unroll
            for (int b = 0; b < 2; ++b)
#pragma unroll
                for (int m = 0; m < 4; ++m)
#pragma unroll
                    for (int n = 0; n < 2; ++n) acc[a][b][m][n] = (f32x4){0.f, 0.f, 0.f, 0.f};
        cur = nxt; cA = nA; cB = nB; ++ui;
        if (wr == 1) PG8_BAR;
    }
    PG8_WAIT_V(0);
    PG8_BAR;
#undef PG8_AK
#undef PG8_SA
#undef PG8_SB
#undef PG8_STAGE
#undef PG8_LDA
#undef PG8_LDB
#undef PG8_MMA
#undef PG8_WAIT_V
#undef PG8_WAIT_L
#undef PG8_BAR
#undef PG8_SCHED
}

struct EpiU {
    static constexpr bool PERM = true;
    bf16_t* U; float* gate; float* out;
    DI void operator()(const f32x4 (&acc)[2][2][4][2], const Unit& u, int wr, int wc, int fr, int fq) const {
        const int row0 = u.pm * BM + wr * 64 + fr, pn = u.pn;
        if (pn == 66) {
            if (wc == 0 && fq < 2) {
#pragma unroll
                for (int ai = 0; ai < 2; ++ai)
#pragma unroll
                    for (int m = 0; m < 4; ++m) { float* g = gate + (size_t)(row0 + ai * HALF + m * 16) * 16 + 8 * fq;
                        *(f32x4*)g = acc[ai][0][m][0]; *(f32x4*)(g + 4) = acc[ai][0][m][1]; }
            }
            return;
        }
        const float scale = (pn < 8) ? 0.18033688011112042f : ((pn >= 22 && pn < 26) ? 0.08838834764831845f : 1.0f);
        const int col0 = pn * BM + wc * 32 + 8 * fq;
#pragma unroll
        for (int ai = 0; ai < 2; ++ai)
#pragma unroll
            for (int m = 0; m < 4; ++m) { bf16_t* rowp = U + (size_t)pn * UT + (size_t)(row0 + ai * HALF + m * 16) * 256 + (wc * 32 + 8 * fq);
#pragma unroll
                for (int bj = 0; bj < 2; ++bj) { const f32x4 v0 = acc[ai][bj][m][0] * scale, v1 = acc[ai][bj][m][1] * scale;
                    u32x4 w; w.x = pk2(v0[0], v0[1]); w.y = pk2(v0[2], v0[3]); w.z = pk2(v1[0], v1[1]); w.w = pk2(v1[2], v1[3]);
                    *(u32x4*)(rowp + bj * HALF) = w; } }
        if (pn == 8 || pn == 9) {
#pragma unroll
            for (int ai = 0; ai < 2; ++ai)
#pragma unroll
                for (int m = 0; m < 4; ++m) { const int r = row0 + ai * HALF + m * 16; float* dst = nullptr;
                    if (r >= 8064 && r < 8192) dst = out + (pn == 8 ? O_KP : O_VP) + (size_t)(r - 8064) * 256;
                    else if (r >= 8192 && r < 8448) { const int b = (r - 8192) >> 4, t = (r - 8192) & 15; dst = out + (pn == 8 ? O_KS : O_VS) + (size_t)(b * 128 + 112 + t) * 256; }
                    if (dst) {
#pragma unroll
                        for (int bj = 0; bj < 2; ++bj) { const int c = bj * HALF + wc * 32 + 8 * fq; *(f32x4*)(dst + c) = acc[ai][bj][m][0]; *(f32x4*)(dst + c + 4) = acc[ai][bj][m][1]; } } }
        }
    }
};
struct EpiMerge {
    static constexpr bool PERM = true;
    const bf16_t* U; bf16_t* MG;
    DI void operator()(const f32x4 (&acc)[2][2][4][2], const Unit& u, int wr, int wc, int fr, int fq) const {
        const int row0 = u.pm * BM + wr * 64 + fr, col0 = u.pn * BM + wc * 32 + 8 * fq; const int gcol = u.sub ? GM : GA;
#pragma unroll
        for (int ai = 0; ai < 2; ++ai) {
            u32x4 g[4][2], o[4][2];
#pragma unroll
            for (int m = 0; m < 4; ++m)
#pragma unroll
                for (int bj = 0; bj < 2; ++bj) { const int r = row0 + ai * HALF + m * 16, c = col0 + bj * HALF;
                    g[m][bj] = *(const u32x4*)(U + uoff(r, gcol + c));
                    o[m][bj] = u.sub ? *(const u32x4*)(MG + (size_t)r * DM + c) : (u32x4){0u, 0u, 0u, 0u}; }
#pragma unroll
            for (int m = 0; m < 4; ++m)
#pragma unroll
                for (int bj = 0; bj < 2; ++bj) { const int r = row0 + ai * HALF + m * 16, c = col0 + bj * HALF;
                    const u32x4 gg = g[m][bj], oo = o[m][bj]; const f32x4 a0 = acc[ai][bj][m][0], a1 = acc[ai][bj][m][1];
                    float v[8];
                    v[0] = sigmoidf_(bflo(gg.x)) * a0[0] + bflo(oo.x); v[1] = sigmoidf_(bfhi(gg.x)) * a0[1] + bfhi(oo.x); v[2] = sigmoidf_(bflo(gg.y)) * a0[2] + bflo(oo.y); v[3] = sigmoidf_(bfhi(gg.y)) * a0[3] + bfhi(oo.y);
                    v[4] = sigmoidf_(bflo(gg.z)) * a1[0] + bflo(oo.z); v[5] = sigmoidf_(bfhi(gg.z)) * a1[1] + bfhi(oo.z); v[6] = sigmoidf_(bflo(gg.w)) * a1[2] + bflo(oo.w); v[7] = sigmoidf_(bfhi(gg.w)) * a1[3] + bfhi(oo.w);
                    u32x4 w; w.x = pk2(v[0], v[1]); w.y = pk2(v[2], v[3]); w.z = pk2(v[4], v[5]); w.w = pk2(v[6], v[7]);
                    *(u32x4*)(MG + (size_t)r * DM + c) = w; }
        }
    }
};
struct EpiOut {
    static constexpr bool PERM = false;
    const float *xp, *xs; bf16_t* X1; float* ssq;
    DI void operator()(const f32x4 (&acc)[2][2][4][2], const Unit& u, int wr, int wc, int fr, int fq) const {
        const int row0 = u.pm * BM + wr * 64 + fr, col0 = u.pn * BM + wc * 32 + 4 * fq;
#pragma unroll
        for (int ai = 0; ai < 2; ++ai) {
            f32x4 xv[4][2][2];
#pragma unroll
            for (int m = 0; m < 4; ++m) { const int r = row0 + ai * HALF + m * 16; const float* xrow = (r < ROW_S) ? xp + (size_t)r * DM : xs + (size_t)(r - ROW_S) * DM;
#pragma unroll
                for (int bj = 0; bj < 2; ++bj)
#pragma unroll
                    for (int n = 0; n < 2; ++n) xv[m][bj][n] = *(const f32x4*)(xrow + col0 + bj * HALF + n * 16); }
#pragma unroll
            for (int m = 0; m < 4; ++m) { const int r = row0 + ai * HALF + m * 16; bf16_t* orow = X1 + (size_t)u.pn * UT + (size_t)r * 256 + wc * 32 + 4 * fq; float ss = 0.f;
#pragma unroll
                for (int bj = 0; bj < 2; ++bj)
#pragma unroll
                    for (int n = 0; n < 2; ++n) { const f32x4 o = xv[m][bj][n] + acc[ai][bj][m][n];
                        u32x2 w; w.x = pk2(o[0], o[1]); w.y = pk2(o[2], o[3]); *(u32x2*)(orow + bj * HALF + n * 16) = w; ss += (o[0] * o[0] + o[1] * o[1]) + (o[2] * o[2] + o[3] * o[3]); }
                ss += __shfl_xor(ss, 16); ss += __shfl_xor(ss, 32);
                if (fq == 0) ssq[(size_t)r * 32 + u.pn * 4 + wc] = ss; }
        }
    }
};
}

DI int win_src_col(int n) { return n < 10752 ? n : (n < 16896 ? n + 16 : (n < 16912 ? 10752 + (n - 16896) : -1)); }

DI void p0_transpose_item(const float* W, int Nsrc, int srccol4, bf16_t* WT, int dstrow0, int k0, LAS float* scr, int lane) {
    f32x4 r[8];
#pragma unroll
    for (int i = 0; i < 8; ++i) { const int kk = (lane >> 3) + 8 * i; r[i] = (srccol4 >= 0) ? *(const f32x4*)(W + (size_t)(k0 + kk) * Nsrc + srccol4) : (f32x4){0.f, 0.f, 0.f, 0.f}; }
#pragma unroll
    for (int i = 0; i < 8; ++i) { const int kk = (lane >> 3) + 8 * i; LAS float* d = scr + kk * 33 + 4 * (lane & 7); d[0] = r[i][0]; d[1] = r[i][1]; d[2] = r[i][2]; d[3] = r[i][3]; }
    LDS_WAIT();
    const int c = lane & 7;
#pragma unroll
    for (int j = 0; j < 4; ++j) { const int n = (lane >> 3) + 8 * j; const LAS float* s = scr + (8 * c) * 33 + n;
        u32x4 o; o.x = pk2(s[0 * 33], s[1 * 33]); o.y = pk2(s[2 * 33], s[3 * 33]); o.z = pk2(s[4 * 33], s[5 * 33]); o.w = pk2(s[6 * 33], s[7 * 33]);
        *(u32x4*)(WT + (size_t)(dstrow0 + n) * 2048 + k0 + 8 * c) = o; }
    LDS_WAIT();
}

DI void p0_prologue(const Params& p, LAS unsigned char* lds) {
    const int tid = threadIdx.x, lane = tid & 63, wave = tid >> 6;
    const int gw = blockIdx.x * 8 + wave, NGW = gridDim.x * 8;
    bf16_t* WIN = (bf16_t*)(p.ws + WS_WIN); bf16_t* WP = (bf16_t*)(p.ws + WS_WP); bf16_t* WOUT = (bf16_t*)(p.ws + WS_WOUT); bf16_t* XN = (bf16_t*)(p.ws + WS_XN);
    LAS float* scr = (LAS float*)(lds + wave * 16384);
    constexpr int I_IN = 32 * (NW / 32), I_SQ = 32 * 64;
    for (int it = gw; it < I_IN + 3 * I_SQ; it += NGW) {
        int r = it;
        if (r < I_IN) { const int nb = r % (NW / 32), kb = r / (NW / 32); p0_transpose_item(p.win, 16912, win_src_col(nb * 32 + 4 * (lane & 7)), WIN, nb * 32, kb * 64, scr, lane); continue; }
        r -= I_IN; const int which = r / I_SQ; r -= which * I_SQ; const int nb = r % 64, kb = r / 64;
        const float* W = which == 0 ? p.wpa : (which == 1 ? p.wpm : p.wout);
        bf16_t* WT = which == 2 ? WOUT : WP; const int drow = (which == 1 ? 2048 : 0) + nb * 32;
        p0_transpose_item(W, 2048, nb * 32 + 4 * (lane & 7), WT, drow, kb * 64, scr, lane);
    }
    for (int m = gw; m < MPAD; m += NGW) {
        u32x2* o8 = (u32x2*)(XN + (size_t)m * DM) + lane;
        if (m >= MROWS) {
#pragma unroll
            for (int j = 0; j < 8; ++j) o8[64 * j] = (u32x2){0u, 0u};
            continue; }
        const float* xrow = m < ROW_S ? p.xp + (size_t)m * DM : (m < ROW_M ? p.xs + (size_t)(m - ROW_S) * DM : p.meta + (size_t)(m - ROW_M) * DM);
        const f32x4* xr = (const f32x4*)xrow + lane; const f32x4* gr = (const f32x4*)p.gnorm + lane;
        f32x4 v[8]; float s = 0.f;
#pragma unroll
        for (int j = 0; j < 8; ++j) { v[j] = xr[64 * j]; s += (v[j][0] * v[j][0] + v[j][1] * v[j][1]) + (v[j][2] * v[j][2] + v[j][3] * v[j][3]); }
        const float rstd = rsqrtf(wsum(s) * (1.f / DM) + EPS);
#pragma unroll
        for (int j = 0; j < 8; ++j) { const f32x4 g = gr[64 * j]; u32x2 w; w.x = pk2(v[j][0] * rstd * g[0], v[j][1] * rstd * g[1]); w.y = pk2(v[j][2] * rstd * g[2], v[j][3] * rstd * g[3]); o8[64 * j] = w; }
    }
    const int gt = blockIdx.x * 512 + tid, NGT = gridDim.x * 512;
    for (int i = gt; i < 2 * 16 * 112 * 64; i += NGT) {
        const int kv = i / (16 * 112 * 64); int r = i - kv * (16 * 112 * 64); const int b = r / (112 * 64); r -= b * (112 * 64);
        const f32x4* src = (const f32x4*)((kv ? p.cv : p.ck) + (size_t)(b * 128 + 16) * 256) + r;
        f32x4* dst = (f32x4*)(p.out + (kv ? O_VS : O_KS) + (size_t)(b * 128) * 256) + r;
        *dst = *src;
    }
}

DI u32x4 attn_fetch8(const Params& p, const bf16_t* U, int kind, int bidx, int g, int key, int ch, int colbase, const float* cache) {
    u32x4 z = (u32x4){0u, 0u, 0u, 0u};
    if (key < 16) return *(const u32x4*)(U + uoff(ROW_M + key, colbase + g * 64 + 8 * ch));
    if (kind == 0) {
        const int row = 64 * (bidx - 2) + (key - 16);
        if (key < 208 && row >= 0) return *(const u32x4*)(U + uoff(row, colbase + g * 64 + 8 * ch));
        return z;
    } else {
        if (key < 144) { const float* s = cache + ((size_t)(bidx * 128 + (key - 16)) * 4 + g) * 64 + 8 * ch; const f32x4 a = *(const f32x4*)s, b = *(const f32x4*)(s + 4);
            u32x4 w; w.x = pk2(a[0], a[1]); w.y = pk2(a[2], a[3]); w.z = pk2(b[0], b[1]); w.w = pk2(b[2], b[3]); return w; }
        if (key < 160) return *(const u32x4*)(U + uoff(ROW_S + 16 * bidx + (key - 144), colbase + g * 64 + 8 * ch));
        return z;
    }
}
DI void attn_item(const Params& p, LAS unsigned char* lds, int kind, int bidx, int g, int dry) {
    int tid_ = threadIdx.x; asm volatile("" : "+v"(tid_)); const int tid = tid_, lane = tid & 63, wave = tid >> 6, lr = lane & 15, q = lane >> 4;
    bf16_t* U = (bf16_t*)(p.ws + WS_U);
    LAS bf16_t* KAl = (LAS bf16_t*)lds; LAS bf16_t* VAl = (LAS bf16_t*)(lds + 32256);
    const int hq = 8 * g + wave; const float sink = p.sinks[hq] * 1.4426950408889634f;
    const int npair = kind == 0 ? 2 : 1, qrow0 = kind == 0 ? 64 * bidx : ROW_S + 16 * bidx;
    const int hi_t = kind == 0 ? 13 : 10; const int lo_t = kind == 0 ? 1 + (bidx < 2 ? 4 * (2 - bidx) : 0) : 1;
    u32x4 kreg[4], vreg[4];
#pragma unroll
    for (int i = 0; i < 4; ++i) { const int ci = tid + 512 * i; kreg[i] = (u32x4){0u, 0u, 0u, 0u}; vreg[i] = kreg[i];
        if (ci < 224 * 8) { kreg[i] = attn_fetch8(p, U, kind, bidx, g, ci >> 3, ci & 7, KA, p.ck); vreg[i] = attn_fetch8(p, U, kind, bidx, g, ci >> 3, ci & 7, VA, p.cv); } }
#pragma unroll
    for (int i = 0; i < 4; ++i) { const int ci = tid + 512 * i; if (ci < 224 * 8) { *(LAS u32x4*)(KAl + (ci >> 3) * 72 + 8 * (ci & 7)) = kreg[i]; *(LAS u32x4*)(VAl + (ci >> 3) * 72 + 8 * (ci & 7)) = vreg[i]; } }
    __syncthreads();
    for (int pr = 0; pr < npair; ++pr) {
        const int tA = 2 * pr, tB = kind == 0 ? 2 * pr + 1 : 0;
        const size_t rowA = (size_t)(qrow0 + 16 * tA + lr) * 256 + (size_t)(hq >> 2) * UT + (hq & 3) * 64, rowB = (size_t)(qrow0 + 16 * tB + lr) * 256 + (size_t)(hq >> 2) * UT + (hq & 3) * 64;
        constexpr size_t ZOFF = (size_t)(ZA >> 8) * UT;
        bf16x8 qa[2], qb[2]; u32x2 za[4], zb[4];
#pragma unroll
        for (int ks = 0; ks < 2; ++ks) { qa[ks] = *(const bf16x8*)(U + rowA + 32 * ks + 8 * q); qb[ks] = *(const bf16x8*)(U + rowB + 32 * ks + 8 * q); }
#pragma unroll
        for (int dt = 0; dt < 4; ++dt) { za[dt] = *(const u32x2*)(U + rowA + ZOFF + 16 * dt + 4 * q); zb[dt] = *(const u32x2*)(U + rowB + ZOFF + 16 * dt + 4 * q); }
        f32x4 accA[14], accB[14];
        float mxA = -1e30f, mxB = -1e30f;
#pragma unroll
        for (int kt = 0; kt < 14; ++kt) {
            if (kt == 0 || (kt >= lo_t && kt < hi_t)) {
                accA[kt] = (f32x4){0.f, 0.f, 0.f, 0.f}; accB[kt] = accA[kt];
#pragma unroll
                for (int ks = 0; ks < 2; ++ks) { const bf16x8 a = *(const LAS bf16x8*)(KAl + (16 * kt + lr) * 72 + 32 * ks + 8 * q); accA[kt] = MFMA16(a, qa[ks], accA[kt]); accB[kt] = MFMA16(a, qb[ks], accB[kt]); }
                mxA = fmaxf(mxA, fmaxf(fmaxf(accA[kt][0], accA[kt][1]), fmaxf(accA[kt][2], accA[kt][3])));
                mxB = fmaxf(mxB, fmaxf(fmaxf(accB[kt][0], accB[kt][1]), fmaxf(accB[kt][2], accB[kt][3])));
            } else { accA[kt] = (f32x4){-1e30f, -1e30f, -1e30f, -1e30f}; accB[kt] = accA[kt]; }
        }
        mxA = fmaxf(mxA, __shfl_xor(mxA, 16)); mxA = fmaxf(mxA, __shfl_xor(mxA, 32)); mxB = fmaxf(mxB, __shfl_xor(mxB, 16)); mxB = fmaxf(mxB, __shfl_xor(mxB, 32));
        const float MA = fmaxf(mxA, sink), MB = fmaxf(mxB, sink); float sumA = 0.f, sumB = 0.f;
#pragma unroll
        for (int kt = 0; kt < 14; ++kt)
#pragma unroll
            for (int j = 0; j < 4; ++j) { const float ea = __builtin_amdgcn_exp2f(accA[kt][j] - MA), eb = __builtin_amdgcn_exp2f(accB[kt][j] - MB); accA[kt][j] = ea; accB[kt][j] = eb; sumA += ea; sumB += eb; }
        sumA += __shfl_xor(sumA, 16); sumA += __shfl_xor(sumA, 32); sumB += __shfl_xor(sumB, 16); sumB += __shfl_xor(sumB, 32);
        const float invA = 1.0f / (sumA + __builtin_amdgcn_exp2f(sink - MA)), invB = 1.0f / (sumB + __builtin_amdgcn_exp2f(sink - MB));
        bf16x8 pA[7], pB[7];
#pragma unroll
        for (int u = 0; u < 7; ++u) { u32x4 w; w.x = pk2(accA[2 * u][0], accA[2 * u][1]); w.y = pk2(accA[2 * u][2], accA[2 * u][3]);
            w.z = pk2(accA[2 * u + 1][0], accA[2 * u + 1][1]); w.w = pk2(accA[2 * u + 1][2], accA[2 * u + 1][3]); pA[u] = __builtin_bit_cast(bf16x8, w);
            w.x = pk2(accB[2 * u][0], accB[2 * u][1]); w.y = pk2(accB[2 * u][2], accB[2 * u][3]);
            w.z = pk2(accB[2 * u + 1][0], accB[2 * u + 1][1]); w.w = pk2(accB[2 * u + 1][2], accB[2 * u + 1][3]); pB[u] = __builtin_bit_cast(bf16x8, w); }
        f32x4 oA[4], oB[4];
#pragma unroll
        for (int dt = 0; dt < 4; ++dt) { oA[dt] = (f32x4){0.f, 0.f, 0.f, 0.f}; oB[dt] = oA[dt];
#pragma unroll
            for (int u = 0; u < 7; ++u) { const LAS bf16_t* vp = VAl + (32 * u + 4 * q + (lr >> 2)) * 72 + 16 * dt + 4 * (lr & 3);
                const s16x4 lo = tr_read(vp), hi = tr_read(vp + 16 * 72);
                const bf16x8 a = __builtin_shufflevector(lo, hi, 0, 1, 2, 3, 4, 5, 6, 7); oA[dt] = MFMA16(a, pA[u], oA[dt]); oB[dt] = MFMA16(a, pB[u], oB[dt]); } }
#pragma unroll
        for (int dt = 0; dt < 4; ++dt) { const int col = hq * 64 + 16 * dt + 4 * q;
            { const u32x2 z = za[dt]; u32x2 w; w.x = pk2(oA[dt][0] * invA * siluf_(bflo(z.x)), oA[dt][1] * invA * siluf_(bfhi(z.x))); w.y = pk2(oA[dt][2] * invA * siluf_(bflo(z.y)), oA[dt][3] * invA * siluf_(bfhi(z.y)));
              if (dry) *(u32x2*)((bf16_t*)(p.ws + WS_XN) + (size_t)(qrow0 + 16 * tA + lr) * DM + col) = w; else *(u32x2*)(U + rowA + 16 * dt + 4 * q) = w; }
            if (kind == 0) { const u32x2 z = zb[dt]; u32x2 w; w.x = pk2(oB[dt][0] * invB * siluf_(bflo(z.x)), oB[dt][1] * invB * siluf_(bfhi(z.x))); w.y = pk2(oB[dt][2] * invB * siluf_(bflo(z.y)), oB[dt][3] * invB * siluf_(bfhi(z.y)));
              if (dry) *(u32x2*)((bf16_t*)(p.ws + WS_XN) + (size_t)(qrow0 + 16 * tB + lr) * DM + col) = w; else *(u32x2*)(U + rowB + 16 * dt + 4 * q) = w; } }
    }
    __syncthreads();
}

constexpr int ML_T2 = 69632, ML_SC = 106496;
constexpr int PV = 272, PKS = 144;
DI void mlstm_v_load(const bf16_t* U, int R0, int h, int tid, u32x4 (&v)[8]) {
#pragma unroll
    for (int it = 0; it < 8; ++it) { const int ci = tid + 512 * it, row = ci >> 5, ch = ci & 31; v[it] = *(const u32x4*)(U + uoff(R0 + row, VM + h * 256 + 8 * ch)); }
}
DI void mlstm_v_store(LAS unsigned char* lds, int tid, const u32x4 (&v)[8]) {
    LAS bf16_t* Vl = (LAS bf16_t*)lds;
#pragma unroll
    for (int it = 0; it < 8; ++it) { const int ci = tid + 512 * it, row = ci >> 5, ch = ci & 31; *(LAS u32x4*)(Vl + row * PV + 8 * ch) = v[it]; }
}

DI void mlstm_sum_item(const Params& p, LAS unsigned char* lds, int h, int j) {
    int tid_ = threadIdx.x; asm volatile("" : "+v"(tid_)); const int tid = tid_, lane = tid & 63, wave = tid >> 6, lr = lane & 15, q = lane >> 4;
    const bf16_t* U = (const bf16_t*)(p.ws + WS_U); const float* GATE = (const float*)(p.ws + WS_GATE);
    LAS float* wS = (LAS float*)(lds + ML_SC);
    const int R0 = 128 * j;
    u32x4 vreg[8], kreg[4];
    mlstm_v_load(U, R0, h, tid, vreg);
#pragma unroll
    for (int it = 0; it < 4; ++it) { const int ci = tid + 512 * it, row = ci >> 4, ch = ci & 15; kreg[it] = *(const u32x4*)(U + uoff(R0 + row, KM + h * 128 + 8 * ch)); }
    if (wave == 0) {
        const float bi = p.bi[h], bfb = p.bf[h];
        const float gi0 = GATE[(size_t)(R0 + lane) * 16 + h] + bi, gi1 = GATE[(size_t)(R0 + 64 + lane) * 16 + h] + bi;
        const float lf0 = logsigmoidf_(GATE[(size_t)(R0 + lane) * 16 + 8 + h] + bfb), lf1 = logsigmoidf_(GATE[(size_t)(R0 + 64 + lane) * 16 + 8 + h] + bfb);
        const float c0 = scan_add(lf0, lane); const float tot0 = __shfl(c0, 63); const float c1 = scan_add(lf1, lane) + tot0; const float blast = __shfl(c1, 63);
        const float x0 = blast - c0 + gi0, x1 = blast - c1 + gi1; const float ml = wmax(fmaxf(x0, x1));
        wS[lane] = __expf(x0 - ml); wS[64 + lane] = __expf(x1 - ml);
        if (lane == 0) { ((float*)(p.ws + WS_BS))[h * NCH + j] = blast; ((float*)(p.ws + WS_ML))[h * NCH + j] = ml; }
    }
    mlstm_v_store(lds, tid, vreg);
    __syncthreads();
    {
        LAS bf16_t* Kl = (LAS bf16_t*)(lds + ML_T2);
#pragma unroll
        for (int it = 0; it < 4; ++it) { const int ci = tid + 512 * it, row = ci >> 4, ch = ci & 15; const u32x4 a = kreg[it]; const float w = wS[row];
            u32x4 o; o.x = pk2(bflo(a.x) * w, bfhi(a.x) * w); o.y = pk2(bflo(a.y) * w, bfhi(a.y) * w); o.z = pk2(bflo(a.z) * w, bfhi(a.z) * w); o.w = pk2(bflo(a.w) * w, bfhi(a.w) * w);
            *(LAS u32x4*)(Kl + row * PKS + 8 * ch) = o; }
    }
    __syncthreads();
    const LAS bf16_t* Vl = (const LAS bf16_t*)lds; const LAS bf16_t* Kl = (const LAS bf16_t*)(lds + ML_T2);
    {
        LAS float* npart = (LAS float*)(lds + ML_SC + 512);
        const int d = tid & 127, part = tid >> 7; float sm = 0.f;
#pragma unroll 8
        for (int r = 0; r < 32; ++r) sm += bf2f(Kl[(32 * part + r) * PKS + d]);
        npart[part * 128 + d] = sm;
    }
    f32x4 acc[2][8];
#pragma unroll
    for (int i = 0; i < 2; ++i)
#pragma unroll
        for (int dt = 0; dt < 8; ++dt) acc[i][dt] = (f32x4){0.f, 0.f, 0.f, 0.f};
#pragma unroll
    for (int ks = 0; ks < 4; ++ks) {
        bf16x8 a[2];
#pragma unroll
        for (int i = 0; i < 2; ++i) { const LAS bf16_t* vp = Vl + (32 * ks + 8 * q + (lr >> 2)) * PV + 16 * (2 * wave + i) + 4 * (lr & 3);
            const s16x4 lo = tr_read(vp), hi = tr_read(vp + 4 * PV); a[i] = __builtin_shufflevector(lo, hi, 0, 1, 2, 3, 4, 5, 6, 7); }
#pragma unroll
        for (int dt = 0; dt < 8; ++dt) { const LAS bf16_t* kp = Kl + (32 * ks + 8 * q + (lr >> 2)) * PKS + 16 * dt + 4 * (lr & 3);
            const s16x4 lo = tr_read(kp), hi = tr_read(kp + 4 * PKS); const bf16x8 b = __builtin_shufflevector(lo, hi, 0, 1, 2, 3, 4, 5, 6, 7);
#pragma unroll
            for (int i = 0; i < 2; ++i) acc[i][dt] = MFMA16(b, a[i], acc[i][dt]); }
    }
    bf16_t* UP = (bf16_t*)(p.ws + WS_UP) + (size_t)(h * NCH + j) * 256 * 128;
#pragma unroll
    for (int i = 0; i < 2; ++i)
#pragma unroll
        for (int dt = 0; dt < 8; ++dt) { u32x2 w; w.x = f2bf_c(acc[i][dt][0]) | (f2bf_c(acc[i][dt][1]) << 16); w.y = f2bf_c(acc[i][dt][2]) | (f2bf_c(acc[i][dt][3]) << 16);
            *(u32x2*)(UP + (size_t)(16 * (2 * wave + i) + lr) * 128 + 16 * dt + 4 * q) = w; }
    __syncthreads();
    if (tid < 128) { const LAS float* npart = (const LAS float*)(lds + ML_SC + 512);
        ((float*)(p.ws + WS_NP))[(size_t)(h * NCH + j) * 128 + tid] = (npart[tid] + npart[128 + tid]) + (npart[256 + tid] + npart[384 + tid]); }
    __syncthreads();
}

DI void mlstm_small_item(const Params& p, LAS unsigned char* lds, int b, int h, int dry) {
    int tid_ = threadIdx.x; asm volatile("" : "+v"(tid_)); const int tid = tid_, lane = tid & 63, wave = tid >> 6;
    bf16_t* U = (bf16_t*)(p.ws + WS_U); const float* GATE = (const float*)(p.ws + WS_GATE);
    const bool meta = (b == 16); const int R0 = meta ? ROW_M : ROW_S + 16 * b;
    LAS float* qT = (LAS float*)lds; LAS float* kwT = (LAS float*)(lds + 8192); LAS float* kS = (LAS float*)(lds + 16384);
    LAS float* Wm = (LAS float*)(lds + 24832); LAS float* sc = (LAS float*)(lds + 25856); LAS float* red = (LAS float*)(lds + 26624);
    LAS float* am = sc, *cm = sc + 16, *bb = sc + 32, *wsS = sc + 48, *misc = sc + 64, *qnS = sc + 80;
    const float* Cin = p.sC + (size_t)(b * 8 + h) * 128 * 256; const float* nin = p.sn + (size_t)(b * 8 + h) * 128;
    float* Cout = meta ? (float*)(p.ws + WS_C0) + (size_t)h * 128 * 256 : p.out + O_CS + (size_t)(b * 8 + h) * 128 * 256;
    float* nout = meta ? (float*)(p.ws + WS_N0) + h * 128 : p.out + O_NS + (size_t)(b * 8 + h) * 128;
#pragma unroll
    for (int i = 0; i < 4; ++i) { const int idx = tid + 512 * i, t = idx >> 7, d = idx & 127;
        qT[d * 16 + t] = bf2f(U[uoff(R0 + t, QM + h * 128 + d)]); kS[t * 132 + d] = bf2f(U[uoff(R0 + t, KM + h * 128 + d)]); }
    if (wave == 0) {
        const bool act = lane < 16; const int tl = act ? lane : 15;
        const float gi = GATE[(size_t)(R0 + tl) * 16 + h] + p.bi[h];
        const float lf = act ? logsigmoidf_(GATE[(size_t)(R0 + tl) * 16 + 8 + h] + p.bf[h]) : 0.f;
        const float c = scan_add(lf, lane); const float a = act ? gi - c : -3e38f; const float pm = scan_max(a, lane);
        const float mprev = meta ? 0.f : p.sm[b * 8 + h]; const float cmv = fmaxf(mprev, pm);
        const float b15 = __shfl(c, 15), cm15 = __shfl(cmv, 15); const float mnew = b15 + cm15;
        if (act) { am[lane] = a; cm[lane] = cmv; bb[lane] = c; wsS[lane] = __expf(b15 + a - mnew); }
        if (lane == 0) { misc[0] = __expf(b15 + mprev - mnew); misc[1] = mnew; misc[2] = mprev;
            if (meta) ((float*)(p.ws + WS_M0))[h] = mnew; else p.out[O_MS + b * 8 + h] = mnew; }
    }
    __syncthreads();
#pragma unroll
    for (int i = 0; i < 4; ++i) { const int idx = tid + 512 * i, s = idx >> 7, d = idx & 127; kwT[d * 16 + s] = kS[s * 132 + d] * wsS[s]; }
    if (tid < 256) { const int t = tid >> 4, s = tid & 15; float dot = 0.f;
        for (int d = 0; d < 128; ++d) dot += qT[d * 16 + t] * kS[s * 132 + d];
        Wm[t * 16 + s] = (s <= t) ? dot * __expf(am[s] - cm[t]) : 0.f;
    } else if (tid < 272) { const int t = tid - 256; float dot = 0.f;
        if (!meta) for (int d = 0; d < 128; ++d) dot += qT[d * 16 + t] * nin[d];
        qnS[t] = dot; }
    __syncthreads();
    const int e = tid & 255, dh = tid >> 8;
    float v[16];
#pragma unroll
    for (int s = 0; s < 16; ++s) v[s] = bf2f(U[uoff(R0 + s, VM + h * 256 + e)]);
    float acc[16];
#pragma unroll
    for (int t = 0; t < 16; ++t) acc[t] = 0.f;
    const float alast = misc[0], mprev = misc[2];
    for (int d0 = dh * 64; d0 < dh * 64 + 64; d0 += 16) {
        float cb[16];
#pragma unroll
        for (int dd = 0; dd < 16; ++dd) cb[dd] = meta ? 0.f : Cin[(size_t)(d0 + dd) * 256 + e];
#pragma unroll
        for (int dd = 0; dd < 16; ++dd) { const int d = d0 + dd; const float c = cb[dd];
            float cn = alast * c;
#pragma unroll
            for (int i = 0; i < 4; ++i) { const f32x4 q4 = *(const LAS f32x4*)(qT + d * 16 + 4 * i), k4 = *(const LAS f32x4*)(kwT + d * 16 + 4 * i);
#pragma unroll
                for (int jj = 0; jj < 4; ++jj) { acc[4 * i + jj] += q4[jj] * c; cn += k4[jj] * v[4 * i + jj]; } }
            Cout[(size_t)d * 256 + e] = cn; }
    }
#pragma unroll
    for (int t = 0; t < 16; ++t) red[(dh * 16 + t) * 256 + e] = acc[t];
    if (tid < 128) { float nn = alast * (meta ? 0.f : nin[tid]);
#pragma unroll
        for (int s = 0; s < 16; ++s) nn += kwT[tid * 16 + s];
        nout[tid] = nn; }
    __syncthreads();
    if (!meta) {
#pragma unroll
        for (int tl = 0; tl < 8; ++tl) { const int t = dh * 8 + tl;
            const float inter = red[t * 256 + e] + red[(16 + t) * 256 + e]; const float sc_t = __expf(mprev - cm[t]);
            float num = sc_t * inter, den = sc_t * qnS[t];
#pragma unroll
            for (int s = 0; s < 16; ++s) { const float w = Wm[t * 16 + s]; num += w * v[s]; den += w; }
            const float mt = bb[t] + cm[t];
            red[t * 256 + e] = num / fmaxf(fabsf(den), __expf(-mt)); }
    }
    __syncthreads();
    if (!meta) {
#pragma unroll
        for (int r = 0; r < 2; ++r) { const int t = 2 * wave + r; float hv[4]; float ss = 0.f;
#pragma unroll
            for (int i = 0; i < 4; ++i) { hv[i] = red[t * 256 + lane + 64 * i]; ss += hv[i] * hv[i]; }
            const float rstd = rsqrtf(wsum(ss) * (1.f / 256.f) + EPS);
            float ov[4], zv[4], gv[4];
#pragma unroll
            for (int i = 0; i < 4; ++i) { const int ee = lane + 64 * i; const size_t ro = (size_t)(R0 + t) * 256 + (size_t)h * UT + ee;
                ov[i] = bf2f(U[ro + (size_t)(OM >> 8) * UT]); zv[i] = bf2f(U[ro + (size_t)(ZM >> 8) * UT]); gv[i] = p.gmh[h * 256 + ee]; }
#pragma unroll
            for (int i = 0; i < 4; ++i) { const int ee = lane + 64 * i; const size_t ro = (size_t)(R0 + t) * 256 + (size_t)h * UT + ee;
                const float val = hv[i] * rstd * gv[i] * sigmoidf_(ov[i]) * siluf_(zv[i]);
                if (!dry) U[ro + (size_t)(OM >> 8) * UT] = (bf16_t)(pk2(val, 0.f) & 0xffffu); } }
    }
    __syncthreads();
}

DI void mlstm_scan(const Params& p) {
    const float* BS = (const float*)(p.ws + WS_BS); const float* MLv = (const float*)(p.ws + WS_ML); float* MS = (float*)(p.ws + WS_MS);
    const float* NPv = (const float*)(p.ws + WS_NP); float* NS = (float*)(p.ws + WS_NS);
    const float* C0 = (const float*)(p.ws + WS_C0); const float* N0 = (const float*)(p.ws + WS_N0); const float* M0 = (const float*)(p.ws + WS_M0);
    for (int gid = blockIdx.x * 512 + threadIdx.x; gid < 8 * 256 * 64; gid += gridDim.x * 512) {
        const int h = gid >> 14, e = (gid >> 6) & 255, d = 2 * (gid & 63);
        const bool isn = (e == 0);
        float m = M0[h];
        float cx = C0[((size_t)h * 128 + d) * 256 + e], cy = C0[((size_t)h * 128 + d + 1) * 256 + e];
        float nx = isn ? N0[h * 128 + d] : 0.f, ny = isn ? N0[h * 128 + d + 1] : 0.f;
        const bf16_t* UP = (const bf16_t*)(p.ws + WS_UP) + (size_t)h * NCH * 256 * 128 + (size_t)e * 128 + d;
        unsigned* CS = (unsigned*)((bf16_t*)(p.ws + WS_CST) + (size_t)h * NCH * 256 * 128 + (size_t)e * 128 + d);
        for (int k0 = 0; k0 < NCH; k0 += 64) {
            unsigned u[64];
#pragma unroll
            for (int i = 0; i < 64; ++i) u[i] = *(const unsigned*)(UP + (size_t)(k0 + i) * 256 * 128);
#pragma unroll
            for (int i = 0; i < 64; ++i) { const int k = k0 + i;
                CS[(size_t)k * 256 * 64] = pk2(cx, cy);
                if (isn) { NS[(size_t)(h * NCH + k) * 128 + d] = nx; NS[(size_t)(h * NCH + k) * 128 + d + 1] = ny; if (d == 0) MS[h * NCH + k] = m; }
                const float bs = BS[h * NCH + k], ml = MLv[h * NCH + k]; const float mn = fmaxf(bs + m, ml);
                const float a = __expf(bs + m - mn), bsc = __expf(ml - mn);
                cx = a * cx + bsc * bflo(u[i]); cy = a * cy + bsc * bfhi(u[i]);
                if (isn) { nx = a * nx + bsc * NPv[(size_t)(h * NCH + k) * 128 + d]; ny = a * ny + bsc * NPv[(size_t)(h * NCH + k) * 128 + d + 1]; }
                m = mn; }
        }
        p.out[O_CP + ((size_t)h * 128 + d) * 256 + e] = cx; p.out[O_CP + ((size_t)h * 128 + d + 1) * 256 + e] = cy;
        if (isn) { p.out[O_NP + h * 128 + d] = nx; p.out[O_NP + h * 128 + d + 1] = ny; if (d == 0) p.out[O_MP + h] = m; }
    }
}

DI void mlstm_sw_tile(const LAS bf16_t* KN, const LAS float* aS, const bf16x8 (&qf)[4], int tT, int t, float cmt, int lr, int q, bf16x8 (&wf)[4], float& dsum) {
    dsum = 0.f;
#pragma unroll
    for (int u = 0; u < 4; ++u) {
        u32x4 w = (u32x4){0u, 0u, 0u, 0u};
#pragma unroll
        for (int hh = 0; hh < 2; ++hh) { const int st = 2 * u + hh;
            if (st <= tT) {
                f32x4 s4 = (f32x4){0.f, 0.f, 0.f, 0.f};
#pragma unroll
                for (int ks = 0; ks < 4; ++ks) { const bf16x8 a = *(const LAS bf16x8*)(KN + (16 * st + lr) * 136 + 32 * ks + 8 * q); s4 = MFMA16(a, qf[ks], s4); }
                float wv[4];
#pragma unroll
                for (int jj = 0; jj < 4; ++jj) { const int sx = 16 * st + 4 * q + jj; const float wg = (sx <= t) ? __expf(aS[sx] - cmt) : 0.f; wv[jj] = s4[jj] * wg; dsum += wv[jj]; }
                if (hh == 0) { w.x = pk2(wv[0], wv[1]); w.y = pk2(wv[2], wv[3]); } else { w.z = pk2(wv[0], wv[1]); w.w = pk2(wv[2], wv[3]); }
            } }
        wf[u] = __builtin_bit_cast(bf16x8, w);
    }
}
DI void mlstm_out_item(const Params& p, LAS unsigned char* lds, int h, int j, int dry) {
    int tid_ = threadIdx.x; asm volatile("" : "+v"(tid_)); const int tid = tid_, lane = tid & 63, wave = __builtin_amdgcn_readfirstlane(tid >> 6), lr = lane & 15, q = lane >> 4;
    const int g = wave >> 2, w = wave & 3, tA = w, tB = 7 - w;
    bf16_t* U = (bf16_t*)(p.ws + WS_U); const float* GATE = (const float*)(p.ws + WS_GATE);
    LAS float* aS = (LAS float*)(lds + ML_SC), *cmS = aS + 128, *bS = aS + 256, *nK = aS + 384, *ssx = aS + 512;
    const int R0 = 128 * j; const float mk = ((const float*)(p.ws + WS_MS))[h * NCH + j];
    u32x4 vreg[8], kn[4];
    mlstm_v_load(U, R0, h, tid, vreg);
#pragma unroll
    for (int it = 0; it < 4; ++it) { const int ci = tid + 512 * it, row = ci >> 4, ch = ci & 15; kn[it] = *(const u32x4*)(U + uoff(R0 + row, KM + h * 128 + 8 * ch)); }
    const int tokA = 16 * tA + lr, tokB = 16 * tB + lr;
    const size_t rowA = (size_t)(R0 + tokA) * 256, rowB = (size_t)(R0 + tokB) * 256;
    const size_t qoff = (size_t)((QM >> 8) + (h >> 1)) * UT + (h & 1) * 128 + 8 * q;
    bf16x8 qfA[4], qfB[4];
#pragma unroll
    for (int ks = 0; ks < 4; ++ks) { qfA[ks] = *(const bf16x8*)(U + rowA + qoff + 32 * ks); qfB[ks] = *(const bf16x8*)(U + rowB + qoff + 32 * ks); }
    if (wave == 0) {
        const float bi = p.bi[h], bfb = p.bf[h];
        const float gi0 = GATE[(size_t)(R0 + lane) * 16 + h] + bi, gi1 = GATE[(size_t)(R0 + 64 + lane) * 16 + h] + bi;
        const float lf0 = logsigmoidf_(GATE[(size_t)(R0 + lane) * 16 + 8 + h] + bfb), lf1 = logsigmoidf_(GATE[(size_t)(R0 + 64 + lane) * 16 + 8 + h] + bfb);
        const float c0 = scan_add(lf0, lane); const float tot0 = __shfl(c0, 63); const float c1 = scan_add(lf1, lane) + tot0;
        const float a0 = gi0 - c0, a1 = gi1 - c1;
        const float p0 = scan_max(a0, lane); const float t0 = __shfl(p0, 63); const float p1 = fmaxf(scan_max(a1, lane), t0);
        aS[lane] = a0; aS[64 + lane] = a1; cmS[lane] = fmaxf(mk, p0); cmS[64 + lane] = fmaxf(mk, p1); bS[lane] = c0; bS[64 + lane] = c1;
    } else if (wave < 3) { const int d = tid - 64; nK[d] = ((const float*)(p.ws + WS_NS))[(size_t)(h * NCH + j) * 128 + d]; }
    mlstm_v_store(lds, tid, vreg);
    {
        LAS bf16_t* KNw = (LAS bf16_t*)(lds + ML_T2);
#pragma unroll
        for (int it = 0; it < 4; ++it) { const int ci = tid + 512 * it, row = ci >> 4, ch = ci & 15; *(LAS u32x4*)(KNw + row * 136 + 8 * ch) = kn[it]; }
    }
    __syncthreads();
    const LAS bf16_t* VT = (const LAS bf16_t*)lds; const LAS bf16_t* KN = (const LAS bf16_t*)(lds + ML_T2);
    const float cmA = cmS[tokA], cmB = cmS[tokB];
    const float scaleA = __expf(mk - cmA), scaleB = __expf(mk - cmB), floA = __expf(-(bS[tokA] + cmA)), floB = __expf(-(bS[tokB] + cmB));
    float qnA = 0.f, qnB = 0.f;
#pragma unroll
    for (int ks = 0; ks < 4; ++ks)
#pragma unroll
        for (int i = 0; i < 8; ++i) { const float nv = nK[32 * ks + 8 * q + i]; qnA += bf2f((unsigned short)qfA[ks][i]) * nv; qnB += bf2f((unsigned short)qfB[ks][i]) * nv; }
    qnA += __shfl_xor(qnA, 16); qnA += __shfl_xor(qnA, 32); qnB += __shfl_xor(qnB, 16); qnB += __shfl_xor(qnB, 32);
    f32x4 accA[8], accB[8];
    const bf16_t* CS = (const bf16_t*)(p.ws + WS_CST) + (size_t)(h * NCH + j) * 256 * 128 + (size_t)(128 * g) * 128;
#pragma unroll
    for (int et = 0; et < 8; ++et) { accA[et] = (f32x4){0.f, 0.f, 0.f, 0.f}; accB[et] = accA[et]; }
#pragma unroll
    for (int ks = 0; ks < 4; ++ks) {
        bf16x8 ca[8];
#pragma unroll
        for (int et = 0; et < 8; ++et) ca[et] = *(const bf16x8*)(CS + (size_t)(16 * et + lr) * 128 + 32 * ks + 8 * q);
#pragma unroll
        for (int et = 0; et < 8; ++et) { accA[et] = MFMA16(ca[et], qfA[ks], accA[et]); accB[et] = MFMA16(ca[et], qfB[ks], accB[et]); }
    }
#pragma unroll
    for (int et = 0; et < 8; ++et) { accA[et] = accA[et] * scaleA; accB[et] = accB[et] * scaleB; }
    asm volatile("" ::: "memory");
    bf16x8 wfA[4], wfB[4]; float dsA, dsB;
    mlstm_sw_tile(KN, aS, qfA, tA, tokA, cmA, lr, q, wfA, dsA);
    mlstm_sw_tile(KN, aS, qfB, tB, tokB, cmB, lr, q, wfB, dsB);
#pragma unroll
    for (int u = 0; u < 4; ++u) {
        if (2 * u <= tB) {
#pragma unroll
            for (int et = 0; et < 8; ++et) { const LAS bf16_t* vp = VT + (32 * u + 4 * q + (lr >> 2)) * PV + 16 * (8 * g + et) + 4 * (lr & 3);
                const s16x4 lo = tr_read(vp), hi = tr_read(vp + 16 * PV); const bf16x8 vf = __builtin_shufflevector(lo, hi, 0, 1, 2, 3, 4, 5, 6, 7);
                accB[et] = MFMA16(vf, wfB[u], accB[et]);
                if (2 * u <= tA) accA[et] = MFMA16(vf, wfA[u], accA[et]); } }
    }
    asm volatile("" ::: "memory");
    dsA += __shfl_xor(dsA, 16); dsA += __shfl_xor(dsA, 32); dsB += __shfl_xor(dsB, 16); dsB += __shfl_xor(dsB, 32);
    const float invA = 1.0f / fmaxf(fabsf(scaleA * qnA + dsA), floA), invB = 1.0f / fmaxf(fabsf(scaleB * qnB + dsB), floB);
    float ssA = 0.f, ssB = 0.f;
#pragma unroll
    for (int et = 0; et < 8; ++et) { accA[et] = accA[et] * invA; accB[et] = accB[et] * invB;
        ssA += (accA[et][0] * accA[et][0] + accA[et][1] * accA[et][1]) + (accA[et][2] * accA[et][2] + accA[et][3] * accA[et][3]);
        ssB += (accB[et][0] * accB[et][0] + accB[et][1] * accB[et][1]) + (accB[et][2] * accB[et][2] + accB[et][3] * accB[et][3]); }
    ssA += __shfl_xor(ssA, 16); ssA += __shfl_xor(ssA, 32); ssB += __shfl_xor(ssB, 16); ssB += __shfl_xor(ssB, 32);
    if (q == 0) { ssx[((g * 4 + w) * 2 + 0) * 16 + lr] = ssA; ssx[((g * 4 + w) * 2 + 1) * 16 + lr] = ssB; }
    __syncthreads();
    const float rstdA = rsqrtf((ssA + ssx[(((g ^ 1) * 4 + w) * 2 + 0) * 16 + lr]) * (1.f / 256.f) + EPS);
    const float rstdB = rsqrtf((ssB + ssx[(((g ^ 1) * 4 + w) * 2 + 1) * 16 + lr]) * (1.f / 256.f) + EPS);
    const size_t ooff = (size_t)((OM >> 8) + h) * UT + 128 * g + 4 * q, zoff = (size_t)((ZM >> 8) + h) * UT + 128 * g + 4 * q;
#pragma unroll
    for (int T = 0; T < 2; ++T) {
        const size_t rowT = T ? rowB : rowA; const float rstd = T ? rstdB : rstdA; const int tok = T ? tokB : tokA;
        u32x2 ov[8], zv[8]; f32x4 gv[8];
#pragma unroll
        for (int et = 0; et < 8; ++et) { ov[et] = *(const u32x2*)(U + rowT + ooff + 16 * et); zv[et] = *(const u32x2*)(U + rowT + zoff + 16 * et); gv[et] = *(const f32x4*)(p.gmh + h * 256 + 128 * g + 16 * et + 4 * q); }
#pragma unroll
        for (int et = 0; et < 8; ++et) { const f32x4 a = T ? accB[et] : accA[et]; const u32x2 o = ov[et], z = zv[et]; const f32x4 gg = gv[et];
            u32x2 wv; wv.x = pk2(a[0] * rstd * gg[0] * sigmoidf_(bflo(o.x)) * siluf_(bflo(z.x)), a[1] * rstd * gg[1] * sigmoidf_(bfhi(o.x)) * siluf_(bfhi(z.x)));
            wv.y = pk2(a[2] * rstd * gg[2] * sigmoidf_(bflo(o.y)) * siluf_(bflo(z.y)), a[3] * rstd * gg[3] * sigmoidf_(bfhi(o.y)) * siluf_(bfhi(z.y)));
            if (dry) *(u32x2*)((bf16_t*)(p.ws + WS_XN) + (size_t)(R0 + tok) * DM + h * 256 + 128 * g + 16 * et + 4 * q) = wv; else *(u32x2*)(U + rowT + ooff + 16 * et) = wv; }
    }
    __syncthreads();
}

DI void skinny_core(f32x4 (&acc)[2][4], const bf16_t* A, size_t lda, size_t wstride, const bf16_t* Bt, int row0, int col0, int wave, int lr, int q) {
    const bf16_t* ap = A + (size_t)(row0 + lr) * lda + wstride * wave + 8 * q;
    const bf16_t* bp = Bt + (size_t)(col0 + lr) * 2048 + 256 * wave + 8 * q;
#pragma unroll 4
    for (int ks = 0; ks < 8; ++ks) {
        bf16x8 a[2], b[4];
#pragma unroll
        for (int rt = 0; rt < 2; ++rt) a[rt] = *(const bf16x8*)(ap + (size_t)rt * 16 * lda + 32 * ks);
#pragma unroll
        for (int ct = 0; ct < 4; ++ct) b[ct] = *(const bf16x8*)(bp + (size_t)ct * 16 * 2048 + 32 * ks);
#pragma unroll
        for (int rt = 0; rt < 2; ++rt)
#pragma unroll
            for (int ct = 0; ct < 4; ++ct) acc[rt][ct] = MFMA16(b[ct], a[rt], acc[rt][ct]);
    }
}
DI void skinny_put(LAS float* red, const f32x4 (&acc)[2][4], int slot, int lr, int q) {
#pragma unroll
    for (int rt = 0; rt < 2; ++rt)
#pragma unroll
        for (int ct = 0; ct < 4; ++ct) *(LAS f32x4*)(red + ((size_t)slot * 32 + 16 * rt + lr) * 64 + 16 * ct + 4 * q) = acc[rt][ct];
}
DI void skinny_merge(const Params& p, LAS unsigned char* lds) {
    const int tid = threadIdx.x, lane = tid & 63, wave = tid >> 6, lr = lane & 15, q = lane >> 4;
    const bf16_t* U = (const bf16_t*)(p.ws + WS_U); const bf16_t* WP = (const bf16_t*)(p.ws + WS_WP); bf16_t* MG = (bf16_t*)(p.ws + WS_XN);
    LAS float* red = (LAS float*)lds;
    for (int tile = blockIdx.x; tile < 256; tile += gridDim.x) {
        const int row0 = ROW_S + 32 * (tile >> 5), col0 = 64 * (tile & 31);
        f32x4 aa[2][4], am[2][4];
#pragma unroll
        for (int rt = 0; rt < 2; ++rt)
#pragma unroll
            for (int ct = 0; ct < 4; ++ct) { aa[rt][ct] = (f32x4){0.f, 0.f, 0.f, 0.f}; am[rt][ct] = (f32x4){0.f, 0.f, 0.f, 0.f}; }
        skinny_core(aa, U + (size_t)(QA >> 8) * UT, 256, UT, WP, row0, col0, wave, lr, q);
        skinny_core(am, U + (size_t)(OM >> 8) * UT, 256, UT, WP + (size_t)2048 * 2048, row0, col0, wave, lr, q);
        skinny_put(red, aa, wave * 2, lr, q); skinny_put(red, am, wave * 2 + 1, lr, q);
        __syncthreads();
        const int row = tid >> 4, c4 = (tid & 15) * 4;
        f32x4 ya = (f32x4){0.f, 0.f, 0.f, 0.f}, ym = ya;
#pragma unroll
        for (int w = 0; w < 8; ++w) { ya += *(const LAS f32x4*)(red + ((size_t)(2 * w) * 32 + row) * 64 + c4); ym += *(const LAS f32x4*)(red + ((size_t)(2 * w + 1) * 32 + row) * 64 + c4); }
        const size_t r = row0 + row; const int col = col0 + c4;
        const u32x2 ga = *(const u32x2*)(U + uoff((int)r, GA + col)), gm = *(const u32x2*)(U + uoff((int)r, GM + col));
        u32x2 w; w.x = pk2(sigmoidf_(bflo(ga.x)) * ya[0] + sigmoidf_(bflo(gm.x)) * ym[0], sigmoidf_(bfhi(ga.x)) * ya[1] + sigmoidf_(bfhi(gm.x)) * ym[1]);
        w.y = pk2(sigmoidf_(bflo(ga.y)) * ya[2] + sigmoidf_(bflo(gm.y)) * ym[2], sigmoidf_(bfhi(ga.y)) * ya[3] + sigmoidf_(bfhi(gm.y)) * ym[3]);
        *(u32x2*)(MG + r * DM + col) = w;
        __syncthreads();
    }
}
DI void skinny_out(const Params& p, LAS unsigned char* lds) {
    const int tid = threadIdx.x, lane = tid & 63, wave = tid >> 6, lr = lane & 15, q = lane >> 4;
    const bf16_t* MG = (const bf16_t*)(p.ws + WS_XN); const bf16_t* WO = (const bf16_t*)(p.ws + WS_WOUT); float* ssq = (float*)(p.ws + WS_SSQ);
    LAS float* red = (LAS float*)lds;
    for (int tile = blockIdx.x; tile < 256; tile += gridDim.x) {
        const int row0 = ROW_S + 32 * (tile >> 5), col0 = 64 * (tile & 31);
        f32x4 aa[2][4];
#pragma unroll
        for (int rt = 0; rt < 2; ++rt)
#pragma unroll
            for (int ct = 0; ct < 4; ++ct) aa[rt][ct] = (f32x4){0.f, 0.f, 0.f, 0.f};
        skinny_core(aa, MG, DM, 256, WO, row0, col0, wave, lr, q);
        skinny_put(red, aa, wave, lr, q);
        __syncthreads();
        const int row = tid >> 4, c4 = (tid & 15) * 4;
        f32x4 y = (f32x4){0.f, 0.f, 0.f, 0.f};
#pragma unroll
        for (int w = 0; w < 8; ++w) y += *(const LAS f32x4*)(red + ((size_t)w * 32 + row) * 64 + c4);
        const size_t r = row0 + row; const int col = col0 + c4;
        const f32x4 o = *(const f32x4*)(p.xs + (r - ROW_S) * DM + col) + y;
        { u32x2 w; w.x = pk2(o[0], o[1]); w.y = pk2(o[2], o[3]); *(u32x2*)((bf16_t*)(p.ws + WS_U) + uoff((int)r, col)) = w; }
        float ss = (o[0] * o[0] + o[1] * o[1]) + (o[2] * o[2] + o[3] * o[3]);
        ss += __shfl_xor(ss, 1); ss += __shfl_xor(ss, 2); ss += __shfl_xor(ss, 4); ss += __shfl_xor(ss, 8);
        if ((tid & 15) == 0) ssq[r * 32 + (tile & 31)] = ss;
        __syncthreads();
    }
}

DI void final_norm(const Params& p) {
    const int lane = threadIdx.x & 63, gw = blockIdx.x * 8 + (threadIdx.x >> 6), NGW = gridDim.x * 8;
    const float* ssq = (const float*)(p.ws + WS_SSQ); const bf16_t* X1 = (const bf16_t*)(p.ws + WS_U);
    for (int r = gw; r < MOUT; r += NGW) {
        u32x2 xv[8];
#pragma unroll
        for (int j = 0; j < 8; ++j) xv[j] = *(const u32x2*)(X1 + (size_t)j * UT + (size_t)r * 256 + 4 * lane);
        const float s = wsum(lane < 32 ? ssq[(size_t)r * 32 + lane] : 0.f);
        const float rstd = rsqrtf(s * (1.f / DM) + EPS);
        f32x4* o = (f32x4*)(p.out + (size_t)r * DM) + lane; const f32x4* g = (const f32x4*)p.gfinal + lane;
#pragma unroll
        for (int j = 0; j < 8; ++j) { const f32x4 gg = g[64 * j]; f32x4 v; v[0] = bflo(xv[j].x) * rstd * gg[0]; v[1] = bfhi(xv[j].x) * rstd * gg[1]; v[2] = bflo(xv[j].y) * rstd * gg[2]; v[3] = bfhi(xv[j].y) * rstd * gg[3]; o[64 * j] = v; }
    }
}

__global__ void __launch_bounds__(512, 2) mega(Params p) {
    extern __shared__ __attribute__((aligned(16))) unsigned char lds_raw[];
    LAS unsigned char* lds = (LAS unsigned char*)lds_raw;
    cg::grid_group grid = cg::this_grid();
    const int lo = p.ph_lo, hi = p.ph_hi;
#define IN(k) (lo <= (k) && (k) < hi)
#define STAMP(i) do { if (TPROBE >= 0 && blockIdx.x == 0 && threadIdx.x == 0) tsl[i] = __builtin_amdgcn_s_memrealtime(); } while (0)
#define SEAM(k) do { if (IN(k) && IN((k) + 1)) xcd_barrier(bar); STAMP((k) + 1); } while (0)
    volatile LAS unsigned long long* tsl = (volatile LAS unsigned long long*)(lds + 131072 + 1040);
    volatile LAS unsigned* bst = (volatile LAS unsigned*)(lds + 131072 + 1024);
    if (threadIdx.x < 2) bst[threadIdx.x] = 0u;
    __syncthreads();
    XcdBarrier bar = xcd_barrier_post((unsigned*)(p.ws + WS_BAR), bst);
    if (hi > 1000) grid.sync();
    bf16_t* U = (bf16_t*)(p.ws + WS_U);
    STAMP(0);
    if (IN(0)) for (int rep = 0; rep < REP0; ++rep) p0_prologue(p, lds);
    SEAM(0);
    if (IN(1)) for (int rep = 0; rep < REP1; ++rep) {
        pg8::Order S; S.init(MPAD / 256, NW / 256, gridDim.x, blockIdx.x, 0);
        S.A0 = S.A1 = (const char*)(p.ws + WS_XN); S.B0 = S.B1 = (const char*)(p.ws + WS_WIN); S.a_tstep = (size_t)256 * DM * 2; S.b_tstep = (size_t)256 * 2048 * 2;
        pg8::EpiU E{U, (float*)(p.ws + WS_GATE), p.out};
        pg8::gemm_phase<pg8::EpiU>(lds, 2048, DM, 512, S, E);
    }
    SEAM(1);
    if (IN(2)) {
        for (int rep = 0; rep < REP2; ++rep) { const int dry = rep + 1 < REP2;
        for (int it = blockIdx.x; it < 1224; it += gridDim.x) {
            if (it < 512) { if (!dry || (PSEL & 1)) attn_item(p, lds, 0, it >> 2, it & 3, dry); }
            else if (it < 576) { if (!dry || (PSEL & 1)) attn_item(p, lds, 1, (it - 512) >> 2, (it - 512) & 3, dry); }
            else if (it < 1088) { if (!dry || (PSEL & 2)) mlstm_sum_item(p, lds, (it - 576) & 7, (it - 576) >> 3); }
            else { if (!dry || (PSEL & 4)) mlstm_small_item(p, lds, (it - 1088) >> 3, (it - 1088) & 7, dry); }
        } }
    }
    SEAM(2);
    if (IN(3)) for (int rep = 0; rep < REP3; ++rep) mlstm_scan(p);
    for (int rep = 0; rep < REPSYNC; ++rep) xcd_barrier(bar);
    SEAM(3);
    if (IN(4)) for (int rep = 0; rep < REP4; ++rep) { for (int it = blockIdx.x; it < 512; it += gridDim.x) mlstm_out_item(p, lds, it & 7, it >> 3, rep + 1 < REP4); }
    SEAM(4);
    if (IN(5)) for (int rep = 0; rep < REP56; ++rep) {
        pg8::Order S; S.init(ROW_S / 256, DM / 256, gridDim.x, blockIdx.x, 1);
        S.A0 = (const char*)(U + (size_t)(QA >> 8) * UT); S.A1 = (const char*)(U + (size_t)(OM >> 8) * UT); S.B0 = (const char*)(p.ws + WS_WP); S.B1 = S.B0 + (size_t)2048 * 2048 * 2;
        S.a_tstep = (size_t)256 * 256 * 2; S.b_tstep = (size_t)256 * 2048 * 2;
        pg8::EpiMerge E{U, (bf16_t*)(p.ws + WS_XN)};
        const bool skinny_first = (blockIdx.x >> 3) & 1;
        if (skinny_first) skinny_merge(p, lds);
        pg8::gemm_phase<pg8::EpiMerge>(lds, 2048, 256, UT * 2, S, E);
        if (!skinny_first) skinny_merge(p, lds);
    }
    SEAM(5);
    if (IN(6)) for (int rep = 0; rep < REP56; ++rep) {
        pg8::Order S; S.init(ROW_S / 256, DM / 256, gridDim.x, blockIdx.x, 0);
        S.A0 = S.A1 = (const char*)(p.ws + WS_XN); S.B0 = S.B1 = (const char*)(p.ws + WS_WOUT); S.a_tstep = (size_t)256 * DM * 2; S.b_tstep = (size_t)256 * 2048 * 2;
        pg8::EpiOut E{p.xp, p.xs, U, (float*)(p.ws + WS_SSQ)};
        const bool skinny_first = (blockIdx.x >> 3) & 1;
        if (skinny_first) skinny_out(p, lds);
        pg8::gemm_phase<pg8::EpiOut>(lds, 2048, DM, 512, S, E);
        if (!skinny_first) skinny_out(p, lds);
    }
    SEAM(6);
    if (IN(7)) final_norm(p);
    if (TPROBE >= 0 && blockIdx.x == 0 && threadIdx.x == 0) { const unsigned long long te = __builtin_amdgcn_s_memrealtime(); tsl[8] = te;
        const unsigned long long d = tsl[TPROBE + 1] - tsl[TPROBE]; while (__builtin_amdgcn_s_memrealtime() - te < 9ull * d) __builtin_amdgcn_s_sleep(8); }
#undef IN
#undef SEAM
}

extern "C" void kernel_launch(void* const* d_in, const int* in_sizes, int n_in, void* d_out, int out_size, void* d_ws, size_t ws_size, hipStream_t stream) {
    static int grid = 0;
    if (grid == 0) {
        if (n_in != 18 || out_size != 22889608 || ws_size < WS_END) { fprintf(stderr, "kernel_launch: unexpected shapes (n_in %d out %d ws %zu need %zu)\n", n_in, out_size, ws_size, (size_t)WS_END); grid = -1; return; }
        int dev = 0, cus = 0, per_cu = 0;
        hipGetDevice(&dev); hipDeviceGetAttribute(&cus, hipDeviceAttributeMultiprocessorCount, dev);
        if (hipFuncSetAttribute((const void*)mega, hipFuncAttributeMaxDynamicSharedMemorySize, LDS_BYTES) != hipSuccess) { fprintf(stderr, "kernel_launch: hipFuncSetAttribute failed\n"); grid = -1; return; }
        if (hipOccupancyMaxActiveBlocksPerMultiprocessor(&per_cu, (const void*)mega, 512, LDS_BYTES) != hipSuccess || per_cu < 1) { fprintf(stderr, "kernel_launch: occupancy query says %d\n", per_cu); (void)hipGetLastError(); }
        grid = cus > 0 ? cus : 256;
    }
    if (grid < 0) return;
    Params p{};
    p.xp = (const float*)d_in[0]; p.xs = (const float*)d_in[1]; p.ck = (const float*)d_in[2]; p.cv = (const float*)d_in[3];
    p.sC = (const float*)d_in[4]; p.sn = (const float*)d_in[5]; p.sm = (const float*)d_in[6]; p.meta = (const float*)d_in[7];
    p.gnorm = (const float*)d_in[8]; p.win = (const float*)d_in[9]; p.bi = (const float*)d_in[10]; p.bf = (const float*)d_in[11];
    p.sinks = (const float*)d_in[12]; p.gmh = (const float*)d_in[13]; p.wpa = (const float*)d_in[14]; p.wpm = (const float*)d_in[15];
    p.wout = (const float*)d_in[16]; p.gfinal = (const float*)d_in[17];
    p.out = (float*)d_out; p.ws = (unsigned char*)d_ws;
#if N_LAUNCH == 1
    p.ph_lo = 0; p.ph_hi = 8;
    if (hipMemsetAsync((char*)d_ws + WS_BAR, 0, 16384, stream) != hipSuccess) { fprintf(stderr, "kernel_launch: memset failed\n"); return; }
    void* args[] = {&p};
    hipError_t e = hipLaunchCooperativeKernel((const void*)mega, dim3(grid), dim3(512), args, LDS_BYTES, stream);
    if (e != hipSuccess) fprintf(stderr, "cooperative launch failed: %s (grid %d)\n", hipGetErrorString(e), grid);
#else
    for (int ph = 0; ph < 8; ++ph) { p.ph_lo = ph; p.ph_hi = ph + 1; hipLaunchKernelGGL(mega, dim3(grid), dim3(512), LDS_BYTES, stream, p); }
#endif
}
```

```cpp
#include <hip/hip_runtime.h>
#include <hip/hip_cooperative_groups.h>
#include <cstdio>
#include <cstdint>
namespace cg = cooperative_groups;

#ifndef REP1
#define REP1 1
#endif
#ifndef REP3
#define REP3 1
#endif
#ifndef REP0
#define REP0 1
#endif
#ifndef REP2
#define REP2 1
#endif
#ifndef REP4
#define REP4 1
#endif
#ifndef PSEL
#define PSEL 7
#endif
#ifndef TPROBE
#define TPROBE -1
#endif
#ifndef REP56
#define REP56 1
#endif
#ifndef REPSYNC
#define REPSYNC 0
#endif
#ifndef N_LAUNCH
#define N_LAUNCH 1
#endif

#define LAS __attribute__((address_space(3)))
typedef unsigned short bf16_t;
typedef short bf16x8 __attribute__((ext_vector_type(8)));
typedef short s16x4 __attribute__((ext_vector_type(4)));
typedef float f32x4 __attribute__((ext_vector_type(4)));
typedef float f32x2 __attribute__((ext_vector_type(2)));
typedef unsigned u32x4 __attribute__((ext_vector_type(4)));
typedef unsigned u32x2 __attribute__((ext_vector_type(2)));
#define DI __device__ __forceinline__

constexpr int DM = 2048;
constexpr int ROW_S = 8192, ROW_M = 8448, MROWS = 8464, MPAD = 8704, MOUT = 8448;
constexpr int NU = 16896, NW = 17152;
constexpr size_t UT = (size_t)8704 * 256;
__device__ __forceinline__ size_t uoff(int row, int col) { return (size_t)(col >> 8) * UT + (size_t)row * 256 + (col & 255); }
constexpr int QA = 0, KA = 2048, VA = 2304, ZA = 2560, QM = 4608, KM = 5632, VM = 6656, OM = 8704, ZM = 10752, GA = 12800, GM = 14848;
constexpr int NCH = 64;
constexpr float EPS = 1e-6f;
constexpr size_t O_KP = 17301504, O_VP = 17334272, O_CP = 17367040, O_NP = 17629184, O_MP = 17630208,
                 O_KS = 17630216, O_VS = 18154504, O_CS = 18678792, O_NS = 22873096, O_MS = 22889480;
constexpr size_t WS_WIN = 4096;
constexpr size_t WS_WP = WS_WIN + (size_t)NW * 2048 * 2;
constexpr size_t WS_WOUT = WS_WP + (size_t)4096 * 2048 * 2;
constexpr size_t WS_XN = WS_WOUT + (size_t)2048 * 2048 * 2;
constexpr size_t WS_U = WS_XN + (size_t)MPAD * 2048 * 2;
constexpr size_t WS_GATE = WS_U + (size_t)MPAD * NU * 2;
constexpr size_t WS_UP = WS_GATE + (size_t)MPAD * 16 * 4;
constexpr size_t WS_CST = WS_UP + (size_t)8 * NCH * 256 * 128 * 4;
constexpr size_t WS_NP = WS_CST + (size_t)8 * NCH * 256 * 128 * 2;
constexpr size_t WS_NS = WS_NP + (size_t)8 * NCH * 128 * 4;
constexpr size_t WS_BS = WS_NS + (size_t)8 * NCH * 128 * 4;
constexpr size_t WS_ML = WS_BS + 4096;
constexpr size_t WS_MS = WS_ML + 4096;
constexpr size_t WS_C0 = WS_MS + 4096;
constexpr size_t WS_N0 = WS_C0 + (size_t)8 * 128 * 256 * 4;
constexpr size_t WS_M0 = WS_N0 + 4096;
constexpr size_t WS_SSQ = WS_M0 + 4096;
constexpr size_t WS_BAR = WS_SSQ + (size_t)MOUT * 32 * 4;
constexpr size_t WS_END = WS_BAR + 16384;
constexpr int LDS_BYTES = 131072 + 2048;

struct Params {
    const float *xp, *xs, *ck, *cv, *sC, *sn, *sm, *meta, *gnorm, *win, *bi, *bf, *sinks, *gmh, *wpa, *wpm, *wout, *gfinal;
    float* out; unsigned char* ws; int ph_lo, ph_hi;
};

DI float bf2f(unsigned short b) { return __uint_as_float(((unsigned)b) << 16); }
DI float bflo(unsigned w) { return __uint_as_float(w << 16); }
DI float bfhi(unsigned w) { return __uint_as_float(w & 0xffff0000u); }
DI unsigned pk2(float lo, float hi) { unsigned r; asm volatile("v_cvt_pk_bf16_f32 %0, %1, %2\n\ts_nop 1" : "=v"(r) : "v"(lo), "v"(hi)); return r; }
DI unsigned f2bf_c(float f) { const unsigned u = __float_as_uint(f); return (u + 0x7fffu + ((u >> 16) & 1u)) >> 16; }
DI float sigmoidf_(float x) { return 1.0f / (1.0f + __expf(-x)); }
DI float siluf_(float x) { return x / (1.0f + __expf(-x)); }
DI float logsigmoidf_(float x) { return fminf(x, 0.f) - log1pf(__expf(-fabsf(x))); }
DI float wsum(float v) {
#pragma unroll
    for (int o = 1; o < 64; o <<= 1) v += __shfl_xor(v, o);
    return v;
}
DI float wmax(float v) {
#pragma unroll
    for (int o = 1; o < 64; o <<= 1) v = fmaxf(v, __shfl_xor(v, o));
    return v;
}
DI float scan_add(float v, int lane) {
#pragma unroll
    for (int o = 1; o < 64; o <<= 1) { float t = __shfl_up(v, o); if (lane >= o) v += t; }
    return v;
}
DI float scan_max(float v, int lane) {
#pragma unroll
    for (int o = 1; o < 64; o <<= 1) { float t = __shfl_up(v, o); if (lane >= o) v = fmaxf(v, t); }
    return v;
}
#define ROWPTR(m) ((m) < ROW_S ? p.xp + (size_t)(m) * DM : ((m) < ROW_M ? p.xs + (size_t)((m) - ROW_S) * DM : p.meta + (size_t)((m) - ROW_M) * DM))
DI s16x4 tr_read(const LAS bf16_t* p) { return __builtin_amdgcn_ds_read_tr16_b64_v4i16((LAS s16x4*)p); }
#define LDS_WAIT() asm volatile("s_waitcnt lgkmcnt(0)" ::: "memory")
#define MFMA16(a, b, c) __builtin_amdgcn_mfma_f32_16x16x32_bf16((a), (b), (c), 0, 0, 0)

#define XB_TMO      128
#define XB_XCNT(j)  (256  + 64 * (j))
#define XB_XSUB(j)  (1280 + 64 * (j))
#define XB_XGEN(j)  (2304 + 64 * (j))
#define XB_TOP      3328
#define XB_TOPGEN   3392
#define XCD_BAR_WORDS 3456
#define XB_SPIN_CAP (1u << 18)
DI unsigned xb_ld(unsigned* p)              { return __hip_atomic_load(p, __ATOMIC_RELAXED, __HIP_MEMORY_SCOPE_AGENT); }
DI unsigned xb_add(unsigned* p, unsigned v) { return __hip_atomic_fetch_add(p, v, __ATOMIC_RELAXED, __HIP_MEMORY_SCOPE_AGENT); }
DI unsigned xb_xcc_id() { return (unsigned)__builtin_amdgcn_s_getreg((3 << 11) | 20) & 0xFu; }
#define XB_SPIN(cond, bar) do { unsigned _sp = 0; while (cond) { __builtin_amdgcn_s_sleep(1); \
    if ((++_sp & 255u) == 0u) { if (xb_ld(&(bar)[XB_TMO])) break; if (_sp > XB_SPIN_CAP) { atomicAdd(&(bar)[XB_TMO], 1u); break; } } } } while (0)
struct XcdBarrier { unsigned* bar; unsigned x; volatile LAS unsigned* st; };
DI XcdBarrier xcd_barrier_post(unsigned* bar, volatile LAS unsigned* st) {
    XcdBarrier b; b.bar = bar; b.x = xb_xcc_id(); b.st = st;
    if (threadIdx.x == 0) (void)xb_add(&bar[XB_XCNT(b.x)], 1u);
    return b;
}
DI void xcd_barrier_complete(unsigned* bar, unsigned x, unsigned& nloc, unsigned& nx) {
    const unsigned G = gridDim.x * gridDim.y * gridDim.z;
    unsigned sum, cnt, mine, sp = 0u;
    for (;;) {
        sum = 0u; cnt = 0u; mine = 0u;
#pragma unroll
        for (unsigned j = 0; j < 16; ++j) { const unsigned c = xb_ld(&bar[XB_XCNT(j)]); sum += c; cnt += (c > 0u) ? 1u : 0u; mine = (j == x) ? c : mine; }
        if (sum == G) break;
        __builtin_amdgcn_s_sleep(1);
        if ((++sp & 255u) == 0u) { if (xb_ld(&bar[XB_TMO])) break; if (sp > XB_SPIN_CAP) { atomicAdd(&bar[XB_TMO], 1u); break; } }
    }
    nloc = mine > 0u ? mine : 1u; nx = cnt > 0u ? cnt : 1u;
}
DI void xcd_barrier(const XcdBarrier& b) {
    asm volatile("s_waitcnt vmcnt(0)" ::: "memory");
    __syncthreads();
    if (threadIdx.x == 0) {
        unsigned* bar = b.bar;
        __builtin_amdgcn_s_waitcnt(0);
        unsigned nloc = b.st[0], nx = b.st[1];
        if (nloc == 0u) { xcd_barrier_complete(bar, b.x, nloc, nx); b.st[0] = nloc; b.st[1] = nx; }
        const unsigned old = xb_add(&bar[XB_XSUB(b.x)], 1u);
        const unsigned gen = old / nloc;
        if (old + 1u == (gen + 1u) * nloc) {
            __builtin_amdgcn_fence(__ATOMIC_RELEASE, "agent");
            asm volatile("s_waitcnt vmcnt(0)" ::: "memory");
            const unsigned og = xb_add(&bar[XB_TOP], 1u);
            const unsigned tg = og / nx;
            if (og + 1u == (tg + 1u) * nx) xb_add(&bar[XB_TOPGEN], 1u);
            else XB_SPIN(xb_ld(&bar[XB_TOPGEN]) == tg, bar);
            __builtin_amdgcn_fence(__ATOMIC_ACQUIRE, "agent");
            xb_add(&bar[XB_XGEN(b.x)], 1u);
            asm volatile("s_waitcnt vmcnt(0)" ::: "memory");
        } else {
            XB_SPIN(xb_ld(&bar[XB_XGEN(b.x)]) == gen, bar);
            __builtin_amdgcn_fence(__ATOMIC_ACQUIRE, "agent");
            asm volatile("s_waitcnt vmcnt(0)" ::: "memory");
        }
    }
    __syncthreads();
}

namespace pg8 {
constexpr int BM = 256, BK = 64, HALF = 128, HTB = HALF * BK * 2, STAGE_BYTES = 8 * HTB, NXCD = 8, WGM = 4;
DI int lds_byte(int r, int c) { const int st = (r >> 4) * 2 + (c >> 5), rr = r & 15, cc = c & 31, ob = rr * 64 + cc * 2; return st * 1024 + (ob ^ (((ob >> 9) & 1) << 5)); }
DI void stage_rc(int b, int& R, int& C) { const int st = b / 1024, sb = b % 1024, swz = sb ^ (((sb >> 9) & 1) << 5); R = (st >> 1) * 16 + swz / 64; C = (st & 1) * 32 + (swz % 64) / 2; }
DI int perm32(int rho) { const int n = rho >> 4, i = rho & 15; return 8 * (i >> 2) + 4 * n + (i & 3); }

struct Unit { int pm, pn, sub; };

struct Order {
    int nM, nN, nwg, G, c, pair;
    const char *A0, *A1, *B0, *B1; size_t a_tstep, b_tstep;
    DI void init(int nM_, int nN_, int G_, int c_, int pair_) { nM = nM_; nN = nN_; nwg = nM * nN; G = G_; c = c_; pair = pair_; }
    DI bool next(int i, Unit& u) const {
        const int t = pair ? (i >> 1) : i; u.sub = pair ? (i & 1) : 0;
        const long L = (long)t * G + c; if (L >= nwg) return false;
        int wgid = (int)L; { const int q = nwg / NXCD, r = nwg % NXCD, xcd = wgid % NXCD, off = wgid / NXCD; wgid = (xcd < r ? xcd * (q + 1) : r * (q + 1) + (xcd - r) * q) + off; }
        const int nig = WGM * nN, gid = wgid / nig, fm = gid * WGM, gsz = (nM - fm) < WGM ? (nM - fm) : WGM;
        u.pm = fm + ((wgid % nig) % gsz); u.pn = (wgid % nig) / gsz; return true;
    }
    DI const char* a_ptr(const Unit& u) const { return (u.sub ? A1 : A0) + (size_t)u.pm * a_tstep; }
    DI const char* b_ptr(const Unit& u) const { return (u.sub ? B1 : B0) + (size_t)u.pn * b_tstep; }
};

template <class Epi>
DI void gemm_phase(LAS unsigned char* lds, const int K, const int lda, const size_t a_kblk, const Order& S, const Epi& E) {
#define PG8_AK(x) ((size_t)((x) >> 2) * a_kblk + (size_t)((x) & 3) * 128)
    const int tid = threadIdx.x, wid = __builtin_amdgcn_readfirstlane(tid >> 6), lane = tid & 63, wr = wid >> 2, wc = wid & 3, fr = lane & 15, fq = lane >> 4;
    const int nt = K / BK;
    unsigned voffA[2], voffB[2];
#pragma unroll
    for (int i = 0; i < 2; ++i) { int R, C; stage_rc(tid * 16 + i * 8192, R, C); const int Rb = Epi::PERM ? ((R & ~31) + perm32(R & 31)) : R;
        voffA[i] = (unsigned)(R * lda + C) * 2u; voffB[i] = (unsigned)(Rb * K + C) * 2u; }
    const size_t kstep = (size_t)(BK * 2);
    const size_t hstepA = (size_t)HALF * lda * 2, hstepB = (size_t)HALF * K * 2;
    const unsigned ldsw = (unsigned)wid * 1024u;
    const int aoff = lds_byte(wr * 64 + fr, fq * 8), boff = lds_byte(wc * 32 + fr, fq * 8);
#define PG8_SA(b, h) (((b) * 2 + (h)) * HTB)
#define PG8_SB(b, h) ((4 + (b) * 2 + (h)) * HTB)
#define PG8_STAGE(bufoff, gbase, voff) do { _Pragma("unroll") for (int _i = 0; _i < 2; ++_i) \
        __builtin_amdgcn_global_load_lds((const unsigned*)((const char*)(gbase) + (voff)[_i]), (LAS unsigned*)(lds + (bufoff) + ldsw + _i * 8192), 16, 0, 0); } while (0)
#define PG8_LDA(dst, b, h) do { _Pragma("unroll") for (int m = 0; m < 4; ++m) _Pragma("unroll") for (int k = 0; k < 2; ++k) dst[m][k] = *(const LAS bf16x8*)(lds + PG8_SA(b, h) + aoff + m * 2048 + k * 1024); } while (0)
#define PG8_LDB(dst, b, h) do { _Pragma("unroll") for (int n = 0; n < 2; ++n) _Pragma("unroll") for (int k = 0; k < 2; ++k) dst[n][k] = *(const LAS bf16x8*)(lds + PG8_SB(b, h) + boff + n * 2048 + k * 1024); } while (0)
#define PG8_MMA(ai, bj, At, Bt) do { __builtin_amdgcn_s_setprio(1); _Pragma("unroll") for (int m = 0; m < 4; ++m) _Pragma("unroll") for (int n = 0; n < 2; ++n) _Pragma("unroll") for (int k = 0; k < 2; ++k) \
        acc[ai][bj][m][n] = __builtin_amdgcn_mfma_f32_16x16x32_bf16(Bt[n][k], At[m][k], acc[ai][bj][m][n], 0, 0, 0); __builtin_amdgcn_s_setprio(0); } while (0)
#define PG8_WAIT_V(n) asm volatile("s_waitcnt vmcnt(" #n ")" ::: "memory")
#define PG8_WAIT_L(n) asm volatile("s_waitcnt lgkmcnt(" #n ")" ::: "memory")
#define PG8_BAR __builtin_amdgcn_s_barrier()
#define PG8_SCHED __builtin_amdgcn_sched_barrier(0)
    Unit cur, nxt; int ui = 0;
    if (!S.next(0, cur)) return;
    f32x4 acc[2][2][4][2];
#pragma unroll
    for (int a = 0; a < 2; ++a)
#pragma unroll
        for (int b = 0; b < 2; ++b)
#pragma unroll
            for (int m = 0; m < 4; ++m)
#pragma unroll
                for (int n = 0; n < 2; ++n) acc[a][b][m][n] = (f32x4){0.f, 0.f, 0.f, 0.f};
    bf16x8 At[4][2], B0[2][2], B1[2][2];
    const char* cA = S.a_ptr(cur); const char* cB = S.b_ptr(cur);
    PG8_STAGE(PG8_SB(0, 0), cB, voffB); PG8_STAGE(PG8_SB(0, 1), cB + hstepB, voffB); PG8_STAGE(PG8_SA(0, 0), cA, voffA); PG8_STAGE(PG8_SA(0, 1), cA + hstepA, voffA);
    if (wr == 1) PG8_BAR;
    PG8_WAIT_V(2); PG8_BAR;
    PG8_STAGE(PG8_SB(1, 0), cB + kstep, voffB); PG8_STAGE(PG8_SA(1, 0), cA + kstep, voffA); PG8_STAGE(PG8_SB(1, 1), cB + hstepB + kstep, voffB);
    PG8_WAIT_V(6); PG8_BAR;
    for (;;) {
        const bool has_next = S.next(ui + 1, nxt);
        const char* nA = has_next ? S.a_ptr(nxt) : cA; const char* nB = has_next ? S.b_ptr(nxt) : cB;
        for (int t = 0; t < nt; t += 2) {
            const bool last = (t == nt - 2);
            const char* a1 = cA + PG8_AK(t + 1);
            const char* a2 = last ? nA : cA + PG8_AK(t + 2); const char* b2 = last ? nB : cB + (size_t)(t + 2) * kstep;
            const char* a3 = a2 + kstep; const char* b3 = b2 + kstep;
            PG8_LDB(B0, 0, 0); PG8_LDB(B1, 0, 1); PG8_SCHED; PG8_LDA(At, 0, 0); PG8_STAGE(PG8_SA(1, 1), a1 + hstepA, voffA);
            PG8_WAIT_V(8); PG8_WAIT_L(0); PG8_BAR; PG8_MMA(0, 0, At, B0); PG8_MMA(0, 1, At, B1); PG8_BAR; PG8_SCHED;
            PG8_LDA(At, 0, 1); PG8_STAGE(PG8_SB(0, 0), b2, voffB); PG8_STAGE(PG8_SB(0, 1), b2 + hstepB, voffB); PG8_STAGE(PG8_SA(0, 0), a2, voffA);
            PG8_WAIT_V(8); PG8_WAIT_L(0); PG8_BAR; PG8_MMA(1, 0, At, B0); PG8_MMA(1, 1, At, B1); PG8_BAR; PG8_SCHED;
            PG8_LDB(B0, 1, 0); PG8_LDB(B1, 1, 1); PG8_SCHED; PG8_LDA(At, 1, 0); PG8_STAGE(PG8_SA(0, 1), a2 + hstepA, voffA);
            PG8_WAIT_V(8); PG8_WAIT_L(0); PG8_BAR; PG8_MMA(0, 0, At, B0); PG8_MMA(0, 1, At, B1); PG8_BAR; PG8_SCHED;
            PG8_LDA(At, 1, 1); PG8_STAGE(PG8_SB(1, 0), b3, voffB); PG8_STAGE(PG8_SB(1, 1), b3 + hstepB, voffB); PG8_STAGE(PG8_SA(1, 0), a3, voffA);
            PG8_WAIT_V(8); PG8_WAIT_L(0); PG8_BAR; PG8_MMA(1, 0, At, B0); PG8_MMA(1, 1, At, B1); PG8_BAR; PG8_SCHED;
        }
        if (wr == 0) PG8_BAR;
        E(acc, cur, wr, wc, fr, fq);
        if (!has_next) break;
#pragma unroll
        for (int a = 0; a < 2; ++a)
#pragma unroll
            for (int b = 0; b < 2; ++b)
#pragma unroll
                for (int m = 0; m < 4; ++m)
#pragma unroll
                    for (int n = 0; n < 2; ++n) acc[a][b][m][n] = (f32x4){0.f, 0.f, 0.f, 0.f};
        cur = nxt; cA = nA; cB = nB; ++ui;
        if (wr == 1) PG8_BAR;
    }
    PG8_WAIT_V(0);
    PG8_BAR;
#undef PG8_AK
#undef PG8_SA
#undef PG8_SB
#undef PG8_STAGE
#undef PG8_LDA
#undef PG8_LDB
#undef PG8_MMA
#undef PG8_WAIT_V
#undef PG8_WAIT_L
#undef PG8_BAR
#undef PG8_SCHED
}

struct EpiU {
    static constexpr bool PERM = true;
    bf16_t* U; float* gate; float* out;
    DI void operator()(const f32x4 (&acc)[2][2][4][2], const Unit& u, int wr, int wc, int fr, int fq) const {
        const int row0 = u.pm * BM + wr * 64 + fr, pn = u.pn;
        if (pn == 66) {
            if (wc == 0 && fq < 2) {
#pragma unroll
                for (int ai = 0; ai < 2; ++ai)
#pragma unroll
                    for (int m = 0; m < 4; ++m) { float* g = gate + (size_t)(row0 + ai * HALF + m * 16) * 16 + 8 * fq;
                        *(f32x4*)g = acc[ai][0][m][0]; *(f32x4*)(g + 4) = acc[ai][0][m][1]; }
            }
            return;
        }
        const float scale = (pn < 8) ? 0.18033688011112042f : ((pn >= 22 && pn < 26) ? 0.08838834764831845f : 1.0f);
        const int col0 = pn * BM + wc * 32 + 8 * fq;
#pragma unroll
        for (int ai = 0; ai < 2; ++ai)
#pragma unroll
            for (int m = 0; m < 4; ++m) { bf16_t* rowp = U + (size_t)pn * UT + (size_t)(row0 + ai * HALF + m * 16) * 256 + (wc * 32 + 8 * fq);
#pragma unroll
                for (int bj = 0; bj < 2; ++bj) { const f32x4 v0 = acc[ai][bj][m][0] * scale, v1 = acc[ai][bj][m][1] * scale;
                    u32x4 w; w.x = pk2(v0[0], v0[1]); w.y = pk2(v0[2], v0[3]); w.z = pk2(v1[0], v1[1]); w.w = pk2(v1[2], v1[3]);
                    *(u32x4*)(rowp + bj * HALF) = w; } }
        if (pn == 8 || pn == 9) {
#pragma unroll
            for (int ai = 0; ai < 2; ++ai)
#pragma unroll
                for (int m = 0; m < 4; ++m) { const int r = row0 + ai * HALF + m * 16; float* dst = nullptr;
                    if (r >= 8064 && r < 8192) dst = out + (pn == 8 ? O_KP : O_VP) + (size_t)(r - 8064) * 256;
                    else if (r >= 8192 && r < 8448) { const int b = (r - 8192) >> 4, t = (r - 8192) & 15; dst = out + (pn == 8 ? O_KS : O_VS) + (size_t)(b * 128 + 112 + t) * 256; }
                    if (dst) {
#pragma unroll
                        for (int bj = 0; bj < 2; ++bj) { const int c = bj * HALF + wc * 32 + 8 * fq; *(f32x4*)(dst + c) = acc[ai][bj][m][0]; *(f32x4*)(dst + c + 4) = acc[ai][bj][m][1]; } } }
        }
    }
};
struct EpiMerge {
    static constexpr bool PERM = true;
    const bf16_t* U; bf16_t* MG;
    DI void operator()(const f32x4 (&acc)[2][2][4][2], const Unit& u, int wr, int wc, int fr, int fq) const {
        const int row0 = u.pm * BM + wr * 64 + fr, col0 = u.pn * BM + wc * 32 + 8 * fq; const int gcol = u.sub ? GM : GA;
#pragma unroll
        for (int ai = 0; ai < 2; ++ai) {
            u32x4 g[4][2], o[4][2];
#pragma unroll
            for (int m = 0; m < 4; ++m)
#pragma unroll
                for (int bj = 0; bj < 2; ++bj) { const int r = row0 + ai * HALF + m * 16, c = col0 + bj * HALF;
                    g[m][bj] = *(const u32x4*)(U + uoff(r, gcol + c));
                    o[m][bj] = u.sub ? *(const u32x4*)(MG + (size_t)r * DM + c) : (u32x4){0u, 0u, 0u, 0u}; }
#pragma unroll
            for (int m = 0; m < 4; ++m)
#pragma unroll
                for (int bj = 0; bj < 2; ++bj) { const int r = row0 + ai * HALF + m * 16, c = col0 + bj * HALF;
                    const u32x4 gg = g[m][bj], oo = o[m][bj]; const f32x4 a0 = acc[ai][bj][m][0], a1 = acc[ai][bj][m][1];
                    float v[8];
                    v[0] = sigmoidf_(bflo(gg.x)) * a0[0] + bflo(oo.x); v[1] = sigmoidf_(bfhi(gg.x)) * a0[1] + bfhi(oo.x); v[2] = sigmoidf_(bflo(gg.y)) * a0[2] + bflo(oo.y); v[3] = sigmoidf_(bfhi(gg.y)) * a0[3] + bfhi(oo.y);
                    v[4] = sigmoidf_(bflo(gg.z)) * a1[0] + bflo(oo.z); v[5] = sigmoidf_(bfhi(gg.z)) * a1[1] + bfhi(oo.z); v[6] = sigmoidf_(bflo(gg.w)) * a1[2] + bflo(oo.w); v[7] = sigmoidf_(bfhi(gg.w)) * a1[3] + bfhi(oo.w);
                    u32x4 w; w.x = pk2(v[0], v[1]); w.y = pk2(v[2], v[3]); w.z = pk2(v[4], v[5]); w.w = pk2(v[6], v[7]);
                    *(u32x4*)(MG + (size_t)r * DM + c) = w; }
        }
    }
};
struct EpiOut {
    static constexpr bool PERM = false;
    const float *xp, *xs; bf16_t* X1; float* ssq;
    DI void operator()(const f32x4 (&acc)[2][2][4][2], const Unit& u, int wr, int wc, int fr, int fq) const {
        const int row0 = u.pm * BM + wr * 64 + fr, col0 = u.pn * BM + wc * 32 + 4 * fq;
#pragma unroll
        for (int ai = 0; ai < 2; ++ai) {
            f32x4 xv[4][2][2];
#pragma unroll
            for (int m = 0; m < 4; ++m) { const int r = row0 + ai * HALF + m * 16; const float* xrow = (r < ROW_S) ? xp + (size_t)r * DM : xs + (size_t)(r - ROW_S) * DM;
#pragma unroll
                for (int bj = 0; bj < 2; ++bj)
#pragma unroll
                    for (int n = 0; n < 2; ++n) xv[m][bj][n] = *(const f32x4*)(xrow + col0 + bj * HALF + n * 16); }
#pragma unroll
            for (int m = 0; m < 4; ++m) { const int r = row0 + ai * HALF + m * 16; bf16_t* orow = X1 + (size_t)u.pn * UT + (size_t)r * 256 + wc * 32 + 4 * fq; float ss = 0.f;
#pragma unroll
                for (int bj = 0; bj < 2; ++bj)
#pragma unroll
                    for (int n = 0; n < 2; ++n) { const f32x4 o = xv[m][bj][n] + acc[ai][bj][m][n];
                        u32x2 w; w.x = pk2(o[0], o[1]); w.y = pk2(o[2], o[3]); *(u32x2*)(orow + bj * HALF + n * 16) = w; ss += (o[0] * o[0] + o[1] * o[1]) + (o[2] * o[2] + o[3] * o[3]); }
                ss += __shfl_xor(ss, 16); ss += __shfl_xor(ss, 32);
                if (fq == 0) ssq[(size_t)r * 32 + u.pn * 4 + wc] = ss; }
        }
    }
};
}

DI int win_src_col(int n) { return n < 10752 ? n : (n < 16896 ? n + 16 : (n < 16912 ? 10752 + (n - 16896) : -1)); }

DI void p0_transpose_item(const float* W, int Nsrc, int srccol4, bf16_t* WT, int dstrow0, int k0, LAS float* scr, int lane) {
    f32x4 r[8];
#pragma unroll
    for (int i = 0; i < 8; ++i) { const int kk = (lane >> 3) + 8 * i; r[i] = (srccol4 >= 0) ? *(const f32x4*)(W + (size_t)(k0 + kk) * Nsrc + srccol4) : (f32x4){0.f, 0.f, 0.f, 0.f}; }
#pragma unroll
    for (int i = 0; i < 8; ++i) { const int kk = (lane >> 3) + 8 * i; LAS float* d = scr + kk * 33 + 4 * (lane & 7); d[0] = r[i][0]; d[1] = r[i][1]; d[2] = r[i][2]; d[3] = r[i][3]; }
    LDS_WAIT();
    const int c = lane & 7;
#pragma unroll
    for (int j = 0; j < 4; ++j) { const int n = (lane >> 3) + 8 * j; const LAS float* s = scr + (8 * c) * 33 + n;
        u32x4 o; o.x = pk2(s[0 * 33], s[1 * 33]); o.y = pk2(s[2 * 33], s[3 * 33]); o.z = pk2(s[4 * 33], s[5 * 33]); o.w = pk2(s[6 * 33], s[7 * 33]);
        *(u32x4*)(WT + (size_t)(dstrow0 + n) * 2048 + k0 + 8 * c) = o; }
    LDS_WAIT();
}

DI void p0_prologue(const Params& p, LAS unsigned char* lds) {
    const int tid = threadIdx.x, lane = tid & 63, wave = tid >> 6;
    const int gw = blockIdx.x * 8 + wave, NGW = gridDim.x * 8;
    bf16_t* WIN = (bf16_t*)(p.ws + WS_WIN); bf16_t* WP = (bf16_t*)(p.ws + WS_WP); bf16_t* WOUT = (bf16_t*)(p.ws + WS_WOUT); bf16_t* XN = (bf16_t*)(p.ws + WS_XN);
    LAS float* scr = (LAS float*)(lds + wave * 16384);
    constexpr int I_IN = 32 * (NW / 32), I_SQ = 32 * 64;
    for (int it = gw; it < I_IN + 3 * I_SQ; it += NGW) {
        int r = it;
        if (r < I_IN) { const int nb = r % (NW / 32), kb = r / (NW / 32); p0_transpose_item(p.win, 16912, win_src_col(nb * 32 + 4 * (lane & 7)), WIN, nb * 32, kb * 64, scr, lane); continue; }
        r -= I_IN; const int which = r / I_SQ; r -= which * I_SQ; const int nb = r % 64, kb = r / 64;
        const float* W = which == 0 ? p.wpa : (which == 1 ? p.wpm : p.wout);
        bf16_t* WT = which == 2 ? WOUT : WP; const int drow = (which == 1 ? 2048 : 0) + nb * 32;
        p0_transpose_item(W, 2048, nb * 32 + 4 * (lane & 7), WT, drow, kb * 64, scr, lane);
    }
    for (int m = gw; m < MPAD; m += NGW) {
        u32x2* o8 = (u32x2*)(XN + (size_t)m * DM) + lane;
        if (m >= MROWS) {
#pragma unroll
            for (int j = 0; j < 8; ++j) o8[64 * j] = (u32x2){0u, 0u};
            continue; }
        const float* xrow = m < ROW_S ? p.xp + (size_t)m * DM : (m < ROW_M ? p.xs + (size_t)(m - ROW_S) * DM : p.meta + (size_t)(m - ROW_M) * DM);
        const f32x4* xr = (const f32x4*)xrow + lane; const f32x4* gr = (const f32x4*)p.gnorm + lane;
        f32x4 v[8]; float s = 0.f;
#pragma unroll
        for (int j = 0; j < 8; ++j) { v[j] = xr[64 * j]; s += (v[j][0] * v[j][0] + v[j][1] * v[j][1]) + (v[j][2] * v[j][2] + v[j][3] * v[j][3]); }
        const float rstd = rsqrtf(wsum(s) * (1.f / DM) + EPS);
#pragma unroll
        for (int j = 0; j < 8; ++j) { const f32x4 g = gr[64 * j]; u32x2 w; w.x = pk2(v[j][0] * rstd * g[0], v[j][1] * rstd * g[1]); w.y = pk2(v[j][2] * rstd * g[2], v[j][3] * rstd * g[3]); o8[64 * j] = w; }
    }
    const int gt = blockIdx.x * 512 + tid, NGT = gridDim.x * 512;
    for (int i = gt; i < 2 * 16 * 112 * 64; i += NGT) {
        const int kv = i / (16 * 112 * 64); int r = i - kv * (16 * 112 * 64); const int b = r / (112 * 64); r -= b * (112 * 64);
        const f32x4* src = (const f32x4*)((kv ? p.cv : p.ck) + (size_t)(b * 128 + 16) * 256) + r;
        f32x4* dst = (f32x4*)(p.out + (kv ? O_VS : O_KS) + (size_t)(b * 128) * 256) + r;
        *dst = *src;
    }
}

DI u32x4 attn_fetch8(const Params& p, const bf16_t* U, int kind, int bidx, int g, int key, int ch, int colbase, const float* cache) {
    u32x4 z = (u32x4){0u, 0u, 0u, 0u};
    if (key < 16) return *(const u32x4*)(U + uoff(ROW_M + key, colbase + g * 64 + 8 * ch));
    if (kind == 0) {
        const int row = 64 * (bidx - 2) + (key - 16);
        if (key < 208 && row >= 0) return *(const u32x4*)(U + uoff(row, colbase + g * 64 + 8 * ch));
        return z;
    } else {
        if (key < 144) { const float* s = cache + ((size_t)(bidx * 128 + (key - 16)) * 4 + g) * 64 + 8 * ch; const f32x4 a = *(const f32x4*)s, b = *(const f32x4*)(s + 4);
            u32x4 w; w.x = pk2(a[0], a[1]); w.y = pk2(a[2], a[3]); w.z = pk2(b[0], b[1]); w.w = pk2(b[2], b[3]); return w; }
        if (key < 160) return *(const u32x4*)(U + uoff(ROW_S + 16 * bidx + (key - 144), colbase + g * 64 + 8 * ch));
        return z;
    }
}
DI void attn_item(const Params& p, LAS unsigned char* lds, int kind, int bidx, int g, int dry) {
    int tid_ = threadIdx.x; asm volatile("" : "+v"(tid_)); const int tid = tid_, lane = tid & 63, wave = tid >> 6, lr = lane & 15, q = lane >> 4;
    bf16_t* U = (bf16_t*)(p.ws + WS_U);
    LAS bf16_t* KAl = (LAS bf16_t*)lds; LAS bf16_t* VAl = (LAS bf16_t*)(lds + 32256);
    const int hq = 8 * g + wave; const float sink = p.sinks[hq] * 1.4426950408889634f;
    const int npair = kind == 0 ? 2 : 1, qrow0 = kind == 0 ? 64 * bidx : ROW_S + 16 * bidx;
    const int hi_t = kind == 0 ? 13 : 10; const int lo_t = kind == 0 ? 1 + (bidx < 2 ? 4 * (2 - bidx) : 0) : 1;
    u32x4 kreg[4], vreg[4];
#pragma unroll
    for (int i = 0; i < 4; ++i) { const int ci = tid + 512 * i; kreg[i] = (u32x4){0u, 0u, 0u, 0u}; vreg[i] = kreg[i];
        if (ci < 224 * 8) { kreg[i] = attn_fetch8(p, U, kind, bidx, g, ci >> 3, ci & 7, KA, p.ck); vreg[i] = attn_fetch8(p, U, kind, bidx, g, ci >> 3, ci & 7, VA, p.cv); } }
#pragma unroll
    for (int i = 0; i < 4; ++i) { const int ci = tid + 512 * i; if (ci < 224 * 8) { *(LAS u32x4*)(KAl + (ci >> 3) * 72 + 8 * (ci & 7)) = kreg[i]; *(LAS u32x4*)(VAl + (ci >> 3) * 72 + 8 * (ci & 7)) = vreg[i]; } }
    __syncthreads();
    for (int pr = 0; pr < npair; ++pr) {
        const int tA = 2 * pr, tB = kind == 0 ? 2 * pr + 1 : 0;
        const size_t rowA = (size_t)(qrow0 + 16 * tA + lr) * 256 + (size_t)(hq >> 2) * UT + (hq & 3) * 64, rowB = (size_t)(qrow0 + 16 * tB + lr) * 256 + (size_t)(hq >> 2) * UT + (hq & 3) * 64;
        constexpr size_t ZOFF = (size_t)(ZA >> 8) * UT;
        bf16x8 qa[2], qb[2]; u32x2 za[4], zb[4];
#pragma unroll
        for (int ks = 0; ks < 2; ++ks) { qa[ks] = *(const bf16x8*)(U + rowA + 32 * ks + 8 * q); qb[ks] = *(const bf16x8*)(U + rowB + 32 * ks + 8 * q); }
#pragma unroll
        for (int dt = 0; dt < 4; ++dt) { za[dt] = *(const u32x2*)(U + rowA + ZOFF + 16 * dt + 4 * q); zb[dt] = *(const u32x2*)(U + rowB + ZOFF + 16 * dt + 4 * q); }
        f32x4 accA[14], accB[14];
        float mxA = -1e30f, mxB = -1e30f;
#pragma unroll
        for (int kt = 0; kt < 14; ++kt) {
            if (kt == 0 || (kt >= lo_t && kt < hi_t)) {
                accA[kt] = (f32x4){0.f, 0.f, 0.f, 0.f}; accB[kt] = accA[kt];
#pragma unroll
                for (int ks = 0; ks < 2; ++ks) { const bf16x8 a = *(const LAS bf16x8*)(KAl + (16 * kt + lr) * 72 + 32 * ks + 8 * q); accA[kt] = MFMA16(a, qa[ks], accA[kt]); accB[kt] = MFMA16(a, qb[ks], accB[kt]); }
                mxA = fmaxf(mxA, fmaxf(fmaxf(accA[kt][0], accA[kt][1]), fmaxf(accA[kt][2], accA[kt][3])));
                mxB = fmaxf(mxB, fmaxf(fmaxf(accB[kt][0], accB[kt][1]), fmaxf(accB[kt][2], accB[kt][3])));
            } else { accA[kt] = (f32x4){-1e30f, -1e30f, -1e30f, -1e30f}; accB[kt] = accA[kt]; }
        }
        mxA = fmaxf(mxA, __shfl_xor(mxA, 16)); mxA = fmaxf(mxA, __shfl_xor(mxA, 32)); mxB = fmaxf(mxB, __shfl_xor(mxB, 16)); mxB = fmaxf(mxB, __shfl_xor(mxB, 32));
        const float MA = fmaxf(mxA, sink), MB = fmaxf(mxB, sink); float sumA = 0.f, sumB = 0.f;
#pragma unroll
        for (int kt = 0; kt < 14; ++kt)
#pragma unroll
            for (int j = 0; j < 4; ++j) { const float ea = __builtin_amdgcn_exp2f(accA[kt][j] - MA), eb = __builtin_amdgcn_exp2f(accB[kt][j] - MB); accA[kt][j] = ea; accB[kt][j] = eb; sumA += ea; sumB += eb; }
        sumA += __shfl_xor(sumA, 16); sumA += __shfl_xor(sumA, 32); sumB += __shfl_xor(sumB, 16); sumB += __shfl_xor(sumB, 32);
        const float invA = 1.0f / (sumA + __builtin_amdgcn_exp2f(sink - MA)), invB = 1.0f / (sumB + __builtin_amdgcn_exp2f(sink - MB));
        bf16x8 pA[7], pB[7];
#pragma unroll
        for (int u = 0; u < 7; ++u) { u32x4 w; w.x = pk2(accA[2 * u][0], accA[2 * u][1]); w.y = pk2(accA[2 * u][2], accA[2 * u][3]);
            w.z = pk2(accA[2 * u + 1][0], accA[2 * u + 1][1]); w.w = pk2(accA[2 * u + 1][2], accA[2 * u + 1][3]); pA[u] = __builtin_bit_cast(bf16x8, w);
            w.x = pk2(accB[2 * u][0], accB[2 * u][1]); w.y = pk2(accB[2 * u][2], accB[2 * u][3]);
            w.z = pk2(accB[2 * u + 1][0], accB[2 * u + 1][1]); w.w = pk2(accB[2 * u + 1][2], accB[2 * u + 1][3]); pB[u] = __builtin_bit_cast(bf16x8, w); }
        f32x4 oA[4], oB[4];
#pragma unroll
        for (int dt = 0; dt < 4; ++dt) { oA[dt] = (f32x4){0.f, 0.f, 0.f, 0.f}; oB[dt] = oA[dt];
#pragma unroll
            for (int u = 0; u < 7; ++u) { const LAS bf16_t* vp = VAl + (32 * u + 4 * q + (lr >> 2)) * 72 + 16 * dt + 4 * (lr & 3);
                const s16x4 lo = tr_read(vp), hi = tr_read(vp + 16 * 72);
                const bf16x8 a = __builtin_shufflevector(lo, hi, 0, 1, 2, 3, 4, 5, 6, 7); oA[dt] = MFMA16(a, pA[u], oA[dt]); oB[dt] = MFMA16(a, pB[u], oB[dt]); } }
#pragma unroll
        for (int dt = 0; dt < 4; ++dt) { const int col = hq * 64 + 16 * dt + 4 * q;
            { const u32x2 z = za[dt]; u32x2 w; w.x = pk2(oA[dt][0] * invA * siluf_(bflo(z.x)), oA[dt][1] * invA * siluf_(bfhi(z.x))); w.y = pk2(oA[dt][2] * invA * siluf_(bflo(z.y)), oA[dt][3] * invA * siluf_(bfhi(z.y)));
              if (dry) *(u32x2*)((bf16_t*)(p.ws + WS_XN) + (size_t)(qrow0 + 16 * tA + lr) * DM + col) = w; else *(u32x2*)(U + rowA + 16 * dt + 4 * q) = w; }
            if (kind == 0) { const u32x2 z = zb[dt]; u32x2 w; w.x = pk2(oB[dt][0] * invB * siluf_(bflo(z.x)), oB[dt][1] * invB * siluf_(bfhi(z.x))); w.y = pk2(oB[dt][2] * invB * siluf_(bflo(z.y)), oB[dt][3] * invB * siluf_(bfhi(z.y)));
              if (dry) *(u32x2*)((bf16_t*)(p.ws + WS_XN) + (size_t)(qrow0 + 16 * tB + lr) * DM + col) = w; else *(u32x2*)(U + rowB + 16 * dt + 4 * q) = w; } }
    }
    __syncthreads();
}

constexpr int ML_T2 = 69632, ML_SC = 106496;
constexpr int PV = 272, PKS = 144;
DI void mlstm_v_load(const bf16_t* U, int R0, int h, int tid, u32x4 (&v)[8]) {
#pragma unroll
    for (int it = 0; it < 8; ++it) { const int ci = tid + 512 * it, row = ci >> 5, ch = ci & 31; v[it] = *(const u32x4*)(U + uoff(R0 + row, VM + h * 256 + 8 * ch)); }
}
DI void mlstm_v_store(LAS unsigned char* lds, int tid, const u32x4 (&v)[8]) {
    LAS bf16_t* Vl = (LAS bf16_t*)lds;
#pragma unroll
    for (int it = 0; it < 8; ++it) { const int ci = tid + 512 * it, row = ci >> 5, ch = ci & 31; *(LAS u32x4*)(Vl + row * PV + 8 * ch) = v[it]; }
}

DI void mlstm_sum_item(const Params& p, LAS unsigned char* lds, int h, int j) {
    int tid_ = threadIdx.x; asm volatile("" : "+v"(tid_)); const int tid = tid_, lane = tid & 63, wave = tid >> 6, lr = lane & 15, q = lane >> 4;
    const bf16_t* U = (const bf16_t*)(p.ws + WS_U); const float* GATE = (const float*)(p.ws + WS_GATE);
    LAS float* wS = (LAS float*)(lds + ML_SC);
    const int R0 = 128 * j;
    u32x4 vreg[8], kreg[4];
    mlstm_v_load(U, R0, h, tid, vreg);
#pragma unroll
    for (int it = 0; it < 4; ++it) { const int ci = tid + 512 * it, row = ci >> 4, ch = ci & 15; kreg[it] = *(const u32x4*)(U + uoff(R0 + row, KM + h * 128 + 8 * ch)); }
    if (wave == 0) {
        const float bi = p.bi[h], bfb = p.bf[h];
        const float gi0 = GATE[(size_t)(R0 + lane) * 16 + h] + bi, gi1 = GATE[(size_t)(R0 + 64 + lane) * 16 + h] + bi;
        const float lf0 = logsigmoidf_(GATE[(size_t)(R0 + lane) * 16 + 8 + h] + bfb), lf1 = logsigmoidf_(GATE[(size_t)(R0 + 64 + lane) * 16 + 8 + h] + bfb);
        const float c0 = scan_add(lf0, lane); const float tot0 = __shfl(c0, 63); const float c1 = scan_add(lf1, lane) + tot0; const float blast = __shfl(c1, 63);
        const float x0 = blast - c0 + gi0, x1 = blast - c1 + gi1; const float ml = wmax(fmaxf(x0, x1));
        wS[lane] = __expf(x0 - ml); wS[64 + lane] = __expf(x1 - ml);
        if (lane == 0) { ((float*)(p.ws + WS_BS))[h * NCH + j] = blast; ((float*)(p.ws + WS_ML))[h * NCH + j] = ml; }
    }
    mlstm_v_store(lds, tid, vreg);
    __syncthreads();
    {
        LAS bf16_t* Kl = (LAS bf16_t*)(lds + ML_T2);
#pragma unroll
        for (int it = 0; it < 4; ++it) { const int ci = tid + 512 * it, row = ci >> 4, ch = ci & 15; const u32x4 a = kreg[it]; const float w = wS[row];
            u32x4 o; o.x = pk2(bflo(a.x) * w, bfhi(a.x) * w); o.y = pk2(bflo(a.y) * w, bfhi(a.y) * w); o.z = pk2(bflo(a.z) * w, bfhi(a.z) * w); o.w = pk2(bflo(a.w) * w, bfhi(a.w) * w);
            *(LAS u32x4*)(Kl + row * PKS + 8 * ch) = o; }
    }
    __syncthreads();
    const LAS bf16_t* Vl = (const LAS bf16_t*)lds; const LAS bf16_t* Kl = (const LAS bf16_t*)(lds + ML_T2);
    {
        LAS float* npart = (LAS float*)(lds + ML_SC + 512);
        const int d = tid & 127, part = tid >> 7; float sm = 0.f;
#pragma unroll 8
        for (int r = 0; r < 32; ++r) sm += bf2f(Kl[(32 * part + r) * PKS + d]);
        npart[part * 128 + d] = sm;
    }
    f32x4 acc[2][8];
#pragma unroll
    for (int i = 0; i < 2; ++i)
#pragma unroll
        for (int dt = 0; dt < 8; ++dt) acc[i][dt] = (f32x4){0.f, 0.f, 0.f, 0.f};
#pragma unroll
    for (int ks = 0; ks < 4; ++ks) {
        bf16x8 a[2];
#pragma unroll
        for (int i = 0; i < 2; ++i) { const LAS bf16_t* vp = Vl + (32 * ks + 8 * q + (lr >> 2)) * PV + 16 * (2 * wave + i) + 4 * (lr & 3);
            const s16x4 lo = tr_read(vp), hi = tr_read(vp + 4 * PV); a[i] = __builtin_shufflevector(lo, hi, 0, 1, 2, 3, 4, 5, 6, 7); }
#pragma unroll
        for (int dt = 0; dt < 8; ++dt) { const LAS bf16_t* kp = Kl + (32 * ks + 8 * q + (lr >> 2)) * PKS + 16 * dt + 4 * (lr & 3);
            const s16x4 lo = tr_read(kp), hi = tr_read(kp + 4 * PKS); const bf16x8 b = __builtin_shufflevector(lo, hi, 0, 1, 2, 3, 4, 5, 6, 7);
#pragma unroll
            for (int i = 0; i < 2; ++i) acc[i][dt] = MFMA16(b, a[i], acc[i][dt]); }
    }
    bf16_t* UP = (bf16_t*)(p.ws + WS_UP) + (size_t)(h * NCH + j) * 256 * 128;
#pragma unroll
    for (int i = 0; i < 2; ++i)
#pragma unroll
        for (int dt = 0; dt < 8; ++dt) { u32x2 w; w.x = f2bf_c(acc[i][dt][0]) | (f2bf_c(acc[i][dt][1]) << 16); w.y = f2bf_c(acc[i][dt][2]) | (f2bf_c(acc[i][dt][3]) << 16);
            *(u32x2*)(UP + (size_t)(16 * (2 * wave + i) + lr) * 128 + 16 * dt + 4 * q) = w; }
    __syncthreads();
    if (tid < 128) { const LAS float* npart = (const LAS float*)(lds + ML_SC + 512);
        ((float*)(p.ws + WS_NP))[(size_t)(h * NCH + j) * 128 + tid] = (npart[tid] + npart[128 + tid]) + (npart[256 + tid] + npart[384 + tid]); }
    __syncthreads();
}

DI void mlstm_small_item(const Params& p, LAS unsigned char* lds, int b, int h, int dry) {
    int tid_ = threadIdx.x; asm volatile("" : "+v"(tid_)); const int tid = tid_, lane = tid & 63, wave = tid >> 6;
    bf16_t* U = (bf16_t*)(p.ws + WS_U); const float* GATE = (const float*)(p.ws + WS_GATE);
    const bool meta = (b == 16); const int R0 = meta ? ROW_M : ROW_S + 16 * b;
    LAS float* qT = (LAS float*)lds; LAS float* kwT = (LAS float*)(lds + 8192); LAS float* kS = (LAS float*)(lds + 16384);
    LAS float* Wm = (LAS float*)(lds + 24832); LAS float* sc = (LAS float*)(lds + 25856); LAS float* red = (LAS float*)(lds + 26624);
    LAS float* am = sc, *cm = sc + 16, *bb = sc + 32, *wsS = sc + 48, *misc = sc + 64, *qnS = sc + 80;
    const float* Cin = p.sC + (size_t)(b * 8 + h) * 128 * 256; const float* nin = p.sn + (size_t)(b * 8 + h) * 128;
    float* Cout = meta ? (float*)(p.ws + WS_C0) + (size_t)h * 128 * 256 : p.out + O_CS + (size_t)(b * 8 + h) * 128 * 256;
    float* nout = meta ? (float*)(p.ws + WS_N0) + h * 128 : p.out + O_NS + (size_t)(b * 8 + h) * 128;
#pragma unroll
    for (int i = 0; i < 4; ++i) { const int idx = tid + 512 * i, t = idx >> 7, d = idx & 127;
        qT[d * 16 + t] = bf2f(U[uoff(R0 + t, QM + h * 128 + d)]); kS[t * 132 + d] = bf2f(U[uoff(R0 + t, KM + h * 128 + d)]); }
    if (wave == 0) {
        const bool act = lane < 16; const int tl = act ? lane : 15;
        const float gi = GATE[(size_t)(R0 + tl) * 16 + h] + p.bi[h];
        const float lf = act ? logsigmoidf_(GATE[(size_t)(R0 + tl) * 16 + 8 + h] + p.bf[h]) : 0.f;
        const float c = scan_add(lf, lane); const float a = act ? gi - c : -3e38f; const float pm = scan_max(a, lane);
        const float mprev = meta ? 0.f : p.sm[b * 8 + h]; const float cmv = fmaxf(mprev, pm);
        const float b15 = __shfl(c, 15), cm15 = __shfl(cmv, 15); const float mnew = b15 + cm15;
        if (act) { am[lane] = a; cm[lane] = cmv; bb[lane] = c; wsS[lane] = __expf(b15 + a - mnew); }
        if (lane == 0) { misc[0] = __expf(b15 + mprev - mnew); misc[1] = mnew; misc[2] = mprev;
            if (meta) ((float*)(p.ws + WS_M0))[h] = mnew; else p.out[O_MS + b * 8 + h] = mnew; }
    }
    __syncthreads();
#pragma unroll
    for (int i = 0; i < 4; ++i) { const int idx = tid + 512 * i, s = idx >> 7, d = idx & 127; kwT[d * 16 + s] = kS[s * 132 + d] * wsS[s]; }
    if (tid < 256) { const int t = tid >> 4, s = tid & 15; float dot = 0.f;
        for (int d = 0; d < 128; ++d) dot += qT[d * 16 + t] * kS[s * 132 + d];
        Wm[t * 16 + s] = (s <= t) ? dot * __expf(am[s] - cm[t]) : 0.f;
    } else if (tid < 272) { const int t = tid - 256; float dot = 0.f;
        if (!meta) for (int d = 0; d < 128; ++d) dot += qT[d * 16 + t] * nin[d];
        qnS[t] = dot; }
    __syncthreads();
    const int e = tid & 255, dh = tid >> 8;
    float v[16];
#pragma unroll
    for (int s = 0; s < 16; ++s) v[s] = bf2f(U[uoff(R0 + s, VM + h * 256 + e)]);
    float acc[16];
#pragma unroll
    for (int t = 0; t < 16; ++t) acc[t] = 0.f;
    const float alast = misc[0], mprev = misc[2];
    for (int d0 = dh * 64; d0 < dh * 64 + 64; d0 += 16) {
        float cb[16];
#pragma unroll
        for (int dd = 0; dd < 16; ++dd) cb[dd] = meta ? 0.f : Cin[(size_t)(d0 + dd) * 256 + e];
#pragma unroll
        for (int dd = 0; dd < 16; ++dd) { const int d = d0 + dd; const float c = cb[dd];
            float cn = alast * c;
#pragma unroll
            for (int i = 0; i < 4; ++i) { const f32x4 q4 = *(const LAS f32x4*)(qT + d * 16 + 4 * i), k4 = *(const LAS f32x4*)(kwT + d * 16 + 4 * i);
#pragma unroll
                for (int jj = 0; jj < 4; ++jj) { acc[4 * i + jj] += q4[jj] * c; cn += k4[jj] * v[4 * i + jj]; } }
            Cout[(size_t)d * 256 + e] = cn; }
    }
#pragma unroll
    for (int t = 0; t < 16; ++t) red[(dh * 16 + t) * 256 + e] = acc[t];
    if (tid < 128) { float nn = alast * (meta ? 0.f : nin[tid]);
#pragma unroll
        for (int s = 0; s < 16; ++s) nn += kwT[tid * 16 + s];
        nout[tid] = nn; }
    __syncthreads();
    if (!meta) {
#pragma unroll
        for (int tl = 0; tl < 8; ++tl) { const int t = dh * 8 + tl;
            const float inter = red[t * 256 + e] + red[(16 + t) * 256 + e]; const float sc_t = __expf(mprev - cm[t]);
            float num = sc_t * inter, den = sc_t * qnS[t];
#pragma unroll
            for (int s = 0; s < 16; ++s) { const float w = Wm[t * 16 + s]; num += w * v[s]; den += w; }
            const float mt = bb[t] + cm[t];
            red[t * 256 + e] = num / fmaxf(fabsf(den), __expf(-mt)); }
    }
    __syncthreads();
    if (!meta) {
#pragma unroll
        for (int r = 0; r < 2; ++r) { const int t = 2 * wave + r; float hv[4]; float ss = 0.f;
#pragma unroll
            for (int i = 0; i < 4; ++i) { hv[i] = red[t * 256 + lane + 64 * i]; ss += hv[i] * hv[i]; }
            const float rstd = rsqrtf(wsum(ss) * (1.f / 256.f) + EPS);
            float ov[4], zv[4], gv[4];
#pragma unroll
            for (int i = 0; i < 4; ++i) { const int ee = lane + 64 * i; const size_t ro = (size_t)(R0 + t) * 256 + (size_t)h * UT + ee;
                ov[i] = bf2f(U[ro + (size_t)(OM >> 8) * UT]); zv[i] = bf2f(U[ro + (size_t)(ZM >> 8) * UT]); gv[i] = p.gmh[h * 256 + ee]; }
#pragma unroll
            for (int i = 0; i < 4; ++i) { const int ee = lane + 64 * i; const size_t ro = (size_t)(R0 + t) * 256 + (size_t)h * UT + ee;
                const float val = hv[i] * rstd * gv[i] * sigmoidf_(ov[i]) * siluf_(zv[i]);
                if (!dry) U[ro + (size_t)(OM >> 8) * UT] = (bf16_t)(pk2(val, 0.f) & 0xffffu); } }
    }
    __syncthreads();
}

DI void mlstm_scan(const Params& p, LAS unsigned char* lds) {
    const float* BS = (const float*)(p.ws + WS_BS); const float* MLv = (const float*)(p.ws + WS_ML); float* MS = (float*)(p.ws + WS_MS);
    const float* NPv = (const float*)(p.ws + WS_NP); float* NS = (float*)(p.ws + WS_NS);
    const float* C0 = (const float*)(p.ws + WS_C0); const float* N0 = (const float*)(p.ws + WS_N0); const float* M0 = (const float*)(p.ws + WS_M0);
    LAS float* tb = (LAS float*)lds, *tm = tb + 64, *ca = tb + 128, *cb = tb + 192, *cm = tb + 256;
    const int tid = threadIdx.x;
    for (int gid0 = blockIdx.x * 512; gid0 < 8 * 256 * 64; gid0 += gridDim.x * 512) {
        const int gid = gid0 + tid, h = gid0 >> 14, e = (gid >> 6) & 255, d = 2 * (gid & 63);
        const bf16_t* UP = (const bf16_t*)(p.ws + WS_UP) + (size_t)h * NCH * 256 * 128 + (size_t)e * 128 + d;
        unsigned u[64];
#pragma unroll
        for (int i = 0; i < 64; ++i) u[i] = *(const unsigned*)(UP + (size_t)i * 256 * 128);
        float cx = C0[((size_t)h * 128 + d) * 256 + e], cy = C0[((size_t)h * 128 + d + 1) * 256 + e];
        __syncthreads();
        if (tid < 64) { tb[tid] = BS[h * NCH + tid]; tm[tid] = MLv[h * NCH + tid]; }
        __syncthreads();
        if (tid == 0) { float m = M0[h];
            for (int k = 0; k < NCH; ++k) { const float bs = tb[k], ml = tm[k]; const float mn = fmaxf(bs + m, ml); ca[k] = __expf(bs + m - mn); cb[k] = __expf(ml - mn); cm[k] = m; m = mn; }
            cm[64] = m; }
        __syncthreads();
        unsigned* CS = (unsigned*)((bf16_t*)(p.ws + WS_CST) + (size_t)h * NCH * 256 * 128 + (size_t)e * 128 + d);
#pragma unroll
        for (int k = 0; k < NCH; ++k) { CS[(size_t)k * 256 * 64] = pk2(cx, cy); const float a = ca[k], b = cb[k]; cx = a * cx + b * bflo(u[k]); cy = a * cy + b * bfhi(u[k]); }
        p.out[O_CP + ((size_t)h * 128 + d) * 256 + e] = cx; p.out[O_CP + ((size_t)h * 128 + d + 1) * 256 + e] = cy;
        if ((gid0 & 16383) == 0) {
            if (tid < 128) { float nv[64];
#pragma unroll
                for (int k = 0; k < 64; ++k) nv[k] = NPv[(size_t)(h * NCH + k) * 128 + tid];
                float n = N0[h * 128 + tid];
#pragma unroll
                for (int k = 0; k < 64; ++k) { NS[(size_t)(h * NCH + k) * 128 + tid] = n; n = ca[k] * n + cb[k] * nv[k]; }
                p.out[O_NP + h * 128 + tid] = n; }
            else if (tid < 192) { MS[h * NCH + (tid - 128)] = cm[tid - 128]; if (tid == 128) p.out[O_MP + h] = cm[64]; }
        }
    }
    __syncthreads();
}

DI void mlstm_sw_tile(const LAS bf16_t* KN, const LAS float* aS, const bf16x8 (&qf)[4], int tT, int t, float cmt, int lr, int q, bf16x8 (&wf)[4], float& dsum) {
    dsum = 0.f;
#pragma unroll
    for (int u = 0; u < 4; ++u) {
        u32x4 w = (u32x4){0u, 0u, 0u, 0u};
#pragma unroll
        for (int hh = 0; hh < 2; ++hh) { const int st = 2 * u + hh;
            if (st <= tT) {
                f32x4 s4 = (f32x4){0.f, 0.f, 0.f, 0.f};
#pragma unroll
                for (int ks = 0; ks < 4; ++ks) { const bf16x8 a = *(const LAS bf16x8*)(KN + (16 * st + lr) * 136 + 32 * ks + 8 * q); s4 = MFMA16(a, qf[ks], s4); }
                float wv[4];
#pragma unroll
                for (int jj = 0; jj < 4; ++jj) { const int sx = 16 * st + 4 * q + jj; const float wg = (sx <= t) ? __expf(aS[sx] - cmt) : 0.f; wv[jj] = s4[jj] * wg; dsum += wv[jj]; }
                if (hh == 0) { w.x = pk2(wv[0], wv[1]); w.y = pk2(wv[2], wv[3]); } else { w.z = pk2(wv[0], wv[1]); w.w = pk2(wv[2], wv[3]); }
            } }
        wf[u] = __builtin_bit_cast(bf16x8, w);
    }
}
DI void mlstm_out_item(const Params& p, LAS unsigned char* lds, int h, int j, int dry) {
    int tid_ = threadIdx.x; asm volatile("" : "+v"(tid_)); const int tid = tid_, lane = tid & 63, wave = __builtin_amdgcn_readfirstlane(tid >> 6), lr = lane & 15, q = lane >> 4;
    const int g = wave >> 2, w = wave & 3, tA = w, tB = 7 - w;
    bf16_t* U = (bf16_t*)(p.ws + WS_U); const float* GATE = (const float*)(p.ws + WS_GATE);
    LAS float* aS = (LAS float*)(lds + ML_SC), *cmS = aS + 128, *bS = aS + 256, *nK = aS + 384, *ssx = aS + 512;
    const int R0 = 128 * j; const float mk = ((const float*)(p.ws + WS_MS))[h * NCH + j];
    u32x4 vreg[8], kn[4];
    mlstm_v_load(U, R0, h, tid, vreg);
#pragma unroll
    for (int it = 0; it < 4; ++it) { const int ci = tid + 512 * it, row = ci >> 4, ch = ci & 15; kn[it] = *(const u32x4*)(U + uoff(R0 + row, KM + h * 128 + 8 * ch)); }
    const int tokA = 16 * tA + lr, tokB = 16 * tB + lr;
    const size_t rowA = (size_t)(R0 + tokA) * 256, rowB = (size_t)(R0 + tokB) * 256;
    const size_t qoff = (size_t)((QM >> 8) + (h >> 1)) * UT + (h & 1) * 128 + 8 * q;
    bf16x8 qfA[4], qfB[4];
#pragma unroll
    for (int ks = 0; ks < 4; ++ks) { qfA[ks] = *(const bf16x8*)(U + rowA + qoff + 32 * ks); qfB[ks] = *(const bf16x8*)(U + rowB + qoff + 32 * ks); }
    if (wave == 0) {
        const float bi = p.bi[h], bfb = p.bf[h];
        const float gi0 = GATE[(size_t)(R0 + lane) * 16 + h] + bi, gi1 = GATE[(size_t)(R0 + 64 + lane) * 16 + h] + bi;
        const float lf0 = logsigmoidf_(GATE[(size_t)(R0 + lane) * 16 + 8 + h] + bfb), lf1 = logsigmoidf_(GATE[(size_t)(R0 + 64 + lane) * 16 + 8 + h] + bfb);
        const float c0 = scan_add(lf0, lane); const float tot0 = __shfl(c0, 63); const float c1 = scan_add(lf1, lane) + tot0;
        const float a0 = gi0 - c0, a1 = gi1 - c1;
        const float p0 = scan_max(a0, lane); const float t0 = __shfl(p0, 63); const float p1 = fmaxf(scan_max(a1, lane), t0);
        aS[lane] = a0; aS[64 + lane] = a1; cmS[lane] = fmaxf(mk, p0); cmS[64 + lane] = fmaxf(mk, p1); bS[lane] = c0; bS[64 + lane] = c1;
    } else if (wave < 3) { const int d = tid - 64; nK[d] = ((const float*)(p.ws + WS_NS))[(size_t)(h * NCH + j) * 128 + d]; }
    mlstm_v_store(lds, tid, vreg);
    {
        LAS bf16_t* KNw = (LAS bf16_t*)(lds + ML_T2);
#pragma unroll
        for (int it = 0; it < 4; ++it) { const int ci = tid + 512 * it, row = ci >> 4, ch = ci & 15; *(LAS u32x4*)(KNw + row * 136 + 8 * ch) = kn[it]; }
    }
    __syncthreads();
    const LAS bf16_t* VT = (const LAS bf16_t*)lds; const LAS bf16_t* KN = (const LAS bf16_t*)(lds + ML_T2);
    const float cmA = cmS[tokA], cmB = cmS[tokB];
    const float scaleA = __expf(mk - cmA), scaleB = __expf(mk - cmB), floA = __expf(-(bS[tokA] + cmA)), floB = __expf(-(bS[tokB] + cmB));
    float qnA = 0.f, qnB = 0.f;
#pragma unroll
    for (int ks = 0; ks < 4; ++ks)
#pragma unroll
        for (int i = 0; i < 8; ++i) { const float nv = nK[32 * ks + 8 * q + i]; qnA += bf2f((unsigned short)qfA[ks][i]) * nv; qnB += bf2f((unsigned short)qfB[ks][i]) * nv; }
    qnA += __shfl_xor(qnA, 16); qnA += __shfl_xor(qnA, 32); qnB += __shfl_xor(qnB, 16); qnB += __shfl_xor(qnB, 32);
    f32x4 accA[8], accB[8];
    const bf16_t* CS = (const bf16_t*)(p.ws + WS_CST) + (size_t)(h * NCH + j) * 256 * 128 + (size_t)(128 * g) * 128;
#pragma unroll
    for (int et = 0; et < 8; ++et) { accA[et] = (f32x4){0.f, 0.f, 0.f, 0.f}; accB[et] = accA[et]; }
#pragma unroll
    for (int ks = 0; ks < 4; ++ks) {
        bf16x8 ca[8];
#pragma unroll
        for (int et = 0; et < 8; ++et) ca[et] = *(const bf16x8*)(CS + (size_t)(16 * et + lr) * 128 + 32 * ks + 8 * q);
#pragma unroll
        for (int et = 0; et < 8; ++et) { accA[et] = MFMA16(ca[et], qfA[ks], accA[et]); accB[et] = MFMA16(ca[et], qfB[ks], accB[et]); }
    }
#pragma unroll
    for (int et = 0; et < 8; ++et) { accA[et] = accA[et] * scaleA; accB[et] = accB[et] * scaleB; }
    asm volatile("" ::: "memory");
    bf16x8 wfA[4], wfB[4]; float dsA, dsB;
    mlstm_sw_tile(KN, aS, qfA, tA, tokA, cmA, lr, q, wfA, dsA);
    mlstm_sw_tile(KN, aS, qfB, tB, tokB, cmB, lr, q, wfB, dsB);
#pragma unroll
    for (int u = 0; u < 4; ++u) {
        if (2 * u <= tB) {
#pragma unroll
            for (int et = 0; et < 8; ++et) { const LAS bf16_t* vp = VT + (32 * u + 4 * q + (lr >> 2)) * PV + 16 * (8 * g + et) + 4 * (lr & 3);
                const s16x4 lo = tr_read(vp), hi = tr_read(vp + 16 * PV); const bf16x8 vf = __builtin_shufflevector(lo, hi, 0, 1, 2, 3, 4, 5, 6, 7);
                accB[et] = MFMA16(vf, wfB[u], accB[et]);
                if (2 * u <= tA) accA[et] = MFMA16(vf, wfA[u], accA[et]); } }
    }
    asm volatile("" ::: "memory");
    dsA += __shfl_xor(dsA, 16); dsA += __shfl_xor(dsA, 32); dsB += __shfl_xor(dsB, 16); dsB += __shfl_xor(dsB, 32);
    const float invA = 1.0f / fmaxf(fabsf(scaleA * qnA + dsA), floA), invB = 1.0f / fmaxf(fabsf(scaleB * qnB + dsB), floB);
    float ssA = 0.f, ssB = 0.f;
#pragma unroll
    for (int et = 0; et < 8; ++et) { accA[et] = accA[et] * invA; accB[et] = accB[et] * invB;
        ssA += (accA[et][0] * accA[et][0] + accA[et][1] * accA[et][1]) + (accA[et][2] * accA[et][2] + accA[et][3] * accA[et][3]);
        ssB += (accB[et][0] * accB[et][0] + accB[et][1] * accB[et][1]) + (accB[et][2] * accB[et][2] + accB[et][3] * accB[et][3]); }
    ssA += __shfl_xor(ssA, 16); ssA += __shfl_xor(ssA, 32); ssB += __shfl_xor(ssB, 16); ssB += __shfl_xor(ssB, 32);
    if (q == 0) { ssx[((g * 4 + w) * 2 + 0) * 16 + lr] = ssA; ssx[((g * 4 + w) * 2 + 1) * 16 + lr] = ssB; }
    __syncthreads();
    const float rstdA = rsqrtf((ssA + ssx[(((g ^ 1) * 4 + w) * 2 + 0) * 16 + lr]) * (1.f / 256.f) + EPS);
    const float rstdB = rsqrtf((ssB + ssx[(((g ^ 1) * 4 + w) * 2 + 1) * 16 + lr]) * (1.f / 256.f) + EPS);
    const size_t ooff = (size_t)((OM >> 8) + h) * UT + 128 * g + 4 * q, zoff = (size_t)((ZM >> 8) + h) * UT + 128 * g + 4 * q;
#pragma unroll
    for (int T = 0; T < 2; ++T) {
        const size_t rowT = T ? rowB : rowA; const float rstd = T ? rstdB : rstdA; const int tok = T ? tokB : tokA;
        u32x2 ov[8], zv[8]; f32x4 gv[8];
#pragma unroll
        for (int et = 0; et < 8; ++et) { ov[et] = *(const u32x2*)(U + rowT + ooff + 16 * et); zv[et] = *(const u32x2*)(U + rowT + zoff + 16 * et); gv[et] = *(const f32x4*)(p.gmh + h * 256 + 128 * g + 16 * et + 4 * q); }
#pragma unroll
        for (int et = 0; et < 8; ++et) { const f32x4 a = T ? accB[et] : accA[et]; const u32x2 o = ov[et], z = zv[et]; const f32x4 gg = gv[et];
            u32x2 wv; wv.x = pk2(a[0] * rstd * gg[0] * sigmoidf_(bflo(o.x)) * siluf_(bflo(z.x)), a[1] * rstd * gg[1] * sigmoidf_(bfhi(o.x)) * siluf_(bfhi(z.x)));
            wv.y = pk2(a[2] * rstd * gg[2] * sigmoidf_(bflo(o.y)) * siluf_(bflo(z.y)), a[3] * rstd * gg[3] * sigmoidf_(bfhi(o.y)) * siluf_(bfhi(z.y)));
            if (dry) *(u32x2*)((bf16_t*)(p.ws + WS_XN) + (size_t)(R0 + tok) * DM + h * 256 + 128 * g + 16 * et + 4 * q) = wv; else *(u32x2*)(U + rowT + ooff + 16 * et) = wv; }
    }
    __syncthreads();
}

DI void skinny_core(f32x4 (&acc)[2][4], const bf16_t* A, size_t lda, size_t wstride, const bf16_t* Bt, int row0, int col0, int wave, int lr, int q) {
    const bf16_t* ap = A + (size_t)(row0 + lr) * lda + wstride * wave + 8 * q;
    const bf16_t* bp = Bt + (size_t)(col0 + lr) * 2048 + 256 * wave + 8 * q;
#pragma unroll 4
    for (int ks = 0; ks < 8; ++ks) {
        bf16x8 a[2], b[4];
#pragma unroll
        for (int rt = 0; rt < 2; ++rt) a[rt] = *(const bf16x8*)(ap + (size_t)rt * 16 * lda + 32 * ks);
#pragma unroll
        for (int ct = 0; ct < 4; ++ct) b[ct] = *(const bf16x8*)(bp + (size_t)ct * 16 * 2048 + 32 * ks);
#pragma unroll
        for (int rt = 0; rt < 2; ++rt)
#pragma unroll
            for (int ct = 0; ct < 4; ++ct) acc[rt][ct] = MFMA16(b[ct], a[rt], acc[rt][ct]);
    }
}
DI void skinny_put(LAS float* red, const f32x4 (&acc)[2][4], int slot, int lr, int q) {
#pragma unroll
    for (int rt = 0; rt < 2; ++rt)
#pragma unroll
        for (int ct = 0; ct < 4; ++ct) *(LAS f32x4*)(red + ((size_t)slot * 32 + 16 * rt + lr) * 64 + 16 * ct + 4 * q) = acc[rt][ct];
}
DI void skinny_merge(const Params& p, LAS unsigned char* lds) {
    const int tid = threadIdx.x, lane = tid & 63, wave = tid >> 6, lr = lane & 15, q = lane >> 4;
    const bf16_t* U = (const bf16_t*)(p.ws + WS_U); const bf16_t* WP = (const bf16_t*)(p.ws + WS_WP); bf16_t* MG = (bf16_t*)(p.ws + WS_XN);
    LAS float* red = (LAS float*)lds;
    for (int tile = blockIdx.x; tile < 256; tile += gridDim.x) {
        const int row0 = ROW_S + 32 * (tile >> 5), col0 = 64 * (tile & 31);
        f32x4 aa[2][4], am[2][4];
#pragma unroll
        for (int rt = 0; rt < 2; ++rt)
#pragma unroll
            for (int ct = 0; ct < 4; ++ct) { aa[rt][ct] = (f32x4){0.f, 0.f, 0.f, 0.f}; am[rt][ct] = (f32x4){0.f, 0.f, 0.f, 0.f}; }
        skinny_core(aa, U + (size_t)(QA >> 8) * UT, 256, UT, WP, row0, col0, wave, lr, q);
        skinny_core(am, U + (size_t)(OM >> 8) * UT, 256, UT, WP + (size_t)2048 * 2048, row0, col0, wave, lr, q);
        skinny_put(red, aa, wave * 2, lr, q); skinny_put(red, am, wave * 2 + 1, lr, q);
        __syncthreads();
        const int row = tid >> 4, c4 = (tid & 15) * 4;
        f32x4 ya = (f32x4){0.f, 0.f, 0.f, 0.f}, ym = ya;
#pragma unroll
        for (int w = 0; w < 8; ++w) { ya += *(const LAS f32x4*)(red + ((size_t)(2 * w) * 32 + row) * 64 + c4); ym += *(const LAS f32x4*)(red + ((size_t)(2 * w + 1) * 32 + row) * 64 + c4); }
        const size_t r = row0 + row; const int col = col0 + c4;
        const u32x2 ga = *(const u32x2*)(U + uoff((int)r, GA + col)), gm = *(const u32x2*)(U + uoff((int)r, GM + col));
        u32x2 w; w.x = pk2(sigmoidf_(bflo(ga.x)) * ya[0] + sigmoidf_(bflo(gm.x)) * ym[0], sigmoidf_(bfhi(ga.x)) * ya[1] + sigmoidf_(bfhi(gm.x)) * ym[1]);
        w.y = pk2(sigmoidf_(bflo(ga.y)) * ya[2] + sigmoidf_(bflo(gm.y)) * ym[2], sigmoidf_(bfhi(ga.y)) * ya[3] + sigmoidf_(bfhi(gm.y)) * ym[3]);
        *(u32x2*)(MG + r * DM + col) = w;
        __syncthreads();
    }
}
DI void skinny_out(const Params& p, LAS unsigned char* lds) {
    const int tid = threadIdx.x, lane = tid & 63, wave = tid >> 6, lr = lane & 15, q = lane >> 4;
    const bf16_t* MG = (const bf16_t*)(p.ws + WS_XN); const bf16_t* WO = (const bf16_t*)(p.ws + WS_WOUT); float* ssq = (float*)(p.ws + WS_SSQ);
    LAS float* red = (LAS float*)lds;
    for (int tile = blockIdx.x; tile < 256; tile += gridDim.x) {
        const int row0 = ROW_S + 32 * (tile >> 5), col0 = 64 * (tile & 31);
        f32x4 aa[2][4];
#pragma unroll
        for (int rt = 0; rt < 2; ++rt)
#pragma unroll
            for (int ct = 0; ct < 4; ++ct) aa[rt][ct] = (f32x4){0.f, 0.f, 0.f, 0.f};
        skinny_core(aa, MG, DM, 256, WO, row0, col0, wave, lr, q);
        skinny_put(red, aa, wave, lr, q);
        __syncthreads();
        const int row = tid >> 4, c4 = (tid & 15) * 4;
        f32x4 y = (f32x4){0.f, 0.f, 0.f, 0.f};
#pragma unroll
        for (int w = 0; w < 8; ++w) y += *(const LAS f32x4*)(red + ((size_t)w * 32 + row) * 64 + c4);
        const size_t r = row0 + row; const int col = col0 + c4;
        const f32x4 o = *(const f32x4*)(p.xs + (r - ROW_S) * DM + col) + y;
        { u32x2 w; w.x = pk2(o[0], o[1]); w.y = pk2(o[2], o[3]); *(u32x2*)((bf16_t*)(p.ws + WS_U) + uoff((int)r, col)) = w; }
        float ss = (o[0] * o[0] + o[1] * o[1]) + (o[2] * o[2] + o[3] * o[3]);
        ss += __shfl_xor(ss, 1); ss += __shfl_xor(ss, 2); ss += __shfl_xor(ss, 4); ss += __shfl_xor(ss, 8);
        if ((tid & 15) == 0) ssq[r * 32 + (tile & 31)] = ss;
        __syncthreads();
    }
}

DI void final_norm(const Params& p) {
    const int lane = threadIdx.x & 63, gw = blockIdx.x * 8 + (threadIdx.x >> 6), NGW = gridDim.x * 8;
    const float* ssq = (const float*)(p.ws + WS_SSQ); const bf16_t* X1 = (const bf16_t*)(p.ws + WS_U);
    for (int r = gw; r < MOUT; r += NGW) {
        u32x2 xv[8];
#pragma unroll
        for (int j = 0; j < 8; ++j) xv[j] = *(const u32x2*)(X1 + (size_t)j * UT + (size_t)r * 256 + 4 * lane);
        const float s = wsum(lane < 32 ? ssq[(size_t)r * 32 + lane] : 0.f);
        const float rstd = rsqrtf(s * (1.f / DM) + EPS);
        f32x4* o = (f32x4*)(p.out + (size_t)r * DM) + lane; const f32x4* g = (const f32x4*)p.gfinal + lane;
#pragma unroll
        for (int j = 0; j < 8; ++j) { const f32x4 gg = g[64 * j]; f32x4 v; v[0] = bflo(xv[j].x) * rstd * gg[0]; v[1] = bfhi(xv[j].x) * rstd * gg[1]; v[2] = bflo(xv[j].y) * rstd * gg[2]; v[3] = bfhi(xv[j].y) * rstd * gg[3]; o[64 * j] = v; }
    }
}

__global__ void __launch_bounds__(512, 2) mega(Params p) {
    extern __shared__ __attribute__((aligned(16))) unsigned char lds_raw[];
    LAS unsigned char* lds = (LAS unsigned char*)lds_raw;
    cg::grid_group grid = cg::this_grid();
    const int lo = p.ph_lo, hi = p.ph_hi;
#define IN(k) (lo <= (k) && (k) < hi)
#define STAMP(i) do { if (TPROBE >= 0 && blockIdx.x == 0 && threadIdx.x == 0) tsl[i] = __builtin_amdgcn_s_memrealtime(); } while (0)
#define SEAM(k) do { if (IN(k) && IN((k) + 1)) xcd_barrier(bar); STAMP((k) + 1); } while (0)
    volatile LAS unsigned long long* tsl = (volatile LAS unsigned long long*)(lds + 131072 + 1040);
    volatile LAS unsigned* bst = (volatile LAS unsigned*)(lds + 131072 + 1024);
    if (threadIdx.x < 2) bst[threadIdx.x] = 0u;
    __syncthreads();
    XcdBarrier bar = xcd_barrier_post((unsigned*)(p.ws + WS_BAR), bst);
    if (hi > 1000) grid.sync();
    bf16_t* U = (bf16_t*)(p.ws + WS_U);
    STAMP(0);
    if (IN(0)) for (int rep = 0; rep < REP0; ++rep) p0_prologue(p, lds);
    SEAM(0);
    if (IN(1)) for (int rep = 0; rep < REP1; ++rep) {
        pg8::Order S; S.init(MPAD / 256, NW / 256, gridDim.x, blockIdx.x, 0);
        S.A0 = S.A1 = (const char*)(p.ws + WS_XN); S.B0 = S.B1 = (const char*)(p.ws + WS_WIN); S.a_tstep = (size_t)256 * DM * 2; S.b_tstep = (size_t)256 * 2048 * 2;
        pg8::EpiU E{U, (float*)(p.ws + WS_GATE), p.out};
        pg8::gemm_phase<pg8::EpiU>(lds, 2048, DM, 512, S, E);
    }
    SEAM(1);
    if (IN(2)) {
        for (int rep = 0; rep < REP2; ++rep) { const int dry = rep + 1 < REP2;
        for (int it = blockIdx.x; it < 1224; it += gridDim.x) {
            if (it < 512) { if (!dry || (PSEL & 1)) attn_item(p, lds, 0, it >> 2, it & 3, dry); }
            else if (it < 576) { if (!dry || (PSEL & 1)) attn_item(p, lds, 1, (it - 512) >> 2, (it - 512) & 3, dry); }
            else if (it < 1088) { if (!dry || (PSEL & 2)) mlstm_sum_item(p, lds, (it - 576) & 7, (it - 576) >> 3); }
            else { if (!dry || (PSEL & 4)) mlstm_small_item(p, lds, (it - 1088) >> 3, (it - 1088) & 7, dry); }
        } }
    }
    SEAM(2);
    if (IN(3)) for (int rep = 0; rep < REP3; ++rep) mlstm_scan(p, lds);
    for (int rep = 0; rep < REPSYNC; ++rep) xcd_barrier(bar);
    SEAM(3);
    if (IN(4)) for (int rep = 0; rep < REP4; ++rep) { for (int it = blockIdx.x; it < 512; it += gridDim.x) mlstm_out_item(p, lds, it & 7, it >> 3, rep + 1 < REP4); }
    SEAM(4);
    if (IN(5)) for (int rep = 0; rep < REP56; ++rep) {
        pg8::Order S; S.init(ROW_S / 256, DM / 256, gridDim.x, blockIdx.x, 1);
        S.A0 = (const char*)(U + (size_t)(QA >> 8) * UT); S.A1 = (const char*)(U + (size_t)(OM >> 8) * UT); S.B0 = (const char*)(p.ws + WS_WP); S.B1 = S.B0 + (size_t)2048 * 2048 * 2;
        S.a_tstep = (size_t)256 * 256 * 2; S.b_tstep = (size_t)256 * 2048 * 2;
        pg8::EpiMerge E{U, (bf16_t*)(p.ws + WS_XN)};
        const bool skinny_first = (blockIdx.x >> 3) & 1;
        if (skinny_first) skinny_merge(p, lds);
        pg8::gemm_phase<pg8::EpiMerge>(lds, 2048, 256, UT * 2, S, E);
        if (!skinny_first) skinny_merge(p, lds);
    }
    SEAM(5);
    if (IN(6)) for (int rep = 0; rep < REP56; ++rep) {
        pg8::Order S; S.init(ROW_S / 256, DM / 256, gridDim.x, blockIdx.x, 0);
        S.A0 = S.A1 = (const char*)(p.ws + WS_XN); S.B0 = S.B1 = (const char*)(p.ws + WS_WOUT); S.a_tstep = (size_t)256 * DM * 2; S.b_tstep = (size_t)256 * 2048 * 2;
        pg8::EpiOut E{p.xp, p.xs, U, (float*)(p.ws + WS_SSQ)};
        const bool skinny_first = (blockIdx.x >> 3) & 1;
        if (skinny_first) skinny_out(p, lds);
        pg8::gemm_phase<pg8::EpiOut>(lds, 2048, DM, 512, S, E);
        if (!skinny_first) skinny_out(p, lds);
    }
    SEAM(6);
    if (IN(7)) final_norm(p);
    if (TPROBE >= 0 && blockIdx.x == 0 && threadIdx.x == 0) { const unsigned long long te = __builtin_amdgcn_s_memrealtime(); tsl[8] = te;
        const unsigned long long d = tsl[TPROBE + 1] - tsl[TPROBE]; while (__builtin_amdgcn_s_memrealtime() - te < 9ull * d) __builtin_amdgcn_s_sleep(8); }
#undef IN
#undef SEAM
}

extern "C" void kernel_launch(void* const* d_in, const int* in_sizes, int n_in, void* d_out, int out_size, void* d_ws, size_t ws_size, hipStream_t stream) {
    static int grid = 0;
    if (grid == 0) {
        if (n_in != 18 || out_size != 22889608 || ws_size < WS_END) { fprintf(stderr, "kernel_launch: unexpected shapes (n_in %d out %d ws %zu need %zu)\n", n_in, out_size, ws_size, (size_t)WS_END); grid = -1; return; }
        int dev = 0, cus = 0, per_cu = 0;
        hipGetDevice(&dev); hipDeviceGetAttribute(&cus, hipDeviceAttributeMultiprocessorCount, dev);
        if (hipFuncSetAttribute((const void*)mega, hipFuncAttributeMaxDynamicSharedMemorySize, LDS_BYTES) != hipSuccess) { fprintf(stderr, "kernel_launch: hipFuncSetAttribute failed\n"); grid = -1; return; }
        if (hipOccupancyMaxActiveBlocksPerMultiprocessor(&per_cu, (const void*)mega, 512, LDS_BYTES) != hipSuccess || per_cu < 1) { fprintf(stderr, "kernel_launch: occupancy query says %d\n", per_cu); (void)hipGetLastError(); }
        grid = cus > 0 ? cus : 256;
    }
    if (grid < 0) return;
    Params p{};
    p.xp = (const float*)d_in[0]; p.xs = (const float*)d_in[1]; p.ck = (const float*)d_in[2]; p.cv = (const float*)d_in[3];
    p.sC = (const float*)d_in[4]; p.sn = (const float*)d_in[5]; p.sm = (const float*)d_in[6]; p.meta = (const float*)d_in[7];
    p.gnorm = (const float*)d_in[8]; p.win = (const float*)d_in[9]; p.bi = (const float*)d_in[10]; p.bf = (const float*)d_in[11];
    p.sinks = (const float*)d_in[12]; p.gmh = (const float*)d_in[13]; p.wpa = (const float*)d_in[14]; p.wpm = (const float*)d_in[15];
    p.wout = (const float*)d_in[16]; p.gfinal = (const float*)d_in[17];
    p.out = (float*)d_out; p.ws = (unsigned char*)d_ws;
#if N_LAUNCH == 1
    p.ph_lo = 0; p.ph_hi = 8;
    if (hipMemsetAsync((char*)d_ws + WS_BAR, 0, 16384, stream) != hipSuccess) { fprintf(stderr, "kernel_launch: memset failed\n"); return; }
    void* args[] = {&p};
    hipError_t e = hipLaunchCooperativeKernel((const void*)mega, dim3(grid), dim3(512), args, LDS_BYTES, stream);
    if (e != hipSuccess) fprintf(stderr, "cooperative launch failed: %s (grid %d)\n", hipGetErrorString(e), grid);
#else
    for (int ph = 0; ph < 8; ++ph) { p.ph_lo = ph; p.ph_hi = ph + 1; hipLaunchKernelGGL(mega, dim3(grid), dim3(512), LDS_BYTES, stream, p); }
#endif
}
```

```cpp
#include <hip/hip_runtime.h>
#include <hip/hip_cooperative_groups.h>
#include <cstdio>
#include <cstdint>
namespace cg = cooperative_groups;

#ifndef REP1
#define REP1 1
#endif
#ifndef REP3
#define REP3 1
#endif
#ifndef REP0
#define REP0 1
#endif
#ifndef REP2
#define REP2 1
#endif
#ifndef REP4
#define REP4 1
#endif
#ifndef PSEL
#define PSEL 7
#endif
#ifndef TPROBE
#define TPROBE -1
#endif
#ifndef REP56
#define REP56 1
#endif
#ifndef REPSYNC
#define REPSYNC 0
#endif
#ifndef N_LAUNCH
#define N_LAUNCH 1
#endif

#define LAS __attribute__((address_space(3)))
typedef unsigned short bf16_t;
typedef short bf16x8 __attribute__((ext_vector_type(8)));
typedef short s16x4 __attribute__((ext_vector_type(4)));
typedef float f32x4 __attribute__((ext_vector_type(4)));
typedef float f32x2 __attribute__((ext_vector_type(2)));
typedef unsigned u32x4 __attribute__((ext_vector_type(4)));
typedef unsigned u32x2 __attribute__((ext_vector_type(2)));
#define DI __device__ __forceinline__

constexpr int DM = 2048;
constexpr int ROW_S = 8192, ROW_M = 8448, MROWS = 8464, MPAD = 8704, MOUT = 8448;
constexpr int NU = 16896, NW = 17152;
constexpr size_t UT = (size_t)8704 * 256;
__device__ __forceinline__ size_t uoff(int row, int col) { return (size_t)(col >> 8) * UT + (size_t)row * 256 + (col & 255); }
constexpr int QA = 0, KA = 2048, VA = 2304, ZA = 2560, QM = 4608, KM = 5632, VM = 6656, OM = 8704, ZM = 10752, GA = 12800, GM = 14848;
constexpr int NCH = 64;
constexpr float EPS = 1e-6f;
constexpr size_t O_KP = 17301504, O_VP = 17334272, O_CP = 17367040, O_NP = 17629184, O_MP = 17630208,
                 O_KS = 17630216, O_VS = 18154504, O_CS = 18678792, O_NS = 22873096, O_MS = 22889480;
constexpr size_t WS_WIN = 4096;
constexpr size_t WS_WP = WS_WIN + (size_t)NW * 2048 * 2;
constexpr size_t WS_WOUT = WS_WP + (size_t)4096 * 2048 * 2;
constexpr size_t WS_XN = WS_WOUT + (size_t)2048 * 2048 * 2;
constexpr size_t WS_U = WS_XN + (size_t)MPAD * 2048 * 2;
constexpr size_t WS_GATE = WS_U + (size_t)MPAD * NU * 2;
constexpr size_t WS_UP = WS_GATE + (size_t)MPAD * 16 * 4;
constexpr size_t WS_CST = WS_UP + (size_t)8 * NCH * 256 * 128 * 4;
constexpr size_t WS_NP = WS_CST + (size_t)8 * NCH * 256 * 128 * 2;
constexpr size_t WS_NS = WS_NP + (size_t)8 * NCH * 128 * 4;
constexpr size_t WS_BS = WS_NS + (size_t)8 * NCH * 128 * 4;
constexpr size_t WS_ML = WS_BS + 4096;
constexpr size_t WS_MS = WS_ML + 4096;
constexpr size_t WS_C0 = WS_MS + 4096;
constexpr size_t WS_N0 = WS_C0 + (size_t)8 * 128 * 256 * 4;
constexpr size_t WS_M0 = WS_N0 + 4096;
constexpr size_t WS_SSQ = WS_M0 + 4096;
constexpr size_t WS_BAR = WS_SSQ + (size_t)MOUT * 32 * 4;
constexpr size_t WS_END = WS_BAR + 16384;
constexpr int LDS_BYTES = 131072 + 2048;

struct Params {
    const float *xp, *xs, *ck, *cv, *sC, *sn, *sm, *meta, *gnorm, *win, *bi, *bf, *sinks, *gmh, *wpa, *wpm, *wout, *gfinal;
    float* out; unsigned char* ws; int ph_lo, ph_hi;
};

DI float bf2f(unsigned short b) { return __uint_as_float(((unsigned)b) << 16); }
DI float bflo(unsigned w) { return __uint_as_float(w << 16); }
DI float bfhi(unsigned w) { return __uint_as_float(w & 0xffff0000u); }
DI unsigned pk2(float lo, float hi) { unsigned r; asm volatile("v_cvt_pk_bf16_f32 %0, %1, %2\n\ts_nop 1" : "=v"(r) : "v"(lo), "v"(hi)); return r; }
DI unsigned f2bf_c(float f) { const unsigned u = __float_as_uint(f); return (u + 0x7fffu + ((u >> 16) & 1u)) >> 16; }
DI float sigmoidf_(float x) { return __builtin_amdgcn_rcpf(1.0f + __expf(-x)); }
DI float siluf_(float x) { return x * __builtin_amdgcn_rcpf(1.0f + __expf(-x)); }
DI float logsigmoidf_(float x) { return fminf(x, 0.f) - log1pf(__expf(-fabsf(x))); }
DI float wsum(float v) {
#pragma unroll
    for (int o = 1; o < 64; o <<= 1) v += __shfl_xor(v, o);
    return v;
}
DI float wmax(float v) {
#pragma unroll
    for (int o = 1; o < 64; o <<= 1) v = fmaxf(v, __shfl_xor(v, o));
    return v;
}
DI float scan_add(float v, int lane) {
#pragma unroll
    for (int o = 1; o < 64; o <<= 1) { float t = __shfl_up(v, o); if (lane >= o) v += t; }
    return v;
}
DI float scan_max(float v, int lane) {
#pragma unroll
    for (int o = 1; o < 64; o <<= 1) { float t = __shfl_up(v, o); if (lane >= o) v = fmaxf(v, t); }
    return v;
}
#define ROWPTR(m) ((m) < ROW_S ? p.xp + (size_t)(m) * DM : ((m) < ROW_M ? p.xs + (size_t)((m) - ROW_S) * DM : p.meta + (size_t)((m) - ROW_M) * DM))
DI s16x4 tr_read(const LAS bf16_t* p) { return __builtin_amdgcn_ds_read_tr16_b64_v4i16((LAS s16x4*)p); }
#define LDS_WAIT() asm volatile("s_waitcnt lgkmcnt(0)" ::: "memory")
#define MFMA16(a, b, c) __builtin_amdgcn_mfma_f32_16x16x32_bf16((a), (b), (c), 0, 0, 0)

#define XB_TMO      128
#define XB_XCNT(j)  (256  + 64 * (j))
#define XB_XSUB(j)  (1280 + 64 * (j))
#define XB_XGEN(j)  (2304 + 64 * (j))
#define XB_TOP      3328
#define XB_TOPGEN   3392
#define XCD_BAR_WORDS 3456
#define XB_SPIN_CAP (1u << 18)
DI unsigned xb_ld(unsigned* p)              { return __hip_atomic_load(p, __ATOMIC_RELAXED, __HIP_MEMORY_SCOPE_AGENT); }
DI unsigned xb_add(unsigned* p, unsigned v) { return __hip_atomic_fetch_add(p, v, __ATOMIC_RELAXED, __HIP_MEMORY_SCOPE_AGENT); }
DI unsigned xb_xcc_id() { return (unsigned)__builtin_amdgcn_s_getreg((3 << 11) | 20) & 0xFu; }
#define XB_SPIN(cond, bar) do { unsigned _sp = 0; while (cond) { __builtin_amdgcn_s_sleep(1); \
    if ((++_sp & 255u) == 0u) { if (xb_ld(&(bar)[XB_TMO])) break; if (_sp > XB_SPIN_CAP) { atomicAdd(&(bar)[XB_TMO], 1u); break; } } } } while (0)
struct XcdBarrier { unsigned* bar; unsigned x; volatile LAS unsigned* st; };
DI XcdBarrier xcd_barrier_post(unsigned* bar, volatile LAS unsigned* st) {
    XcdBarrier b; b.bar = bar; b.x = xb_xcc_id(); b.st = st;
    if (threadIdx.x == 0) (void)xb_add(&bar[XB_XCNT(b.x)], 1u);
    return b;
}
DI void xcd_barrier_complete(unsigned* bar, unsigned x, unsigned& nloc, unsigned& nx) {
    const unsigned G = gridDim.x * gridDim.y * gridDim.z;
    unsigned sum, cnt, mine, sp = 0u;
    for (;;) {
        sum = 0u; cnt = 0u; mine = 0u;
#pragma unroll
        for (unsigned j = 0; j < 16; ++j) { const unsigned c = xb_ld(&bar[XB_XCNT(j)]); sum += c; cnt += (c > 0u) ? 1u : 0u; mine = (j == x) ? c : mine; }
        if (sum == G) break;
        __builtin_amdgcn_s_sleep(1);
        if ((++sp & 255u) == 0u) { if (xb_ld(&bar[XB_TMO])) break; if (sp > XB_SPIN_CAP) { atomicAdd(&bar[XB_TMO], 1u); break; } }
    }
    nloc = mine > 0u ? mine : 1u; nx = cnt > 0u ? cnt : 1u;
}
DI void xcd_barrier(const XcdBarrier& b) {
    asm volatile("s_waitcnt vmcnt(0)" ::: "memory");
    __syncthreads();
    if (threadIdx.x == 0) {
        unsigned* bar = b.bar;
        __builtin_amdgcn_s_waitcnt(0);
        unsigned nloc = b.st[0], nx = b.st[1];
        if (nloc == 0u) { xcd_barrier_complete(bar, b.x, nloc, nx); b.st[0] = nloc; b.st[1] = nx; }
        const unsigned old = xb_add(&bar[XB_XSUB(b.x)], 1u);
        const unsigned gen = old / nloc;
        if (old + 1u == (gen + 1u) * nloc) {
            __builtin_amdgcn_fence(__ATOMIC_RELEASE, "agent");
            asm volatile("s_waitcnt vmcnt(0)" ::: "memory");
            const unsigned og = xb_add(&bar[XB_TOP], 1u);
            const unsigned tg = og / nx;
            if (og + 1u == (tg + 1u) * nx) xb_add(&bar[XB_TOPGEN], 1u);
            else XB_SPIN(xb_ld(&bar[XB_TOPGEN]) == tg, bar);
            __builtin_amdgcn_fence(__ATOMIC_ACQUIRE, "agent");
            xb_add(&bar[XB_XGEN(b.x)], 1u);
            asm volatile("s_waitcnt vmcnt(0)" ::: "memory");
        } else {
            XB_SPIN(xb_ld(&bar[XB_XGEN(b.x)]) == gen, bar);
            __builtin_amdgcn_fence(__ATOMIC_ACQUIRE, "agent");
            asm volatile("s_waitcnt vmcnt(0)" ::: "memory");
        }
    }
    __syncthreads();
}

namespace pg8 {
constexpr int BM = 256, BK = 64, HALF = 128, HTB = HALF * BK * 2, STAGE_BYTES = 8 * HTB, NXCD = 8, WGM = 4;
DI int lds_byte(int r, int c) { const int st = (r >> 4) * 2 + (c >> 5), rr = r & 15, cc = c & 31, ob = rr * 64 + cc * 2; return st * 1024 + (ob ^ (((ob >> 9) & 1) << 5)); }
DI void stage_rc(int b, int& R, int& C) { const int st = b / 1024, sb = b % 1024, swz = sb ^ (((sb >> 9) & 1) << 5); R = (st >> 1) * 16 + swz / 64; C = (st & 1) * 32 + (swz % 64) / 2; }
DI int perm32(int rho) { const int n = rho >> 4, i = rho & 15; return 8 * (i >> 2) + 4 * n + (i & 3); }

struct Unit { int pm, pn, sub; };

struct Order {
    int nM, nN, nwg, G, c, pair;
    const char *A0, *A1, *B0, *B1; size_t a_tstep, b_tstep;
    DI void init(int nM_, int nN_, int G_, int c_, int pair_) { nM = nM_; nN = nN_; nwg = nM * nN; G = G_; c = c_; pair = pair_; }
    DI bool next(int i, Unit& u) const {
        const int t = pair ? (i >> 1) : i; u.sub = pair ? (i & 1) : 0;
        const long L = (long)t * G + c; if (L >= nwg) return false;
        int wgid = (int)L; { const int q = nwg / NXCD, r = nwg % NXCD, xcd = wgid % NXCD, off = wgid / NXCD; wgid = (xcd < r ? xcd * (q + 1) : r * (q + 1) + (xcd - r) * q) + off; }
        const int nig = WGM * nN, gid = wgid / nig, fm = gid * WGM, gsz = (nM - fm) < WGM ? (nM - fm) : WGM;
        u.pm = fm + ((wgid % nig) % gsz); u.pn = (wgid % nig) / gsz; return true;
    }
    DI const char* a_ptr(const Unit& u) const { return (u.sub ? A1 : A0) + (size_t)u.pm * a_tstep; }
    DI const char* b_ptr(const Unit& u) const { return (u.sub ? B1 : B0) + (size_t)u.pn * b_tstep; }
};

template <class Epi>
DI void gemm_phase(LAS unsigned char* lds, const int K, const int lda, const size_t a_kblk, const Order& S, const Epi& E) {
#define PG8_AK(x) ((size_t)((x) >> 2) * a_kblk + (size_t)((x) & 3) * 128)
    const int tid = threadIdx.x, wid = __builtin_amdgcn_readfirstlane(tid >> 6), lane = tid & 63, wr = wid >> 2, wc = wid & 3, fr = lane & 15, fq = lane >> 4;
    const int nt = K / BK;
    unsigned voffA[2], voffB[2];
#pragma unroll
    for (int i = 0; i < 2; ++i) { int R, C; stage_rc(tid * 16 + i * 8192, R, C); const int Rb = Epi::PERM ? ((R & ~31) + perm32(R & 31)) : R;
        voffA[i] = (unsigned)(R * lda + C) * 2u; voffB[i] = (unsigned)(Rb * K + C) * 2u; }
    const size_t kstep = (size_t)(BK * 2);
    const size_t hstepA = (size_t)HALF * lda * 2, hstepB = (size_t)HALF * K * 2;
    const unsigned ldsw = (unsigned)wid * 1024u;
    const int aoff = lds_byte(wr * 64 + fr, fq * 8), boff = lds_byte(wc * 32 + fr, fq * 8);
#define PG8_SA(b, h) (((b) * 2 + (h)) * HTB)
#define PG8_SB(b, h) ((4 + (b) * 2 + (h)) * HTB)
#define PG8_STAGE(bufoff, gbase, voff) do { _Pragma("unroll") for (int _i = 0; _i < 2; ++_i) \
        __builtin_amdgcn_global_load_lds((const unsigned*)((const char*)(gbase) + (voff)[_i]), (LAS unsigned*)(lds + (bufoff) + ldsw + _i * 8192), 16, 0, 0); } while (0)
#define PG8_LDA(dst, b, h) do { _Pragma("unroll") for (int m = 0; m < 4; ++m) _Pragma("unroll") for (int k = 0; k < 2; ++k) dst[m][k] = *(const LAS bf16x8*)(lds + PG8_SA(b, h) + aoff + m * 2048 + k * 1024); } while (0)
#define PG8_LDB(dst, b, h) do { _Pragma("unroll") for (int n = 0; n < 2; ++n) _Pragma("unroll") for (int k = 0; k < 2; ++k) dst[n][k] = *(const LAS bf16x8*)(lds + PG8_SB(b, h) + boff + n * 2048 + k * 1024); } while (0)
#define PG8_MMA(ai, bj, At, Bt) do { __builtin_amdgcn_s_setprio(1); _Pragma("unroll") for (int m = 0; m < 4; ++m) _Pragma("unroll") for (int n = 0; n < 2; ++n) _Pragma("unroll") for (int k = 0; k < 2; ++k) \
        acc[ai][bj][m][n] = __builtin_amdgcn_mfma_f32_16x16x32_bf16(Bt[n][k], At[m][k], acc[ai][bj][m][n], 0, 0, 0); __builtin_amdgcn_s_setprio(0); } while (0)
#define PG8_WAIT_V(n) asm volatile("s_waitcnt vmcnt(" #n ")" ::: "memory")
#define PG8_WAIT_L(n) asm volatile("s_waitcnt lgkmcnt(" #n ")" ::: "memory")
#define PG8_BAR __builtin_amdgcn_s_barrier()
#define PG8_SCHED __builtin_amdgcn_sched_barrier(0)
    Unit cur, nxt; int ui = 0;
    if (!S.next(0, cur)) return;
    f32x4 acc[2][2][4][2];
#pragma unroll
    for (int a = 0; a < 2; ++a)
#pragma unroll
        for (int b = 0; b < 2; ++b)
#pragma unroll
            for (int m = 0; m < 4; ++m)
#pragma unroll
                for (int n = 0; n < 2; ++n) acc[a][b][m][n] = (f32x4){0.f, 0.f, 0.f, 0.f};
    bf16x8 At[4][2], B0[2][2], B1[2][2];
    const char* cA = S.a_ptr(cur); const char* cB = S.b_ptr(cur);
    PG8_STAGE(PG8_SB(0, 0), cB, voffB); PG8_STAGE(PG8_SB(0, 1), cB + hstepB, voffB); PG8_STAGE(PG8_SA(0, 0), cA, voffA); PG8_STAGE(PG8_SA(0, 1), cA + hstepA, voffA);
    if (wr == 1) PG8_BAR;
    PG8_WAIT_V(2); PG8_BAR;
    PG8_STAGE(PG8_SB(1, 0), cB + kstep, voffB); PG8_STAGE(PG8_SA(1, 0), cA + kstep, voffA); PG8_STAGE(PG8_SB(1, 1), cB + hstepB + kstep, voffB);
    PG8_WAIT_V(6); PG8_BAR;
    for (;;) {
        const bool has_next = S.next(ui + 1, nxt);
        const char* nA = has_next ? S.a_ptr(nxt) : cA; const char* nB = has_next ? S.b_ptr(nxt) : cB;
        for (int t = 0; t < nt; t += 2) {
            const bool last = (t == nt - 2);
            const char* a1 = cA + PG8_AK(t + 1);
            const char* a2 = last ? nA : cA + PG8_AK(t + 2); const char* b2 = last ? nB : cB + (size_t)(t + 2) * kstep;
            const char* a3 = a2 + kstep; const char* b3 = b2 + kstep;
            PG8_LDB(B0, 0, 0); PG8_LDB(B1, 0, 1); PG8_SCHED; PG8_LDA(At, 0, 0); PG8_STAGE(PG8_SA(1, 1), a1 + hstepA, voffA);
            PG8_WAIT_V(8); PG8_WAIT_L(0); PG8_BAR; PG8_MMA(0, 0, At, B0); PG8_MMA(0, 1, At, B1); PG8_BAR; PG8_SCHED;
            PG8_LDA(At, 0, 1); PG8_STAGE(PG8_SB(0, 0), b2, voffB); PG8_STAGE(PG8_SB(0, 1), b2 + hstepB, voffB); PG8_STAGE(PG8_SA(0, 0), a2, voffA);
            PG8_WAIT_V(8); PG8_WAIT_L(0); PG8_BAR; PG8_MMA(1, 0, At, B0); PG8_MMA(1, 1, At, B1); PG8_BAR; PG8_SCHED;
            PG8_LDB(B0, 1, 0); PG8_LDB(B1, 1, 1); PG8_SCHED; PG8_LDA(At, 1, 0); PG8_STAGE(PG8_SA(0, 1), a2 + hstepA, voffA);
            PG8_WAIT_V(8); PG8_WAIT_L(0); PG8_BAR; PG8_MMA(0, 0, At, B0); PG8_MMA(0, 1, At, B1); PG8_BAR; PG8_SCHED;
            PG8_LDA(At, 1, 1); PG8_STAGE(PG8_SB(1, 0), b3, voffB); PG8_STAGE(PG8_SB(1, 1), b3 + hstepB, voffB); PG8_STAGE(PG8_SA(1, 0), a3, voffA);
            PG8_WAIT_V(8); PG8_WAIT_L(0); PG8_BAR; PG8_MMA(1, 0, At, B0); PG8_MMA(1, 1, At, B1); PG8_BAR; PG8_SCHED;
        }
        if (wr == 0) PG8_BAR;
        E(acc, cur, wr, wc, fr, fq);
        if (!has_next) break;
#pragma unroll
        for (int a = 0; a < 2; ++a)
#pragma unroll
            for (int b = 0; b < 2; ++b)
#pragma unroll
                for (int m = 0; m < 4; ++m)
#pragma unroll
                    for (int n = 0; n < 2; ++n) acc[a][b][m][n] = (f32x4){0.f, 0.f, 0.f, 0.f};
        cur = nxt; cA = nA; cB = nB; ++ui;
        if (wr == 1) PG8_BAR;
    }
    PG8_WAIT_V(0);
    PG8_BAR;
#undef PG8_AK
#undef PG8_SA
#undef PG8_SB
#undef PG8_STAGE
#undef PG8_LDA
#undef PG8_LDB
#undef PG8_MMA
#undef PG8_WAIT_V
#undef PG8_WAIT_L
#undef PG8_BAR
#undef PG8_SCHED
}

struct EpiU {
    static constexpr bool PERM = true;
    bf16_t* U; float* gate; float* out;
    DI void operator()(const f32x4 (&acc)[2][2][4][2], const Unit& u, int wr, int wc, int fr, int fq) const {
        const int row0 = u.pm * BM + wr * 64 + fr, pn = u.pn;
        if (pn == 66) {
            if (wc == 0 && fq < 2) {
#pragma unroll
                for (int ai = 0; ai < 2; ++ai)
#pragma unroll
                    for (int m = 0; m < 4; ++m) { float* g = gate + (size_t)(row0 + ai * HALF + m * 16) * 16 + 8 * fq;
                        *(f32x4*)g = acc[ai][0][m][0]; *(f32x4*)(g + 4) = acc[ai][0][m][1]; }
            }
            return;
        }
        const float scale = (pn < 8) ? 0.18033688011112042f : ((pn >= 22 && pn < 26) ? 0.08838834764831845f : 1.0f);
        const int col0 = pn * BM + wc * 32 + 8 * fq;
#pragma unroll
        for (int ai = 0; ai < 2; ++ai)
#pragma unroll
            for (int m = 0; m < 4; ++m) { bf16_t* rowp = U + (size_t)pn * UT + (size_t)(row0 + ai * HALF + m * 16) * 256 + (wc * 32 + 8 * fq);
#pragma unroll
                for (int bj = 0; bj < 2; ++bj) { const f32x4 v0 = acc[ai][bj][m][0] * scale, v1 = acc[ai][bj][m][1] * scale;
                    u32x4 w; w.x = pk2(v0[0], v0[1]); w.y = pk2(v0[2], v0[3]); w.z = pk2(v1[0], v1[1]); w.w = pk2(v1[2], v1[3]);
                    *(u32x4*)(rowp + bj * HALF) = w; } }
        if (pn == 8 || pn == 9) {
#pragma unroll
            for (int ai = 0; ai < 2; ++ai)
#pragma unroll
                for (int m = 0; m < 4; ++m) { const int r = row0 + ai * HALF + m * 16; float* dst = nullptr;
                    if (r >= 8064 && r < 8192) dst = out + (pn == 8 ? O_KP : O_VP) + (size_t)(r - 8064) * 256;
                    else if (r >= 8192 && r < 8448) { const int b = (r - 8192) >> 4, t = (r - 8192) & 15; dst = out + (pn == 8 ? O_KS : O_VS) + (size_t)(b * 128 + 112 + t) * 256; }
                    if (dst) {
#pragma unroll
                        for (int bj = 0; bj < 2; ++bj) { const int c = bj * HALF + wc * 32 + 8 * fq; *(f32x4*)(dst + c) = acc[ai][bj][m][0]; *(f32x4*)(dst + c + 4) = acc[ai][bj][m][1]; } } }
        }
    }
};
struct EpiMerge {
    static constexpr bool PERM = true;
    const bf16_t* U; bf16_t* MG;
    DI void operator()(const f32x4 (&acc)[2][2][4][2], const Unit& u, int wr, int wc, int fr, int fq) const {
        const int row0 = u.pm * BM + wr * 64 + fr, col0 = u.pn * BM + wc * 32 + 8 * fq; const int gcol = u.sub ? GM : GA;
#pragma unroll
        for (int ai = 0; ai < 2; ++ai) {
            u32x4 g[4][2], o[4][2];
#pragma unroll
            for (int m = 0; m < 4; ++m)
#pragma unroll
                for (int bj = 0; bj < 2; ++bj) { const int r = row0 + ai * HALF + m * 16, c = col0 + bj * HALF;
                    g[m][bj] = *(const u32x4*)(U + uoff(r, gcol + c));
                    o[m][bj] = u.sub ? *(const u32x4*)(MG + (size_t)r * DM + c) : (u32x4){0u, 0u, 0u, 0u}; }
#pragma unroll
            for (int m = 0; m < 4; ++m)
#pragma unroll
                for (int bj = 0; bj < 2; ++bj) { const int r = row0 + ai * HALF + m * 16, c = col0 + bj * HALF;
                    const u32x4 gg = g[m][bj], oo = o[m][bj]; const f32x4 a0 = acc[ai][bj][m][0], a1 = acc[ai][bj][m][1];
                    float v[8];
                    v[0] = sigmoidf_(bflo(gg.x)) * a0[0] + bflo(oo.x); v[1] = sigmoidf_(bfhi(gg.x)) * a0[1] + bfhi(oo.x); v[2] = sigmoidf_(bflo(gg.y)) * a0[2] + bflo(oo.y); v[3] = sigmoidf_(bfhi(gg.y)) * a0[3] + bfhi(oo.y);
                    v[4] = sigmoidf_(bflo(gg.z)) * a1[0] + bflo(oo.z); v[5] = sigmoidf_(bfhi(gg.z)) * a1[1] + bfhi(oo.z); v[6] = sigmoidf_(bflo(gg.w)) * a1[2] + bflo(oo.w); v[7] = sigmoidf_(bfhi(gg.w)) * a1[3] + bfhi(oo.w);
                    u32x4 w; w.x = pk2(v[0], v[1]); w.y = pk2(v[2], v[3]); w.z = pk2(v[4], v[5]); w.w = pk2(v[6], v[7]);
                    *(u32x4*)(MG + (size_t)r * DM + c) = w; }
        }
    }
};
struct EpiOut {
    static constexpr bool PERM = false;
    const float *xp, *xs; bf16_t* X1; float* ssq;
    DI void operator()(const f32x4 (&acc)[2][2][4][2], const Unit& u, int wr, int wc, int fr, int fq) const {
        const int row0 = u.pm * BM + wr * 64 + fr, col0 = u.pn * BM + wc * 32 + 4 * fq;
#pragma unroll
        for (int ai = 0; ai < 2; ++ai) {
            f32x4 xv[4][2][2];
#pragma unroll
            for (int m = 0; m < 4; ++m) { const int r = row0 + ai * HALF + m * 16; const float* xrow = (r < ROW_S) ? xp + (size_t)r * DM : xs + (size_t)(r - ROW_S) * DM;
#pragma unroll
                for (int bj = 0; bj < 2; ++bj)
#pragma unroll
                    for (int n = 0; n < 2; ++n) xv[m][bj][n] = *(const f32x4*)(xrow + col0 + bj * HALF + n * 16); }
#pragma unroll
            for (int m = 0; m < 4; ++m) { const int r = row0 + ai * HALF + m * 16; bf16_t* orow = X1 + (size_t)u.pn * UT + (size_t)r * 256 + wc * 32 + 4 * fq; float ss = 0.f;
#pragma unroll
                for (int bj = 0; bj < 2; ++bj)
#pragma unroll
                    for (int n = 0; n < 2; ++n) { const f32x4 o = xv[m][bj][n] + acc[ai][bj][m][n];
                        u32x2 w; w.x = pk2(o[0], o[1]); w.y = pk2(o[2], o[3]); *(u32x2*)(orow + bj * HALF + n * 16) = w; ss += (o[0] * o[0] + o[1] * o[1]) + (o[2] * o[2] + o[3] * o[3]); }
                ss += __shfl_xor(ss, 16); ss += __shfl_xor(ss, 32);
                if (fq == 0) ssq[(size_t)r * 32 + u.pn * 4 + wc] = ss; }
        }
    }
};
}

DI int win_src_col(int n) { return n < 10752 ? n : (n < 16896 ? n + 16 : (n < 16912 ? 10752 + (n - 16896) : -1)); }

DI void p0_transpose_item(const float* W, int Nsrc, int srccol4, bf16_t* WT, int dstrow0, int k0, LAS float* scr, int lane) {
    f32x4 r[8];
#pragma unroll
    for (int i = 0; i < 8; ++i) { const int kk = (lane >> 3) + 8 * i; r[i] = (srccol4 >= 0) ? *(const f32x4*)(W + (size_t)(k0 + kk) * Nsrc + srccol4) : (f32x4){0.f, 0.f, 0.f, 0.f}; }
#pragma unroll
    for (int i = 0; i < 8; ++i) { const int kk = (lane >> 3) + 8 * i; LAS float* d = scr + kk * 33 + 4 * (lane & 7); d[0] = r[i][0]; d[1] = r[i][1]; d[2] = r[i][2]; d[3] = r[i][3]; }
    LDS_WAIT();
    const int c = lane & 7;
#pragma unroll
    for (int j = 0; j < 4; ++j) { const int n = (lane >> 3) + 8 * j; const LAS float* s = scr + (8 * c) * 33 + n;
        u32x4 o; o.x = pk2(s[0 * 33], s[1 * 33]); o.y = pk2(s[2 * 33], s[3 * 33]); o.z = pk2(s[4 * 33], s[5 * 33]); o.w = pk2(s[6 * 33], s[7 * 33]);
        *(u32x4*)(WT + (size_t)(dstrow0 + n) * 2048 + k0 + 8 * c) = o; }
    LDS_WAIT();
}

DI void p0_prologue(const Params& p, LAS unsigned char* lds) {
    const int tid = threadIdx.x, lane = tid & 63, wave = tid >> 6;
    const int gw = blockIdx.x * 8 + wave, NGW = gridDim.x * 8;
    bf16_t* WIN = (bf16_t*)(p.ws + WS_WIN); bf16_t* WP = (bf16_t*)(p.ws + WS_WP); bf16_t* WOUT = (bf16_t*)(p.ws + WS_WOUT); bf16_t* XN = (bf16_t*)(p.ws + WS_XN);
    LAS float* scr = (LAS float*)(lds + wave * 16384);
    constexpr int I_IN = 32 * (NW / 32), I_SQ = 32 * 64;
    for (int it = gw; it < I_IN + 3 * I_SQ; it += NGW) {
        int r = it;
        if (r < I_IN) { const int nb = r % (NW / 32), kb = r / (NW / 32); p0_transpose_item(p.win, 16912, win_src_col(nb * 32 + 4 * (lane & 7)), WIN, nb * 32, kb * 64, scr, lane); continue; }
        r -= I_IN; const int which = r / I_SQ; r -= which * I_SQ; const int nb = r % 64, kb = r / 64;
        const float* W = which == 0 ? p.wpa : (which == 1 ? p.wpm : p.wout);
        bf16_t* WT = which == 2 ? WOUT : WP; const int drow = (which == 1 ? 2048 : 0) + nb * 32;
        p0_transpose_item(W, 2048, nb * 32 + 4 * (lane & 7), WT, drow, kb * 64, scr, lane);
    }
    for (int m = gw; m < MPAD; m += NGW) {
        u32x2* o8 = (u32x2*)(XN + (size_t)m * DM) + lane;
        if (m >= MROWS) {
#pragma unroll
            for (int j = 0; j < 8; ++j) o8[64 * j] = (u32x2){0u, 0u};
            continue; }
        const float* xrow = m < ROW_S ? p.xp + (size_t)m * DM : (m < ROW_M ? p.xs + (size_t)(m - ROW_S) * DM : p.meta + (size_t)(m - ROW_M) * DM);
        const f32x4* xr = (const f32x4*)xrow + lane; const f32x4* gr = (const f32x4*)p.gnorm + lane;
        f32x4 v[8]; float s = 0.f;
#pragma unroll
        for (int j = 0; j < 8; ++j) { v[j] = xr[64 * j]; s += (v[j][0] * v[j][0] + v[j][1] * v[j][1]) + (v[j][2] * v[j][2] + v[j][3] * v[j][3]); }
        const float rstd = rsqrtf(wsum(s) * (1.f / DM) + EPS);
#pragma unroll
        for (int j = 0; j < 8; ++j) { const f32x4 g = gr[64 * j]; u32x2 w; w.x = pk2(v[j][0] * rstd * g[0], v[j][1] * rstd * g[1]); w.y = pk2(v[j][2] * rstd * g[2], v[j][3] * rstd * g[3]); o8[64 * j] = w; }
    }
    const int gt = blockIdx.x * 512 + tid, NGT = gridDim.x * 512;
    for (int i = gt; i < 2 * 16 * 112 * 64; i += NGT) {
        const int kv = i / (16 * 112 * 64); int r = i - kv * (16 * 112 * 64); const int b = r / (112 * 64); r -= b * (112 * 64);
        const f32x4* src = (const f32x4*)((kv ? p.cv : p.ck) + (size_t)(b * 128 + 16) * 256) + r;
        f32x4* dst = (f32x4*)(p.out + (kv ? O_VS : O_KS) + (size_t)(b * 128) * 256) + r;
        *dst = *src;
    }
}

DI u32x4 attn_fetch8(const Params& p, const bf16_t* U, int kind, int bidx, int g, int key, int ch, int colbase, const float* cache) {
    u32x4 z = (u32x4){0u, 0u, 0u, 0u};
    if (key < 16) return *(const u32x4*)(U + uoff(ROW_M + key, colbase + g * 64 + 8 * ch));
    if (kind == 0) {
        const int row = 64 * (bidx - 2) + (key - 16);
        if (key < 208 && row >= 0) return *(const u32x4*)(U + uoff(row, colbase + g * 64 + 8 * ch));
        return z;
    } else {
        if (key < 144) { const float* s = cache + ((size_t)(bidx * 128 + (key - 16)) * 4 + g) * 64 + 8 * ch; const f32x4 a = *(const f32x4*)s, b = *(const f32x4*)(s + 4);
            u32x4 w; w.x = pk2(a[0], a[1]); w.y = pk2(a[2], a[3]); w.z = pk2(b[0], b[1]); w.w = pk2(b[2], b[3]); return w; }
        if (key < 160) return *(const u32x4*)(U + uoff(ROW_S + 16 * bidx + (key - 144), colbase + g * 64 + 8 * ch));
        return z;
    }
}
DI void attn_item(const Params& p, LAS unsigned char* lds, int kind, int bidx, int g, int dry) {
    int tid_ = threadIdx.x; asm volatile("" : "+v"(tid_)); const int tid = tid_, lane = tid & 63, wave = tid >> 6, lr = lane & 15, q = lane >> 4;
    bf16_t* U = (bf16_t*)(p.ws + WS_U);
    LAS bf16_t* KAl = (LAS bf16_t*)lds; LAS bf16_t* VAl = (LAS bf16_t*)(lds + 32256);
    const int hq = 8 * g + wave; const float sink = p.sinks[hq] * 1.4426950408889634f;
    const int npair = kind == 0 ? 2 : 1, qrow0 = kind == 0 ? 64 * bidx : ROW_S + 16 * bidx;
    const int hi_t = kind == 0 ? 13 : 10; const int lo_t = kind == 0 ? 1 + (bidx < 2 ? 4 * (2 - bidx) : 0) : 1;
    u32x4 kreg[4], vreg[4];
#pragma unroll
    for (int i = 0; i < 4; ++i) { const int ci = tid + 512 * i; kreg[i] = (u32x4){0u, 0u, 0u, 0u}; vreg[i] = kreg[i];
        if (ci < 224 * 8) { kreg[i] = attn_fetch8(p, U, kind, bidx, g, ci >> 3, ci & 7, KA, p.ck); vreg[i] = attn_fetch8(p, U, kind, bidx, g, ci >> 3, ci & 7, VA, p.cv); } }
#pragma unroll
    for (int i = 0; i < 4; ++i) { const int ci = tid + 512 * i; if (ci < 224 * 8) { *(LAS u32x4*)(KAl + (ci >> 3) * 72 + 8 * (ci & 7)) = kreg[i]; *(LAS u32x4*)(VAl + (ci >> 3) * 72 + 8 * (ci & 7)) = vreg[i]; } }
    __syncthreads();
    for (int pr = 0; pr < npair; ++pr) {
        const int tA = 2 * pr, tB = kind == 0 ? 2 * pr + 1 : 0;
        const size_t rowA = (size_t)(qrow0 + 16 * tA + lr) * 256 + (size_t)(hq >> 2) * UT + (hq & 3) * 64, rowB = (size_t)(qrow0 + 16 * tB + lr) * 256 + (size_t)(hq >> 2) * UT + (hq & 3) * 64;
        constexpr size_t ZOFF = (size_t)(ZA >> 8) * UT;
        bf16x8 qa[2], qb[2]; u32x2 za[4], zb[4];
#pragma unroll
        for (int ks = 0; ks < 2; ++ks) { qa[ks] = *(const bf16x8*)(U + rowA + 32 * ks + 8 * q); qb[ks] = *(const bf16x8*)(U + rowB + 32 * ks + 8 * q); }
#pragma unroll
        for (int dt = 0; dt < 4; ++dt) { za[dt] = *(const u32x2*)(U + rowA + ZOFF + 16 * dt + 4 * q); zb[dt] = *(const u32x2*)(U + rowB + ZOFF + 16 * dt + 4 * q); }
        f32x4 accA[14], accB[14];
        float mxA = -1e30f, mxB = -1e30f;
#pragma unroll
        for (int kt = 0; kt < 14; ++kt) {
            if (kt == 0 || (kt >= lo_t && kt < hi_t)) {
                accA[kt] = (f32x4){0.f, 0.f, 0.f, 0.f}; accB[kt] = accA[kt];
#pragma unroll
                for (int ks = 0; ks < 2; ++ks) { const bf16x8 a = *(const LAS bf16x8*)(KAl + (16 * kt + lr) * 72 + 32 * ks + 8 * q); accA[kt] = MFMA16(a, qa[ks], accA[kt]); accB[kt] = MFMA16(a, qb[ks], accB[kt]); }
                mxA = fmaxf(mxA, fmaxf(fmaxf(accA[kt][0], accA[kt][1]), fmaxf(accA[kt][2], accA[kt][3])));
                mxB = fmaxf(mxB, fmaxf(fmaxf(accB[kt][0], accB[kt][1]), fmaxf(accB[kt][2], accB[kt][3])));
            } else { accA[kt] = (f32x4){-1e30f, -1e30f, -1e30f, -1e30f}; accB[kt] = accA[kt]; }
        }
        mxA = fmaxf(mxA, __shfl_xor(mxA, 16)); mxA = fmaxf(mxA, __shfl_xor(mxA, 32)); mxB = fmaxf(mxB, __shfl_xor(mxB, 16)); mxB = fmaxf(mxB, __shfl_xor(mxB, 32));
        const float MA = fmaxf(mxA, sink), MB = fmaxf(mxB, sink); float sumA = 0.f, sumB = 0.f;
#pragma unroll
        for (int kt = 0; kt < 14; ++kt)
#pragma unroll
            for (int j = 0; j < 4; ++j) { const float ea = __builtin_amdgcn_exp2f(accA[kt][j] - MA), eb = __builtin_amdgcn_exp2f(accB[kt][j] - MB); accA[kt][j] = ea; accB[kt][j] = eb; sumA += ea; sumB += eb; }
        sumA += __shfl_xor(sumA, 16); sumA += __shfl_xor(sumA, 32); sumB += __shfl_xor(sumB, 16); sumB += __shfl_xor(sumB, 32);
        const float invA = 1.0f / (sumA + __builtin_amdgcn_exp2f(sink - MA)), invB = 1.0f / (sumB + __builtin_amdgcn_exp2f(sink - MB));
        bf16x8 pA[7], pB[7];
#pragma unroll
        for (int u = 0; u < 7; ++u) { u32x4 w; w.x = pk2(accA[2 * u][0], accA[2 * u][1]); w.y = pk2(accA[2 * u][2], accA[2 * u][3]);
            w.z = pk2(accA[2 * u + 1][0], accA[2 * u + 1][1]); w.w = pk2(accA[2 * u + 1][2], accA[2 * u + 1][3]); pA[u] = __builtin_bit_cast(bf16x8, w);
            w.x = pk2(accB[2 * u][0], accB[2 * u][1]); w.y = pk2(accB[2 * u][2], accB[2 * u][3]);
            w.z = pk2(accB[2 * u + 1][0], accB[2 * u + 1][1]); w.w = pk2(accB[2 * u + 1][2], accB[2 * u + 1][3]); pB[u] = __builtin_bit_cast(bf16x8, w); }
        f32x4 oA[4], oB[4];
#pragma unroll
        for (int dt = 0; dt < 4; ++dt) { oA[dt] = (f32x4){0.f, 0.f, 0.f, 0.f}; oB[dt] = oA[dt];
#pragma unroll
            for (int u = 0; u < 7; ++u) { const LAS bf16_t* vp = VAl + (32 * u + 4 * q + (lr >> 2)) * 72 + 16 * dt + 4 * (lr & 3);
                const s16x4 lo = tr_read(vp), hi = tr_read(vp + 16 * 72);
                const bf16x8 a = __builtin_shufflevector(lo, hi, 0, 1, 2, 3, 4, 5, 6, 7); oA[dt] = MFMA16(a, pA[u], oA[dt]); oB[dt] = MFMA16(a, pB[u], oB[dt]); } }
#pragma unroll
        for (int dt = 0; dt < 4; ++dt) { const int col = hq * 64 + 16 * dt + 4 * q;
            { const u32x2 z = za[dt]; u32x2 w; w.x = pk2(oA[dt][0] * invA * siluf_(bflo(z.x)), oA[dt][1] * invA * siluf_(bfhi(z.x))); w.y = pk2(oA[dt][2] * invA * siluf_(bflo(z.y)), oA[dt][3] * invA * siluf_(bfhi(z.y)));
              if (dry) *(u32x2*)((bf16_t*)(p.ws + WS_XN) + (size_t)(qrow0 + 16 * tA + lr) * DM + col) = w; else *(u32x2*)(U + rowA + 16 * dt + 4 * q) = w; }
            if (kind == 0) { const u32x2 z = zb[dt]; u32x2 w; w.x = pk2(oB[dt][0] * invB * siluf_(bflo(z.x)), oB[dt][1] * invB * siluf_(bfhi(z.x))); w.y = pk2(oB[dt][2] * invB * siluf_(bflo(z.y)), oB[dt][3] * invB * siluf_(bfhi(z.y)));
              if (dry) *(u32x2*)((bf16_t*)(p.ws + WS_XN) + (size_t)(qrow0 + 16 * tB + lr) * DM + col) = w; else *(u32x2*)(U + rowB + 16 * dt + 4 * q) = w; } }
    }
    __syncthreads();
}

constexpr int ML_T2 = 69632, ML_SC = 106496;
constexpr int PV = 272, PKS = 144;
DI void mlstm_v_load(const bf16_t* U, int R0, int h, int tid, u32x4 (&v)[8]) {
#pragma unroll
    for (int it = 0; it < 8; ++it) { const int ci = tid + 512 * it, row = ci >> 5, ch = ci & 31; v[it] = *(const u32x4*)(U + uoff(R0 + row, VM + h * 256 + 8 * ch)); }
}
DI void mlstm_v_store(LAS unsigned char* lds, int tid, const u32x4 (&v)[8]) {
    LAS bf16_t* Vl = (LAS bf16_t*)lds;
#pragma unroll
    for (int it = 0; it < 8; ++it) { const int ci = tid + 512 * it, row = ci >> 5, ch = ci & 31; *(LAS u32x4*)(Vl + row * PV + 8 * ch) = v[it]; }
}

DI void mlstm_sum_item(const Params& p, LAS unsigned char* lds, int h, int j) {
    int tid_ = threadIdx.x; asm volatile("" : "+v"(tid_)); const int tid = tid_, lane = tid & 63, wave = tid >> 6, lr = lane & 15, q = lane >> 4;
    const bf16_t* U = (const bf16_t*)(p.ws + WS_U); const float* GATE = (const float*)(p.ws + WS_GATE);
    LAS float* wS = (LAS float*)(lds + ML_SC);
    const int R0 = 128 * j;
    u32x4 vreg[8], kreg[4];
    mlstm_v_load(U, R0, h, tid, vreg);
#pragma unroll
    for (int it = 0; it < 4; ++it) { const int ci = tid + 512 * it, row = ci >> 4, ch = ci & 15; kreg[it] = *(const u32x4*)(U + uoff(R0 + row, KM + h * 128 + 8 * ch)); }
    if (wave == 0) {
        const float bi = p.bi[h], bfb = p.bf[h];
        const float gi0 = GATE[(size_t)(R0 + lane) * 16 + h] + bi, gi1 = GATE[(size_t)(R0 + 64 + lane) * 16 + h] + bi;
        const float lf0 = logsigmoidf_(GATE[(size_t)(R0 + lane) * 16 + 8 + h] + bfb), lf1 = logsigmoidf_(GATE[(size_t)(R0 + 64 + lane) * 16 + 8 + h] + bfb);
        const float c0 = scan_add(lf0, lane); const float tot0 = __shfl(c0, 63); const float c1 = scan_add(lf1, lane) + tot0; const float blast = __shfl(c1, 63);
        const float x0 = blast - c0 + gi0, x1 = blast - c1 + gi1; const float ml = wmax(fmaxf(x0, x1));
        wS[lane] = __expf(x0 - ml); wS[64 + lane] = __expf(x1 - ml);
        if (lane == 0) { ((float*)(p.ws + WS_BS))[h * NCH + j] = blast; ((float*)(p.ws + WS_ML))[h * NCH + j] = ml; }
    }
    mlstm_v_store(lds, tid, vreg);
    __syncthreads();
    {
        LAS bf16_t* Kl = (LAS bf16_t*)(lds + ML_T2);
#pragma unroll
        for (int it = 0; it < 4; ++it) { const int ci = tid + 512 * it, row = ci >> 4, ch = ci & 15; const u32x4 a = kreg[it]; const float w = wS[row];
            u32x4 o; o.x = pk2(bflo(a.x) * w, bfhi(a.x) * w); o.y = pk2(bflo(a.y) * w, bfhi(a.y) * w); o.z = pk2(bflo(a.z) * w, bfhi(a.z) * w); o.w = pk2(bflo(a.w) * w, bfhi(a.w) * w);
            *(LAS u32x4*)(Kl + row * PKS + 8 * ch) = o; }
    }
    __syncthreads();
    const LAS bf16_t* Vl = (const LAS bf16_t*)lds; const LAS bf16_t* Kl = (const LAS bf16_t*)(lds + ML_T2);
    {
        LAS float* npart = (LAS float*)(lds + ML_SC + 512);
        const int d = tid & 127, part = tid >> 7; float sm = 0.f;
#pragma unroll 8
        for (int r = 0; r < 32; ++r) sm += bf2f(Kl[(32 * part + r) * PKS + d]);
        npart[part * 128 + d] = sm;
    }
    f32x4 acc[2][8];
#pragma unroll
    for (int i = 0; i < 2; ++i)
#pragma unroll
        for (int dt = 0; dt < 8; ++dt) acc[i][dt] = (f32x4){0.f, 0.f, 0.f, 0.f};
#pragma unroll
    for (int ks = 0; ks < 4; ++ks) {
        bf16x8 a[2];
#pragma unroll
        for (int i = 0; i < 2; ++i) { const LAS bf16_t* vp = Vl + (32 * ks + 8 * q + (lr >> 2)) * PV + 16 * (2 * wave + i) + 4 * (lr & 3);
            const s16x4 lo = tr_read(vp), hi = tr_read(vp + 4 * PV); a[i] = __builtin_shufflevector(lo, hi, 0, 1, 2, 3, 4, 5, 6, 7); }
#pragma unroll
        for (int dt = 0; dt < 8; ++dt) { const LAS bf16_t* kp = Kl + (32 * ks + 8 * q + (lr >> 2)) * PKS + 16 * dt + 4 * (lr & 3);
            const s16x4 lo = tr_read(kp), hi = tr_read(kp + 4 * PKS); const bf16x8 b = __builtin_shufflevector(lo, hi, 0, 1, 2, 3, 4, 5, 6, 7);
#pragma unroll
            for (int i = 0; i < 2; ++i) acc[i][dt] = MFMA16(b, a[i], acc[i][dt]); }
    }
    bf16_t* UP = (bf16_t*)(p.ws + WS_UP) + (size_t)(h * NCH + j) * 256 * 128;
#pragma unroll
    for (int i = 0; i < 2; ++i)
#pragma unroll
        for (int dt = 0; dt < 8; ++dt) { u32x2 w; w.x = f2bf_c(acc[i][dt][0]) | (f2bf_c(acc[i][dt][1]) << 16); w.y = f2bf_c(acc[i][dt][2]) | (f2bf_c(acc[i][dt][3]) << 16);
            *(u32x2*)(UP + (size_t)(16 * (2 * wave + i) + lr) * 128 + 16 * dt + 4 * q) = w; }
    __syncthreads();
    if (tid < 128) { const LAS float* npart = (const LAS float*)(lds + ML_SC + 512);
        ((float*)(p.ws + WS_NP))[(size_t)(h * NCH + j) * 128 + tid] = (npart[tid] + npart[128 + tid]) + (npart[256 + tid] + npart[384 + tid]); }
    __syncthreads();
}

DI void mlstm_small_item(const Params& p, LAS unsigned char* lds, int b, int h, int dry) {
    int tid_ = threadIdx.x; asm volatile("" : "+v"(tid_)); const int tid = tid_, lane = tid & 63, wave = tid >> 6;
    bf16_t* U = (bf16_t*)(p.ws + WS_U); const float* GATE = (const float*)(p.ws + WS_GATE);
    const bool meta = (b == 16); const int R0 = meta ? ROW_M : ROW_S + 16 * b;
    LAS float* qT = (LAS float*)lds; LAS float* kwT = (LAS float*)(lds + 8192); LAS float* kS = (LAS float*)(lds + 16384);
    LAS float* Wm = (LAS float*)(lds + 24832); LAS float* sc = (LAS float*)(lds + 25856); LAS float* red = (LAS float*)(lds + 26624);
    LAS float* am = sc, *cm = sc + 16, *bb = sc + 32, *wsS = sc + 48, *misc = sc + 64, *qnS = sc + 80;
    const float* Cin = p.sC + (size_t)(b * 8 + h) * 128 * 256; const float* nin = p.sn + (size_t)(b * 8 + h) * 128;
    float* Cout = meta ? (float*)(p.ws + WS_C0) + (size_t)h * 128 * 256 : p.out + O_CS + (size_t)(b * 8 + h) * 128 * 256;
    float* nout = meta ? (float*)(p.ws + WS_N0) + h * 128 : p.out + O_NS + (size_t)(b * 8 + h) * 128;
#pragma unroll
    for (int i = 0; i < 4; ++i) { const int idx = tid + 512 * i, t = idx >> 7, d = idx & 127;
        qT[d * 16 + t] = bf2f(U[uoff(R0 + t, QM + h * 128 + d)]); kS[t * 132 + d] = bf2f(U[uoff(R0 + t, KM + h * 128 + d)]); }
    if (wave == 0) {
        const bool act = lane < 16; const int tl = act ? lane : 15;
        const float gi = GATE[(size_t)(R0 + tl) * 16 + h] + p.bi[h];
        const float lf = act ? logsigmoidf_(GATE[(size_t)(R0 + tl) * 16 + 8 + h] + p.bf[h]) : 0.f;
        const float c = scan_add(lf, lane); const float a = act ? gi - c : -3e38f; const float pm = scan_max(a, lane);
        const float mprev = meta ? 0.f : p.sm[b * 8 + h]; const float cmv = fmaxf(mprev, pm);
        const float b15 = __shfl(c, 15), cm15 = __shfl(cmv, 15); const float mnew = b15 + cm15;
        if (act) { am[lane] = a; cm[lane] = cmv; bb[lane] = c; wsS[lane] = __expf(b15 + a - mnew); }
        if (lane == 0) { misc[0] = __expf(b15 + mprev - mnew); misc[1] = mnew; misc[2] = mprev;
            if (meta) ((float*)(p.ws + WS_M0))[h] = mnew; else p.out[O_MS + b * 8 + h] = mnew; }
    }
    __syncthreads();
#pragma unroll
    for (int i = 0; i < 4; ++i) { const int idx = tid + 512 * i, s = idx >> 7, d = idx & 127; kwT[d * 16 + s] = kS[s * 132 + d] * wsS[s]; }
    if (tid < 256) { const int t = tid >> 4, s = tid & 15; float dot = 0.f;
        for (int d = 0; d < 128; ++d) dot += qT[d * 16 + t] * kS[s * 132 + d];
        Wm[t * 16 + s] = (s <= t) ? dot * __expf(am[s] - cm[t]) : 0.f;
    } else if (tid < 272) { const int t = tid - 256; float dot = 0.f;
        if (!meta) for (int d = 0; d < 128; ++d) dot += qT[d * 16 + t] * nin[d];
        qnS[t] = dot; }
    __syncthreads();
    const int e = tid & 255, dh = tid >> 8;
    float v[16];
#pragma unroll
    for (int s = 0; s < 16; ++s) v[s] = bf2f(U[uoff(R0 + s, VM + h * 256 + e)]);
    float acc[16];
#pragma unroll
    for (int t = 0; t < 16; ++t) acc[t] = 0.f;
    const float alast = misc[0], mprev = misc[2];
    for (int d0 = dh * 64; d0 < dh * 64 + 64; d0 += 16) {
        float cb[16];
#pragma unroll
        for (int dd = 0; dd < 16; ++dd) cb[dd] = meta ? 0.f : Cin[(size_t)(d0 + dd) * 256 + e];
#pragma unroll
        for (int dd = 0; dd < 16; ++dd) { const int d = d0 + dd; const float c = cb[dd];
            float cn = alast * c;
#pragma unroll
            for (int i = 0; i < 4; ++i) { const f32x4 q4 = *(const LAS f32x4*)(qT + d * 16 + 4 * i), k4 = *(const LAS f32x4*)(kwT + d * 16 + 4 * i);
#pragma unroll
                for (int jj = 0; jj < 4; ++jj) { acc[4 * i + jj] += q4[jj] * c; cn += k4[jj] * v[4 * i + jj]; } }
            Cout[(size_t)d * 256 + e] = cn; }
    }
#pragma unroll
    for (int t = 0; t < 16; ++t) red[(dh * 16 + t) * 256 + e] = acc[t];
    if (tid < 128) { float nn = alast * (meta ? 0.f : nin[tid]);
#pragma unroll
        for (int s = 0; s < 16; ++s) nn += kwT[tid * 16 + s];
        nout[tid] = nn; }
    __syncthreads();
    if (!meta) {
#pragma unroll
        for (int tl = 0; tl < 8; ++tl) { const int t = dh * 8 + tl;
            const float inter = red[t * 256 + e] + red[(16 + t) * 256 + e]; const float sc_t = __expf(mprev - cm[t]);
            float num = sc_t * inter, den = sc_t * qnS[t];
#pragma unroll
            for (int s = 0; s < 16; ++s) { const float w = Wm[t * 16 + s]; num += w * v[s]; den += w; }
            const float mt = bb[t] + cm[t];
            red[t * 256 + e] = num / fmaxf(fabsf(den), __expf(-mt)); }
    }
    __syncthreads();
    if (!meta) {
#pragma unroll
        for (int r = 0; r < 2; ++r) { const int t = 2 * wave + r; float hv[4]; float ss = 0.f;
#pragma unroll
            for (int i = 0; i < 4; ++i) { hv[i] = red[t * 256 + lane + 64 * i]; ss += hv[i] * hv[i]; }
            const float rstd = rsqrtf(wsum(ss) * (1.f / 256.f) + EPS);
            float ov[4], zv[4], gv[4];
#pragma unroll
            for (int i = 0; i < 4; ++i) { const int ee = lane + 64 * i; const size_t ro = (size_t)(R0 + t) * 256 + (size_t)h * UT + ee;
                ov[i] = bf2f(U[ro + (size_t)(OM >> 8) * UT]); zv[i] = bf2f(U[ro + (size_t)(ZM >> 8) * UT]); gv[i] = p.gmh[h * 256 + ee]; }
#pragma unroll
            for (int i = 0; i < 4; ++i) { const int ee = lane + 64 * i; const size_t ro = (size_t)(R0 + t) * 256 + (size_t)h * UT + ee;
                const float val = hv[i] * rstd * gv[i] * sigmoidf_(ov[i]) * siluf_(zv[i]);
                if (!dry) U[ro + (size_t)(OM >> 8) * UT] = (bf16_t)(pk2(val, 0.f) & 0xffffu); } }
    }
    __syncthreads();
}

DI void mlstm_scan(const Params& p, LAS unsigned char* lds) {
    const float* BS = (const float*)(p.ws + WS_BS); const float* MLv = (const float*)(p.ws + WS_ML); float* MS = (float*)(p.ws + WS_MS);
    const float* NPv = (const float*)(p.ws + WS_NP); float* NS = (float*)(p.ws + WS_NS);
    const float* C0 = (const float*)(p.ws + WS_C0); const float* N0 = (const float*)(p.ws + WS_N0); const float* M0 = (const float*)(p.ws + WS_M0);
    LAS float* tb = (LAS float*)lds, *tm = tb + 64, *ca = tb + 128, *cb = tb + 192, *cm = tb + 256;
    const int tid = threadIdx.x;
    for (int gid0 = blockIdx.x * 512; gid0 < 8 * 256 * 64; gid0 += gridDim.x * 512) {
        const int gid = gid0 + tid, h = gid0 >> 14, e = (gid >> 6) & 255, d = 2 * (gid & 63);
        const bf16_t* UP = (const bf16_t*)(p.ws + WS_UP) + (size_t)h * NCH * 256 * 128 + (size_t)e * 128 + d;
        unsigned u[64];
#pragma unroll
        for (int i = 0; i < 64; ++i) u[i] = *(const unsigned*)(UP + (size_t)i * 256 * 128);
        float cx = C0[((size_t)h * 128 + d) * 256 + e], cy = C0[((size_t)h * 128 + d + 1) * 256 + e];
        __syncthreads();
        if (tid < 64) { tb[tid] = BS[h * NCH + tid]; tm[tid] = MLv[h * NCH + tid]; }
        __syncthreads();
        if (tid == 0) { float m = M0[h];
            for (int k = 0; k < NCH; ++k) { const float bs = tb[k], ml = tm[k]; const float mn = fmaxf(bs + m, ml); ca[k] = __expf(bs + m - mn); cb[k] = __expf(ml - mn); cm[k] = m; m = mn; }
            cm[64] = m; }
        __syncthreads();
        unsigned* CS = (unsigned*)((bf16_t*)(p.ws + WS_CST) + (size_t)h * NCH * 256 * 128 + (size_t)e * 128 + d);
#pragma unroll
        for (int k = 0; k < NCH; ++k) { CS[(size_t)k * 256 * 64] = pk2(cx, cy); const float a = ca[k], b = cb[k]; cx = a * cx + b * bflo(u[k]); cy = a * cy + b * bfhi(u[k]); }
        p.out[O_CP + ((size_t)h * 128 + d) * 256 + e] = cx; p.out[O_CP + ((size_t)h * 128 + d + 1) * 256 + e] = cy;
        if ((gid0 & 16383) == 0) {
            if (tid < 128) { float nv[64];
#pragma unroll
                for (int k = 0; k < 64; ++k) nv[k] = NPv[(size_t)(h * NCH + k) * 128 + tid];
                float n = N0[h * 128 + tid];
#pragma unroll
                for (int k = 0; k < 64; ++k) { NS[(size_t)(h * NCH + k) * 128 + tid] = n; n = ca[k] * n + cb[k] * nv[k]; }
                p.out[O_NP + h * 128 + tid] = n; }
            else if (tid < 192) { MS[h * NCH + (tid - 128)] = cm[tid - 128]; if (tid == 128) p.out[O_MP + h] = cm[64]; }
        }
    }
    __syncthreads();
}

DI void mlstm_sw_tile(const LAS bf16_t* KN, const LAS float* aS, const bf16x8 (&qf)[4], int tT, int t, float cmt, int lr, int q, bf16x8 (&wf)[4], float& dsum) {
    dsum = 0.f;
#pragma unroll
    for (int u = 0; u < 4; ++u) {
        u32x4 w = (u32x4){0u, 0u, 0u, 0u};
#pragma unroll
        for (int hh = 0; hh < 2; ++hh) { const int st = 2 * u + hh;
            if (st <= tT) {
                f32x4 s4 = (f32x4){0.f, 0.f, 0.f, 0.f};
#pragma unroll
                for (int ks = 0; ks < 4; ++ks) { const bf16x8 a = *(const LAS bf16x8*)(KN + (16 * st + lr) * 136 + 32 * ks + 8 * q); s4 = MFMA16(a, qf[ks], s4); }
                float wv[4];
#pragma unroll
                for (int jj = 0; jj < 4; ++jj) { const int sx = 16 * st + 4 * q + jj; const float wg = (sx <= t) ? __expf(aS[sx] - cmt) : 0.f; wv[jj] = s4[jj] * wg; dsum += wv[jj]; }
                if (hh == 0) { w.x = pk2(wv[0], wv[1]); w.y = pk2(wv[2], wv[3]); } else { w.z = pk2(wv[0], wv[1]); w.w = pk2(wv[2], wv[3]); }
            } }
        wf[u] = __builtin_bit_cast(bf16x8, w);
    }
}
DI void mlstm_out_item(const Params& p, LAS unsigned char* lds, int h, int j, int dry) {
    int tid_ = threadIdx.x; asm volatile("" : "+v"(tid_)); const int tid = tid_, lane = tid & 63, wave = __builtin_amdgcn_readfirstlane(tid >> 6), lr = lane & 15, q = lane >> 4;
    const int g = wave >> 2, w = wave & 3, tA = w, tB = 7 - w;
    bf16_t* U = (bf16_t*)(p.ws + WS_U); const float* GATE = (const float*)(p.ws + WS_GATE);
    LAS float* aS = (LAS float*)(lds + ML_SC), *cmS = aS + 128, *bS = aS + 256, *nK = aS + 384, *ssx = aS + 512;
    const int R0 = 128 * j; const float mk = ((const float*)(p.ws + WS_MS))[h * NCH + j];
    u32x4 vreg[8], kn[4];
    mlstm_v_load(U, R0, h, tid, vreg);
#pragma unroll
    for (int it = 0; it < 4; ++it) { const int ci = tid + 512 * it, row = ci >> 4, ch = ci & 15; kn[it] = *(const u32x4*)(U + uoff(R0 + row, KM + h * 128 + 8 * ch)); }
    const int tokA = 16 * tA + lr, tokB = 16 * tB + lr;
    const size_t rowA = (size_t)(R0 + tokA) * 256, rowB = (size_t)(R0 + tokB) * 256;
    const size_t qoff = (size_t)((QM >> 8) + (h >> 1)) * UT + (h & 1) * 128 + 8 * q;
    bf16x8 qfA[4], qfB[4];
#pragma unroll
    for (int ks = 0; ks < 4; ++ks) { qfA[ks] = *(const bf16x8*)(U + rowA + qoff + 32 * ks); qfB[ks] = *(const bf16x8*)(U + rowB + qoff + 32 * ks); }
    if (wave == 0) {
        const float bi = p.bi[h], bfb = p.bf[h];
        const float gi0 = GATE[(size_t)(R0 + lane) * 16 + h] + bi, gi1 = GATE[(size_t)(R0 + 64 + lane) * 16 + h] + bi;
        const float lf0 = logsigmoidf_(GATE[(size_t)(R0 + lane) * 16 + 8 + h] + bfb), lf1 = logsigmoidf_(GATE[(size_t)(R0 + 64 + lane) * 16 + 8 + h] + bfb);
        const float c0 = scan_add(lf0, lane); const float tot0 = __shfl(c0, 63); const float c1 = scan_add(lf1, lane) + tot0;
        const float a0 = gi0 - c0, a1 = gi1 - c1;
        const float p0 = scan_max(a0, lane); const float t0 = __shfl(p0, 63); const float p1 = fmaxf(scan_max(a1, lane), t0);
        aS[lane] = a0; aS[64 + lane] = a1; cmS[lane] = fmaxf(mk, p0); cmS[64 + lane] = fmaxf(mk, p1); bS[lane] = c0; bS[64 + lane] = c1;
    } else if (wave < 3) { const int d = tid - 64; nK[d] = ((const float*)(p.ws + WS_NS))[(size_t)(h * NCH + j) * 128 + d]; }
    mlstm_v_store(lds, tid, vreg);
    {
        LAS bf16_t* KNw = (LAS bf16_t*)(lds + ML_T2);
#pragma unroll
        for (int it = 0; it < 4; ++it) { const int ci = tid + 512 * it, row = ci >> 4, ch = ci & 15; *(LAS u32x4*)(KNw + row * 136 + 8 * ch) = kn[it]; }
    }
    __syncthreads();
    const LAS bf16_t* VT = (const LAS bf16_t*)lds; const LAS bf16_t* KN = (const LAS bf16_t*)(lds + ML_T2);
    const float cmA = cmS[tokA], cmB = cmS[tokB];
    const float scaleA = __expf(mk - cmA), scaleB = __expf(mk - cmB), floA = __expf(-(bS[tokA] + cmA)), floB = __expf(-(bS[tokB] + cmB));
    float qnA = 0.f, qnB = 0.f;
#pragma unroll
    for (int ks = 0; ks < 4; ++ks)
#pragma unroll
        for (int i = 0; i < 8; ++i) { const float nv = nK[32 * ks + 8 * q + i]; qnA += bf2f((unsigned short)qfA[ks][i]) * nv; qnB += bf2f((unsigned short)qfB[ks][i]) * nv; }
    qnA += __shfl_xor(qnA, 16); qnA += __shfl_xor(qnA, 32); qnB += __shfl_xor(qnB, 16); qnB += __shfl_xor(qnB, 32);
    f32x4 accA[8], accB[8];
    const bf16_t* CS = (const bf16_t*)(p.ws + WS_CST) + (size_t)(h * NCH + j) * 256 * 128 + (size_t)(128 * g) * 128;
#pragma unroll
    for (int et = 0; et < 8; ++et) { accA[et] = (f32x4){0.f, 0.f, 0.f, 0.f}; accB[et] = accA[et]; }
#pragma unroll
    for (int ks = 0; ks < 4; ++ks) {
        bf16x8 ca[8];
#pragma unroll
        for (int et = 0; et < 8; ++et) ca[et] = *(const bf16x8*)(CS + (size_t)(16 * et + lr) * 128 + 32 * ks + 8 * q);
#pragma unroll
        for (int et = 0; et < 8; ++et) { accA[et] = MFMA16(ca[et], qfA[ks], accA[et]); accB[et] = MFMA16(ca[et], qfB[ks], accB[et]); }
    }
#pragma unroll
    for (int et = 0; et < 8; ++et) { accA[et] = accA[et] * scaleA; accB[et] = accB[et] * scaleB; }
    asm volatile("" ::: "memory");
    bf16x8 wfA[4], wfB[4]; float dsA, dsB;
    mlstm_sw_tile(KN, aS, qfA, tA, tokA, cmA, lr, q, wfA, dsA);
    mlstm_sw_tile(KN, aS, qfB, tB, tokB, cmB, lr, q, wfB, dsB);
#pragma unroll
    for (int u = 0; u < 4; ++u) {
        if (2 * u <= tB) {
#pragma unroll
            for (int et = 0; et < 8; ++et) { const LAS bf16_t* vp = VT + (32 * u + 4 * q + (lr >> 2)) * PV + 16 * (8 * g + et) + 4 * (lr & 3);
                const s16x4 lo = tr_read(vp), hi = tr_read(vp + 16 * PV); const bf16x8 vf = __builtin_shufflevector(lo, hi, 0, 1, 2, 3, 4, 5, 6, 7);
                accB[et] = MFMA16(vf, wfB[u], accB[et]);
                if (2 * u <= tA) accA[et] = MFMA16(vf, wfA[u], accA[et]); } }
    }
    asm volatile("" ::: "memory");
    dsA += __shfl_xor(dsA, 16); dsA += __shfl_xor(dsA, 32); dsB += __shfl_xor(dsB, 16); dsB += __shfl_xor(dsB, 32);
    const float invA = 1.0f / fmaxf(fabsf(scaleA * qnA + dsA), floA), invB = 1.0f / fmaxf(fabsf(scaleB * qnB + dsB), floB);
    float ssA = 0.f, ssB = 0.f;
#pragma unroll
    for (int et = 0; et < 8; ++et) { accA[et] = accA[et] * invA; accB[et] = accB[et] * invB;
        ssA += (accA[et][0] * accA[et][0] + accA[et][1] * accA[et][1]) + (accA[et][2] * accA[et][2] + accA[et][3] * accA[et][3]);
        ssB += (accB[et][0] * accB[et][0] + accB[et][1] * accB[et][1]) + (accB[et][2] * accB[et][2] + accB[et][3] * accB[et][3]); }
    ssA += __shfl_xor(ssA, 16); ssA += __shfl_xor(ssA, 32); ssB += __shfl_xor(ssB, 16); ssB += __shfl_xor(ssB, 32);
    if (q == 0) { ssx[((g * 4 + w) * 2 + 0) * 16 + lr] = ssA; ssx[((g * 4 + w) * 2 + 1) * 16 + lr] = ssB; }
    __syncthreads();
    const float rstdA = rsqrtf((ssA + ssx[(((g ^ 1) * 4 + w) * 2 + 0) * 16 + lr]) * (1.f / 256.f) + EPS);
    const float rstdB = rsqrtf((ssB + ssx[(((g ^ 1) * 4 + w) * 2 + 1) * 16 + lr]) * (1.f / 256.f) + EPS);
    const size_t ooff = (size_t)((OM >> 8) + h) * UT + 128 * g + 4 * q, zoff = (size_t)((ZM >> 8) + h) * UT + 128 * g + 4 * q;
#pragma unroll
    for (int T = 0; T < 2; ++T) {
        const size_t rowT = T ? rowB : rowA; const float rstd = T ? rstdB : rstdA; const int tok = T ? tokB : tokA;
        u32x2 ov[8], zv[8]; f32x4 gv[8];
#pragma unroll
        for (int et = 0; et < 8; ++et) { ov[et] = *(const u32x2*)(U + rowT + ooff + 16 * et); zv[et] = *(const u32x2*)(U + rowT + zoff + 16 * et); gv[et] = *(const f32x4*)(p.gmh + h * 256 + 128 * g + 16 * et + 4 * q); }
#pragma unroll
        for (int et = 0; et < 8; ++et) { const f32x4 a = T ? accB[et] : accA[et]; const u32x2 o = ov[et], z = zv[et]; const f32x4 gg = gv[et];
            u32x2 wv; wv.x = pk2(a[0] * rstd * gg[0] * sigmoidf_(bflo(o.x)) * siluf_(bflo(z.x)), a[1] * rstd * gg[1] * sigmoidf_(bfhi(o.x)) * siluf_(bfhi(z.x)));
            wv.y = pk2(a[2] * rstd * gg[2] * sigmoidf_(bflo(o.y)) * siluf_(bflo(z.y)), a[3] * rstd * gg[3] * sigmoidf_(bfhi(o.y)) * siluf_(bfhi(z.y)));
            if (dry) *(u32x2*)((bf16_t*)(p.ws + WS_XN) + (size_t)(R0 + tok) * DM + h * 256 + 128 * g + 16 * et + 4 * q) = wv; else *(u32x2*)(U + rowT + ooff + 16 * et) = wv; }
    }
    __syncthreads();
}

DI void skinny_core(f32x4 (&acc)[2][4], const bf16_t* A, size_t lda, size_t wstride, const bf16_t* Bt, int row0, int col0, int wave, int lr, int q) {
    const bf16_t* ap = A + (size_t)(row0 + lr) * lda + wstride * wave + 8 * q;
    const bf16_t* bp = Bt + (size_t)(col0 + lr) * 2048 + 256 * wave + 8 * q;
#pragma unroll 4
    for (int ks = 0; ks < 8; ++ks) {
        bf16x8 a[2], b[4];
#pragma unroll
        for (int rt = 0; rt < 2; ++rt) a[rt] = *(const bf16x8*)(ap + (size_t)rt * 16 * lda + 32 * ks);
#pragma unroll
        for (int ct = 0; ct < 4; ++ct) b[ct] = *(const bf16x8*)(bp + (size_t)ct * 16 * 2048 + 32 * ks);
#pragma unroll
        for (int rt = 0; rt < 2; ++rt)
#pragma unroll
            for (int ct = 0; ct < 4; ++ct) acc[rt][ct] = MFMA16(b[ct], a[rt], acc[rt][ct]);
    }
}
DI void skinny_put(LAS float* red, const f32x4 (&acc)[2][4], int slot, int lr, int q) {
#pragma unroll
    for (int rt = 0; rt < 2; ++rt)
#pragma unroll
        for (int ct = 0; ct < 4; ++ct) *(LAS f32x4*)(red + ((size_t)slot * 32 + 16 * rt + lr) * 64 + 16 * ct + 4 * q) = acc[rt][ct];
}
DI void skinny_merge(const Params& p, LAS unsigned char* lds) {
    const int tid = threadIdx.x, lane = tid & 63, wave = tid >> 6, lr = lane & 15, q = lane >> 4;
    const bf16_t* U = (const bf16_t*)(p.ws + WS_U); const bf16_t* WP = (const bf16_t*)(p.ws + WS_WP); bf16_t* MG = (bf16_t*)(p.ws + WS_XN);
    LAS float* red = (LAS float*)lds;
    for (int tile = blockIdx.x; tile < 256; tile += gridDim.x) {
        const int row0 = ROW_S + 32 * (tile >> 5), col0 = 64 * (tile & 31);
        f32x4 aa[2][4], am[2][4];
#pragma unroll
        for (int rt = 0; rt < 2; ++rt)
#pragma unroll
            for (int ct = 0; ct < 4; ++ct) { aa[rt][ct] = (f32x4){0.f, 0.f, 0.f, 0.f}; am[rt][ct] = (f32x4){0.f, 0.f, 0.f, 0.f}; }
        skinny_core(aa, U + (size_t)(QA >> 8) * UT, 256, UT, WP, row0, col0, wave, lr, q);
        skinny_core(am, U + (size_t)(OM >> 8) * UT, 256, UT, WP + (size_t)2048 * 2048, row0, col0, wave, lr, q);
        skinny_put(red, aa, wave * 2, lr, q); skinny_put(red, am, wave * 2 + 1, lr, q);
        __syncthreads();
        const int row = tid >> 4, c4 = (tid & 15) * 4;
        f32x4 ya = (f32x4){0.f, 0.f, 0.f, 0.f}, ym = ya;
#pragma unroll
        for (int w = 0; w < 8; ++w) { ya += *(const LAS f32x4*)(red + ((size_t)(2 * w) * 32 + row) * 64 + c4); ym += *(const LAS f32x4*)(red + ((size_t)(2 * w + 1) * 32 + row) * 64 + c4); }
        const size_t r = row0 + row; const int col = col0 + c4;
        const u32x2 ga = *(const u32x2*)(U + uoff((int)r, GA + col)), gm = *(const u32x2*)(U + uoff((int)r, GM + col));
        u32x2 w; w.x = pk2(sigmoidf_(bflo(ga.x)) * ya[0] + sigmoidf_(bflo(gm.x)) * ym[0], sigmoidf_(bfhi(ga.x)) * ya[1] + sigmoidf_(bfhi(gm.x)) * ym[1]);
        w.y = pk2(sigmoidf_(bflo(ga.y)) * ya[2] + sigmoidf_(bflo(gm.y)) * ym[2], sigmoidf_(bfhi(ga.y)) * ya[3] + sigmoidf_(bfhi(gm.y)) * ym[3]);
        *(u32x2*)(MG + r * DM + col) = w;
        __syncthreads();
    }
}
DI void skinny_out(const Params& p, LAS unsigned char* lds) {
    const int tid = threadIdx.x, lane = tid & 63, wave = tid >> 6, lr = lane & 15, q = lane >> 4;
    const bf16_t* MG = (const bf16_t*)(p.ws + WS_XN); const bf16_t* WO = (const bf16_t*)(p.ws + WS_WOUT); float* ssq = (float*)(p.ws + WS_SSQ);
    LAS float* red = (LAS float*)lds;
    for (int tile = blockIdx.x; tile < 256; tile += gridDim.x) {
        const int row0 = ROW_S + 32 * (tile >> 5), col0 = 64 * (tile & 31);
        f32x4 aa[2][4];
#pragma unroll
        for (int rt = 0; rt < 2; ++rt)
#pragma unroll
            for (int ct = 0; ct < 4; ++ct) aa[rt][ct] = (f32x4){0.f, 0.f, 0.f, 0.f};
        skinny_core(aa, MG, DM, 256, WO, row0, col0, wave, lr, q);
        skinny_put(red, aa, wave, lr, q);
        __syncthreads();
        const int row = tid >> 4, c4 = (tid & 15) * 4;
        f32x4 y = (f32x4){0.f, 0.f, 0.f, 0.f};
#pragma unroll
        for (int w = 0; w < 8; ++w) y += *(const LAS f32x4*)(red + ((size_t)w * 32 + row) * 64 + c4);
        const size_t r = row0 + row; const int col = col0 + c4;
        const f32x4 o = *(const f32x4*)(p.xs + (r - ROW_S) * DM + col) + y;
        { u32x2 w; w.x = pk2(o[0], o[1]); w.y = pk2(o[2], o[3]); *(u32x2*)((bf16_t*)(p.ws + WS_U) + uoff((int)r, col)) = w; }
        float ss = (o[0] * o[0] + o[1] * o[1]) + (o[2] * o[2] + o[3] * o[3]);
        ss += __shfl_xor(ss, 1); ss += __shfl_xor(ss, 2); ss += __shfl_xor(ss, 4); ss += __shfl_xor(ss, 8);
        if ((tid & 15) == 0) ssq[r * 32 + (tile & 31)] = ss;
        __syncthreads();
    }
}

DI void final_norm(const Params& p) {
    const int lane = threadIdx.x & 63, gw = blockIdx.x * 8 + (threadIdx.x >> 6), NGW = gridDim.x * 8;
    const float* ssq = (const float*)(p.ws + WS_SSQ); const bf16_t* X1 = (const bf16_t*)(p.ws + WS_U);
    for (int r = gw; r < MOUT; r += NGW) {
        u32x2 xv[8];
#pragma unroll
        for (int j = 0; j < 8; ++j) xv[j] = *(const u32x2*)(X1 + (size_t)j * UT + (size_t)r * 256 + 4 * lane);
        const float s = wsum(lane < 32 ? ssq[(size_t)r * 32 + lane] : 0.f);
        const float rstd = rsqrtf(s * (1.f / DM) + EPS);
        f32x4* o = (f32x4*)(p.out + (size_t)r * DM) + lane; const f32x4* g = (const f32x4*)p.gfinal + lane;
#pragma unroll
        for (int j = 0; j < 8; ++j) { const f32x4 gg = g[64 * j]; f32x4 v; v[0] = bflo(xv[j].x) * rstd * gg[0]; v[1] = bfhi(xv[j].x) * rstd * gg[1]; v[2] = bflo(xv[j].y) * rstd * gg[2]; v[3] = bfhi(xv[j].y) * rstd * gg[3]; o[64 * j] = v; }
    }
}

__global__ void __launch_bounds__(512, 2) mega(Params p) {
    extern __shared__ __attribute__((aligned(16))) unsigned char lds_raw[];
    LAS unsigned char* lds = (LAS unsigned char*)lds_raw;
    cg::grid_group grid = cg::this_grid();
    const int lo = p.ph_lo, hi = p.ph_hi;
#define IN(k) (lo <= (k) && (k) < hi)
#define STAMP(i) do { if (TPROBE >= 0 && blockIdx.x == 0 && threadIdx.x == 0) tsl[i] = __builtin_amdgcn_s_memrealtime(); } while (0)
#define SEAM(k) do { if (IN(k) && IN((k) + 1)) xcd_barrier(bar); STAMP((k) + 1); } while (0)
    volatile LAS unsigned long long* tsl = (volatile LAS unsigned long long*)(lds + 131072 + 1040);
    volatile LAS unsigned* bst = (volatile LAS unsigned*)(lds + 131072 + 1024);
    if (threadIdx.x < 2) bst[threadIdx.x] = 0u;
    __syncthreads();
    XcdBarrier bar = xcd_barrier_post((unsigned*)(p.ws + WS_BAR), bst);
    if (hi > 1000) grid.sync();
    bf16_t* U = (bf16_t*)(p.ws + WS_U);
    STAMP(0);
    if (IN(0)) for (int rep = 0; rep < REP0; ++rep) p0_prologue(p, lds);
    SEAM(0);
    if (IN(1)) for (int rep = 0; rep < REP1; ++rep) {
        pg8::Order S; S.init(MPAD / 256, NW / 256, gridDim.x, blockIdx.x, 0);
        S.A0 = S.A1 = (const char*)(p.ws + WS_XN); S.B0 = S.B1 = (const char*)(p.ws + WS_WIN); S.a_tstep = (size_t)256 * DM * 2; S.b_tstep = (size_t)256 * 2048 * 2;
        pg8::EpiU E{U, (float*)(p.ws + WS_GATE), p.out};
        pg8::gemm_phase<pg8::EpiU>(lds, 2048, DM, 512, S, E);
    }
    SEAM(1);
    if (IN(2)) {
        for (int rep = 0; rep < REP2; ++rep) { const int dry = rep + 1 < REP2;
        for (int it = blockIdx.x; it < 1224; it += gridDim.x) {
            if (it < 512) { if (!dry || (PSEL & 1)) attn_item(p, lds, 0, it >> 2, it & 3, dry); }
            else if (it < 576) { if (!dry || (PSEL & 1)) attn_item(p, lds, 1, (it - 512) >> 2, (it - 512) & 3, dry); }
            else if (it < 1088) { if (!dry || (PSEL & 2)) mlstm_sum_item(p, lds, (it - 576) & 7, (it - 576) >> 3); }
            else { if (!dry || (PSEL & 4)) mlstm_small_item(p, lds, (it - 1088) >> 3, (it - 1088) & 7, dry); }
        } }
    }
    SEAM(2);
    if (IN(3)) for (int rep = 0; rep < REP3; ++rep) mlstm_scan(p, lds);
    for (int rep = 0; rep < REPSYNC; ++rep) xcd_barrier(bar);
    SEAM(3);
    if (IN(4)) for (int rep = 0; rep < REP4; ++rep) { for (int it = blockIdx.x; it < 512; it += gridDim.x) mlstm_out_item(p, lds, it & 7, it >> 3, rep + 1 < REP4); }
    SEAM(4);
    if (IN(5)) for (int rep = 0; rep < REP56; ++rep) {
        pg8::Order S; S.init(ROW_S / 256, DM / 256, gridDim.x, blockIdx.x, 1);
        S.A0 = (const char*)(U + (size_t)(QA >> 8) * UT); S.A1 = (const char*)(U + (size_t)(OM >> 8) * UT); S.B0 = (const char*)(p.ws + WS_WP); S.B1 = S.B0 + (size_t)2048 * 2048 * 2;
        S.a_tstep = (size_t)256 * 256 * 2; S.b_tstep = (size_t)256 * 2048 * 2;
        pg8::EpiMerge E{U, (bf16_t*)(p.ws + WS_XN)};
        const bool skinny_first = (blockIdx.x >> 3) & 1;
        if (skinny_first) skinny_merge(p, lds);
        pg8::gemm_phase<pg8::EpiMerge>(lds, 2048, 256, UT * 2, S, E);
        if (!skinny_first) skinny_merge(p, lds);
    }
    SEAM(5);
    if (IN(6)) for (int rep = 0; rep < REP56; ++rep) {
        pg8::Order S; S.init(ROW_S / 256, DM / 256, gridDim.x, blockIdx.x, 0);
        S.A0 = S.A1 = (const char*)(p.ws + WS_XN); S.B0 = S.B1 = (const char*)(p.ws + WS_WOUT); S.a_tstep = (size_t)256 * DM * 2; S.b_tstep = (size_t)256 * 2048 * 2;
        pg8::EpiOut E{p.xp, p.xs, U, (float*)(p.ws + WS_SSQ)};
        const bool skinny_first = (blockIdx.x >> 3) & 1;
        if (skinny_first) skinny_out(p, lds);
        pg8::gemm_phase<pg8::EpiOut>(lds, 2048, DM, 512, S, E);
        if (!skinny_first) skinny_out(p, lds);
    }
    SEAM(6);
    if (IN(7)) final_norm(p);
    if (TPROBE >= 0 && blockIdx.x == 0 && threadIdx.x == 0) { const unsigned long long te = __builtin_amdgcn_s_memrealtime(); tsl[8] = te;
        const unsigned long long d = tsl[TPROBE + 1] - tsl[TPROBE]; while (__builtin_amdgcn_s_memrealtime() - te < 9ull * d) __builtin_amdgcn_s_sleep(8); }
#undef IN
#undef SEAM
}

extern "C" void kernel_launch(void* const* d_in, const int* in_sizes, int n_in, void* d_out, int out_size, void* d_ws, size_t ws_size, hipStream_t stream) {
    static int grid = 0;
    if (grid == 0) {
        if (n_in != 18 || out_size != 22889608 || ws_size < WS_END) { fprintf(stderr, "kernel_launch: unexpected shapes (n_in %d out %d ws %zu need %zu)\n", n_in, out_size, ws_size, (size_t)WS_END); grid = -1; return; }
        int dev = 0, cus = 0, per_cu = 0;
        hipGetDevice(&dev); hipDeviceGetAttribute(&cus, hipDeviceAttributeMultiprocessorCount, dev);
        if (hipFuncSetAttribute((const void*)mega, hipFuncAttributeMaxDynamicSharedMemorySize, LDS_BYTES) != hipSuccess) { fprintf(stderr, "kernel_launch: hipFuncSetAttribute failed\n"); grid = -1; return; }
        if (hipOccupancyMaxActiveBlocksPerMultiprocessor(&per_cu, (const void*)mega, 512, LDS_BYTES) != hipSuccess || per_cu < 1) { fprintf(stderr, "kernel_launch: occupancy query says %d\n", per_cu); (void)hipGetLastError(); }
        grid = cus > 0 ? cus : 256;
    }
    if (grid < 0) return;
    Params p{};
    p.xp = (const float*)d_in[0]; p.xs = (const float*)d_in[1]; p.ck = (const float*)d_in[2]; p.cv = (const float*)d_in[3];
    p.sC = (const float*)d_in[4]; p.sn = (const float*)d_in[5]; p.sm = (const float*)d_in[6]; p.meta = (const float*)d_in[7];
    p.gnorm = (const float*)d_in[8]; p.win = (const float*)d_in[9]; p.bi = (const float*)d_in[10]; p.bf = (const float*)d_in[11];
    p.sinks = (const float*)d_in[12]; p.gmh = (const float*)d_in[13]; p.wpa = (const float*)d_in[14]; p.wpm = (const float*)d_in[15];
    p.wout = (const float*)d_in[16]; p.gfinal = (const float*)d_in[17];
    p.out = (float*)d_out; p.ws = (unsigned char*)d_ws;
#if N_LAUNCH == 1
    p.ph_lo = 0; p.ph_hi = 8;
    if (hipMemsetAsync((char*)d_ws + WS_BAR, 0, 16384, stream) != hipSuccess) { fprintf(stderr, "kernel_launch: memset failed\n"); return; }
    void* args[] = {&p};
    hipError_t e = hipLaunchCooperativeKernel((const void*)mega, dim3(grid), dim3(512), args, LDS_BYTES, stream);
    if (e != hipSuccess) fprintf(stderr, "cooperative launch failed: %s (grid %d)\n", hipGetErrorString(e), grid);
#else
    for (int ph = 0; ph < 8; ++ph) { p.ph_lo = ph; p.ph_hi = ph + 1; hipLaunchKernelGGL(mega, dim3(grid), dim3(512), LDS_BYTES, stream, p); }
#endif
}
```

```cpp
#include <hip/hip_runtime.h>
#include <hip/hip_cooperative_groups.h>
#include <cstdio>
#include <cstdint>
namespace cg = cooperative_groups;

#ifndef REP1
#define REP1 1
#endif
#ifndef REP3
#define REP3 1
#endif
#ifndef REP0
#define REP0 1
#endif
#ifndef REP2
#define REP2 1
#endif
#ifndef REP4
#define REP4 1
#endif
#ifndef PSEL
#define PSEL 7
#endif
#ifndef TPROBE
#define TPROBE -1
#endif
#ifndef REP56
#define REP56 1
#endif
#ifndef REPSYNC
#define REPSYNC 0
#endif
#ifndef N_LAUNCH
#define N_LAUNCH 1
#endif

#define LAS __attribute__((address_space(3)))
typedef unsigned short bf16_t;
typedef short bf16x8 __attribute__((ext_vector_type(8)));
typedef short s16x4 __attribute__((ext_vector_type(4)));
typedef float f32x4 __attribute__((ext_vector_type(4)));
typedef float f32x2 __attribute__((ext_vector_type(2)));
typedef unsigned u32x4 __attribute__((ext_vector_type(4)));
typedef unsigned u32x2 __attribute__((ext_vector_type(2)));
#define DI __device__ __forceinline__

constexpr int DM = 2048;
constexpr int ROW_S = 8192, ROW_M = 8448, MROWS = 8464, MPAD = 8704, MOUT = 8448;
constexpr int NU = 16896, NW = 17152;
constexpr size_t UT = (size_t)8704 * 256;
__device__ __forceinline__ size_t uoff(int row, int col) { return (size_t)(col >> 8) * UT + (size_t)row * 256 + (col & 255); }
constexpr int QA = 0, KA = 2048, VA = 2304, ZA = 2560, QM = 4608, KM = 5632, VM = 6656, OM = 8704, ZM = 10752, GA = 12800, GM = 14848;
constexpr int NCH = 64;
constexpr float EPS = 1e-6f;
constexpr size_t O_KP = 17301504, O_VP = 17334272, O_CP = 17367040, O_NP = 17629184, O_MP = 17630208,
                 O_KS = 17630216, O_VS = 18154504, O_CS = 18678792, O_NS = 22873096, O_MS = 22889480;
constexpr size_t WS_WIN = 4096;
constexpr size_t WS_WP = WS_WIN + (size_t)NW * 2048 * 2;
constexpr size_t WS_WOUT = WS_WP + (size_t)4096 * 2048 * 2;
constexpr size_t WS_XN = WS_WOUT + (size_t)2048 * 2048 * 2;
constexpr size_t WS_U = WS_XN + (size_t)MPAD * 2048 * 2;
constexpr size_t WS_GATE = WS_U + (size_t)MPAD * NU * 2;
constexpr size_t WS_UP = WS_GATE + (size_t)MPAD * 16 * 4;
constexpr size_t WS_CST = WS_UP + (size_t)8 * NCH * 256 * 128 * 4;
constexpr size_t WS_NP = WS_CST + (size_t)8 * NCH * 256 * 128 * 2;
constexpr size_t WS_NS = WS_NP + (size_t)8 * NCH * 128 * 4;
constexpr size_t WS_BS = WS_NS + (size_t)8 * NCH * 128 * 4;
constexpr size_t WS_ML = WS_BS + 4096;
constexpr size_t WS_MS = WS_ML + 4096;
constexpr size_t WS_C0 = WS_MS + 4096;
constexpr size_t WS_N0 = WS_C0 + (size_t)8 * 128 * 256 * 4;
constexpr size_t WS_M0 = WS_N0 + 4096;
constexpr size_t WS_SSQ = WS_M0 + 4096;
constexpr size_t WS_BAR = WS_SSQ + (size_t)MOUT * 32 * 4;
constexpr size_t WS_END = WS_BAR + 16384;
constexpr int LDS_BYTES = 131072 + 2048;

struct Params {
    const float *xp, *xs, *ck, *cv, *sC, *sn, *sm, *meta, *gnorm, *win, *bi, *bf, *sinks, *gmh, *wpa, *wpm, *wout, *gfinal;
    float* out; unsigned char* ws; int ph_lo, ph_hi;
};

DI float bf2f(unsigned short b) { return __uint_as_float(((unsigned)b) << 16); }
DI float bflo(unsigned w) { return __uint_as_float(w << 16); }
DI float bfhi(unsigned w) { return __uint_as_float(w & 0xffff0000u); }
DI unsigned pk2(float lo, float hi) { unsigned r; asm volatile("v_cvt_pk_bf16_f32 %0, %1, %2\n\ts_nop 1" : "=v"(r) : "v"(lo), "v"(hi)); return r; }
DI unsigned f2bf_c(float f) { const unsigned u = __float_as_uint(f); return (u + 0x7fffu + ((u >> 16) & 1u)) >> 16; }
DI float sigmoidf_(float x) { return __builtin_amdgcn_rcpf(1.0f + __expf(-x)); }
DI float siluf_(float x) { return x * __builtin_amdgcn_rcpf(1.0f + __expf(-x)); }
DI float logsigmoidf_(float x) { return fminf(x, 0.f) - log1pf(__expf(-fabsf(x))); }
DI float wsum(float v) {
#pragma unroll
    for (int o = 1; o < 64; o <<= 1) v += __shfl_xor(v, o);
    return v;
}
DI float wmax(float v) {
#pragma unroll
    for (int o = 1; o < 64; o <<= 1) v = fmaxf(v, __shfl_xor(v, o));
    return v;
}
DI float scan_add(float v, int lane) {
#pragma unroll
    for (int o = 1; o < 64; o <<= 1) { float t = __shfl_up(v, o); if (lane >= o) v += t; }
    return v;
}
DI float scan_max(float v, int lane) {
#pragma unroll
    for (int o = 1; o < 64; o <<= 1) { float t = __shfl_up(v, o); if (lane >= o) v = fmaxf(v, t); }
    return v;
}
#define ROWPTR(m) ((m) < ROW_S ? p.xp + (size_t)(m) * DM : ((m) < ROW_M ? p.xs + (size_t)((m) - ROW_S) * DM : p.meta + (size_t)((m) - ROW_M) * DM))
DI s16x4 tr_read(const LAS bf16_t* p) { return __builtin_amdgcn_ds_read_tr16_b64_v4i16((LAS s16x4*)p); }
#define LDS_WAIT() asm volatile("s_waitcnt lgkmcnt(0)" ::: "memory")
#define MFMA16(a, b, c) __builtin_amdgcn_mfma_f32_16x16x32_bf16((a), (b), (c), 0, 0, 0)

#define XB_TMO      128
#define XB_XCNT(j)  (256  + 64 * (j))
#define XB_XSUB(j)  (1280 + 64 * (j))
#define XB_XGEN(j)  (2304 + 64 * (j))
#define XB_TOP      3328
#define XB_TOPGEN   3392
#define XCD_BAR_WORDS 3456
#define XB_SPIN_CAP (1u << 18)
DI unsigned xb_ld(unsigned* p)              { return __hip_atomic_load(p, __ATOMIC_RELAXED, __HIP_MEMORY_SCOPE_AGENT); }
DI unsigned xb_add(unsigned* p, unsigned v) { return __hip_atomic_fetch_add(p, v, __ATOMIC_RELAXED, __HIP_MEMORY_SCOPE_AGENT); }
DI unsigned xb_xcc_id() { return (unsigned)__builtin_amdgcn_s_getreg((3 << 11) | 20) & 0xFu; }
#define XB_SPIN(cond, bar) do { unsigned _sp = 0; while (cond) { __builtin_amdgcn_s_sleep(1); \
    if ((++_sp & 255u) == 0u) { if (xb_ld(&(bar)[XB_TMO])) break; if (_sp > XB_SPIN_CAP) { atomicAdd(&(bar)[XB_TMO], 1u); break; } } } } while (0)
struct XcdBarrier { unsigned* bar; unsigned x; volatile LAS unsigned* st; };
DI XcdBarrier xcd_barrier_post(unsigned* bar, volatile LAS unsigned* st) {
    XcdBarrier b; b.bar = bar; b.x = xb_xcc_id(); b.st = st;
    if (threadIdx.x == 0) (void)xb_add(&bar[XB_XCNT(b.x)], 1u);
    return b;
}
DI void xcd_barrier_complete(unsigned* bar, unsigned x, unsigned& nloc, unsigned& nx) {
    const unsigned G = gridDim.x * gridDim.y * gridDim.z;
    unsigned sum, cnt, mine, sp = 0u;
    for (;;) {
        sum = 0u; cnt = 0u; mine = 0u;
#pragma unroll
        for (unsigned j = 0; j < 16; ++j) { const unsigned c = xb_ld(&bar[XB_XCNT(j)]); sum += c; cnt += (c > 0u) ? 1u : 0u; mine = (j == x) ? c : mine; }
        if (sum == G) break;
        __builtin_amdgcn_s_sleep(1);
        if ((++sp & 255u) == 0u) { if (xb_ld(&bar[XB_TMO])) break; if (sp > XB_SPIN_CAP) { atomicAdd(&bar[XB_TMO], 1u); break; } }
    }
    nloc = mine > 0u ? mine : 1u; nx = cnt > 0u ? cnt : 1u;
}
DI void xcd_barrier(const XcdBarrier& b) {
    asm volatile("s_waitcnt vmcnt(0)" ::: "memory");
    __syncthreads();
    if (threadIdx.x == 0) {
        unsigned* bar = b.bar;
        __builtin_amdgcn_s_waitcnt(0);
        unsigned nloc = b.st[0], nx = b.st[1];
        if (nloc == 0u) { xcd_barrier_complete(bar, b.x, nloc, nx); b.st[0] = nloc; b.st[1] = nx; }
        const unsigned old = xb_add(&bar[XB_XSUB(b.x)], 1u);
        const unsigned gen = old / nloc;
        if (old + 1u == (gen + 1u) * nloc) {
            __builtin_amdgcn_fence(__ATOMIC_RELEASE, "agent");
            asm volatile("s_waitcnt vmcnt(0)" ::: "memory");
            const unsigned og = xb_add(&bar[XB_TOP], 1u);
            const unsigned tg = og / nx;
            if (og + 1u == (tg + 1u) * nx) xb_add(&bar[XB_TOPGEN], 1u);
            else XB_SPIN(xb_ld(&bar[XB_TOPGEN]) == tg, bar);
            __builtin_amdgcn_fence(__ATOMIC_ACQUIRE, "agent");
            xb_add(&bar[XB_XGEN(b.x)], 1u);
            asm volatile("s_waitcnt vmcnt(0)" ::: "memory");
        } else {
            XB_SPIN(xb_ld(&bar[XB_XGEN(b.x)]) == gen, bar);
            __builtin_amdgcn_fence(__ATOMIC_ACQUIRE, "agent");
            asm volatile("s_waitcnt vmcnt(0)" ::: "memory");
        }
    }
    __syncthreads();
}

namespace pg8 {
constexpr int BM = 256, BK = 64, HALF = 128, HTB = HALF * BK * 2, STAGE_BYTES = 8 * HTB, NXCD = 8, WGM = 4;
DI int lds_byte(int r, int c) { const int st = (r >> 4) * 2 + (c >> 5), rr = r & 15, cc = c & 31, ob = rr * 64 + cc * 2; return st * 1024 + (ob ^ (((ob >> 9) & 1) << 5)); }
DI void stage_rc(int b, int& R, int& C) { const int st = b / 1024, sb = b % 1024, swz = sb ^ (((sb >> 9) & 1) << 5); R = (st >> 1) * 16 + swz / 64; C = (st & 1) * 32 + (swz % 64) / 2; }
DI int perm32(int rho) { const int n = rho >> 4, i = rho & 15; return 8 * (i >> 2) + 4 * n + (i & 3); }

struct Unit { int pm, pn, sub; };

struct Order {
    int nM, nN, nwg, G, c, pair;
    const char *A0, *A1, *B0, *B1; size_t a_tstep, b_tstep;
    DI void init(int nM_, int nN_, int G_, int c_, int pair_) { nM = nM_; nN = nN_; nwg = nM * nN; G = G_; c = c_; pair = pair_; }
    DI bool next(int i, Unit& u) const {
        const int t = pair ? (i >> 1) : i; u.sub = pair ? (i & 1) : 0;
        const long L = (long)t * G + c; if (L >= nwg) return false;
        int wgid = (int)L; { const int q = nwg / NXCD, r = nwg % NXCD, xcd = wgid % NXCD, off = wgid / NXCD; wgid = (xcd < r ? xcd * (q + 1) : r * (q + 1) + (xcd - r) * q) + off; }
        const int nig = WGM * nN, gid = wgid / nig, fm = gid * WGM, gsz = (nM - fm) < WGM ? (nM - fm) : WGM;
        u.pm = fm + ((wgid % nig) % gsz); u.pn = (wgid % nig) / gsz; return true;
    }
    DI const char* a_ptr(const Unit& u) const { return (u.sub ? A1 : A0) + (size_t)u.pm * a_tstep; }
    DI const char* b_ptr(const Unit& u) const { return (u.sub ? B1 : B0) + (size_t)u.pn * b_tstep; }
};

template <class Epi>
DI void gemm_phase(LAS unsigned char* lds, const int K, const int lda, const size_t a_kblk, const Order& S, const Epi& E) {
#define PG8_AK(x) ((size_t)((x) >> 2) * a_kblk + (size_t)((x) & 3) * 128)
    const int tid = threadIdx.x, wid = __builtin_amdgcn_readfirstlane(tid >> 6), lane = tid & 63, wr = wid >> 2, wc = wid & 3, fr = lane & 15, fq = lane >> 4;
    const int nt = K / BK;
    unsigned voffA[2], voffB[2];
#pragma unroll
    for (int i = 0; i < 2; ++i) { int R, C; stage_rc(tid * 16 + i * 8192, R, C); const int Rb = Epi::PERM ? ((R & ~31) + perm32(R & 31)) : R;
        voffA[i] = (unsigned)(R * lda + C) * 2u; voffB[i] = (unsigned)(Rb * K + C) * 2u; }
    const size_t kstep = (size_t)(BK * 2);
    const size_t hstepA = (size_t)HALF * lda * 2, hstepB = (size_t)HALF * K * 2;
    const unsigned ldsw = (unsigned)wid * 1024u;
    const int aoff = lds_byte(wr * 64 + fr, fq * 8), boff = lds_byte(wc * 32 + fr, fq * 8);
#define PG8_SA(b, h) (((b) * 2 + (h)) * HTB)
#define PG8_SB(b, h) ((4 + (b) * 2 + (h)) * HTB)
#define PG8_STAGE(bufoff, gbase, voff) do { _Pragma("unroll") for (int _i = 0; _i < 2; ++_i) \
        __builtin_amdgcn_global_load_lds((const unsigned*)((const char*)(gbase) + (voff)[_i]), (LAS unsigned*)(lds + (bufoff) + ldsw + _i * 8192), 16, 0, 0); } while (0)
#define PG8_LDA(dst, b, h) do { _Pragma("unroll") for (int m = 0; m < 4; ++m) _Pragma("unroll") for (int k = 0; k < 2; ++k) dst[m][k] = *(const LAS bf16x8*)(lds + PG8_SA(b, h) + aoff + m * 2048 + k * 1024); } while (0)
#define PG8_LDB(dst, b, h) do { _Pragma("unroll") for (int n = 0; n < 2; ++n) _Pragma("unroll") for (int k = 0; k < 2; ++k) dst[n][k] = *(const LAS bf16x8*)(lds + PG8_SB(b, h) + boff + n * 2048 + k * 1024); } while (0)
#define PG8_MMA(ai, bj, At, Bt) do { __builtin_amdgcn_s_setprio(1); _Pragma("unroll") for (int m = 0; m < 4; ++m) _Pragma("unroll") for (int n = 0; n < 2; ++n) _Pragma("unroll") for (int k = 0; k < 2; ++k) \
        acc[ai][bj][m][n] = __builtin_amdgcn_mfma_f32_16x16x32_bf16(Bt[n][k], At[m][k], acc[ai][bj][m][n], 0, 0, 0); __builtin_amdgcn_s_setprio(0); } while (0)
#define PG8_WAIT_V(n) asm volatile("s_waitcnt vmcnt(" #n ")" ::: "memory")
#define PG8_WAIT_L(n) asm volatile("s_waitcnt lgkmcnt(" #n ")" ::: "memory")
#define PG8_BAR __builtin_amdgcn_s_barrier()
#define PG8_SCHED __builtin_amdgcn_sched_barrier(0)
    Unit cur, nxt; int ui = 0;
    if (!S.next(0, cur)) return;
    f32x4 acc[2][2][4][2];
#pragma unroll
    for (int a = 0; a < 2; ++a)
#pragma unroll
        for (int b = 0; b < 2; ++b)
#pragma unroll
            for (int m = 0; m < 4; ++m)
#pragma unroll
                for (int n = 0; n < 2; ++n) acc[a][b][m][n] = (f32x4){0.f, 0.f, 0.f, 0.f};
    bf16x8 At[4][2], B0[2][2], B1[2][2];
    const char* cA = S.a_ptr(cur); const char* cB = S.b_ptr(cur);
    PG8_STAGE(PG8_SB(0, 0), cB, voffB); PG8_STAGE(PG8_SB(0, 1), cB + hstepB, voffB); PG8_STAGE(PG8_SA(0, 0), cA, voffA); PG8_STAGE(PG8_SA(0, 1), cA + hstepA, voffA);
    if (wr == 1) PG8_BAR;
    PG8_WAIT_V(2); PG8_BAR;
    PG8_STAGE(PG8_SB(1, 0), cB + kstep, voffB); PG8_STAGE(PG8_SA(1, 0), cA + kstep, voffA); PG8_STAGE(PG8_SB(1, 1), cB + hstepB + kstep, voffB);
    PG8_WAIT_V(6); PG8_BAR;
    for (;;) {
        const bool has_next = S.next(ui + 1, nxt);
        const char* nA = has_next ? S.a_ptr(nxt) : cA; const char* nB = has_next ? S.b_ptr(nxt) : cB;
        for (int t = 0; t < nt; t += 2) {
            const bool last = (t == nt - 2);
            const char* a1 = cA + PG8_AK(t + 1);
            const char* a2 = last ? nA : cA + PG8_AK(t + 2); const char* b2 = last ? nB : cB + (size_t)(t + 2) * kstep;
            const char* a3 = a2 + kstep; const char* b3 = b2 + kstep;
            PG8_LDB(B0, 0, 0); PG8_LDB(B1, 0, 1); PG8_SCHED; PG8_LDA(At, 0, 0); PG8_STAGE(PG8_SA(1, 1), a1 + hstepA, voffA);
            PG8_WAIT_V(8); PG8_WAIT_L(0); PG8_BAR; PG8_MMA(0, 0, At, B0); PG8_MMA(0, 1, At, B1); PG8_BAR; PG8_SCHED;
            PG8_LDA(At, 0, 1); PG8_STAGE(PG8_SB(0, 0), b2, voffB); PG8_STAGE(PG8_SB(0, 1), b2 + hstepB, voffB); PG8_STAGE(PG8_SA(0, 0), a2, voffA);
            PG8_WAIT_V(8); PG8_WAIT_L(0); PG8_BAR; PG8_MMA(1, 0, At, B0); PG8_MMA(1, 1, At, B1); PG8_BAR; PG8_SCHED;
            PG8_LDB(B0, 1, 0); PG8_LDB(B1, 1, 1); PG8_SCHED; PG8_LDA(At, 1, 0); PG8_STAGE(PG8_SA(0, 1), a2 + hstepA, voffA);
            PG8_WAIT_V(8); PG8_WAIT_L(0); PG8_BAR; PG8_MMA(0, 0, At, B0); PG8_MMA(0, 1, At, B1); PG8_BAR; PG8_SCHED;
            PG8_LDA(At, 1, 1); PG8_STAGE(PG8_SB(1, 0), b3, voffB); PG8_STAGE(PG8_SB(1, 1), b3 + hstepB, voffB); PG8_STAGE(PG8_SA(1, 0), a3, voffA);
            PG8_WAIT_V(8); PG8_WAIT_L(0); PG8_BAR; PG8_MMA(1, 0, At, B0); PG8_MMA(1, 1, At, B1); PG8_BAR; PG8_SCHED;
        }
        if (wr == 0) PG8_BAR;
        E(acc, cur, wr, wc, fr, fq);
        if (!has_next) break;
#pragma unroll
        for (int a = 0; a < 2; ++a)
#pragma unroll
            for (int b = 0; b < 2; ++b)
#pragma unroll
                for (int m = 0; m < 4; ++m)
#pragma unroll
                    for (int n = 0; n < 2; ++n) acc[a][b][m][n] = (f32x4){0.f, 0.f, 0.f, 0.f};
        cur = nxt; cA = nA; cB = nB; ++ui;
        if (wr == 1) PG8_BAR;
    }
    PG8_WAIT_V(0);
    PG8_BAR;
#undef PG8_AK
#undef PG8_SA
#undef PG8_SB
#undef PG8_STAGE
#undef PG8_LDA
#undef PG8_LDB
#undef PG8_MMA
#undef PG8_WAIT_V
#undef PG8_WAIT_L
#undef PG8_BAR
#undef PG8_SCHED
}

struct EpiU {
    static constexpr bool PERM = true;
    bf16_t* U; float* gate; float* out;
    DI void operator()(const f32x4 (&acc)[2][2][4][2], const Unit& u, int wr, int wc, int fr, int fq) const {
        const int row0 = u.pm * BM + wr * 64 + fr, pn = u.pn;
        if (pn == 66) {
            if (wc == 0 && fq < 2) {
#pragma unroll
                for (int ai = 0; ai < 2; ++ai)
#pragma unroll
                    for (int m = 0; m < 4; ++m) { float* g = gate + (size_t)(row0 + ai * HALF + m * 16) * 16 + 8 * fq;
                        *(f32x4*)g = acc[ai][0][m][0]; *(f32x4*)(g + 4) = acc[ai][0][m][1]; }
            }
            return;
        }
        const float scale = (pn < 8) ? 0.18033688011112042f : ((pn >= 22 && pn < 26) ? 0.08838834764831845f : 1.0f);
        const int col0 = pn * BM + wc * 32 + 8 * fq;
#pragma unroll
        for (int ai = 0; ai < 2; ++ai)
#pragma unroll
            for (int m = 0; m < 4; ++m) { bf16_t* rowp = U + (size_t)pn * UT + (size_t)(row0 + ai * HALF + m * 16) * 256 + (wc * 32 + 8 * fq);
#pragma unroll
                for (int bj = 0; bj < 2; ++bj) { const f32x4 v0 = acc[ai][bj][m][0] * scale, v1 = acc[ai][bj][m][1] * scale;
                    u32x4 w; w.x = pk2(v0[0], v0[1]); w.y = pk2(v0[2], v0[3]); w.z = pk2(v1[0], v1[1]); w.w = pk2(v1[2], v1[3]);
                    *(u32x4*)(rowp + bj * HALF) = w; } }
        if (pn == 8 || pn == 9) {
#pragma unroll
            for (int ai = 0; ai < 2; ++ai)
#pragma unroll
                for (int m = 0; m < 4; ++m) { const int r = row0 + ai * HALF + m * 16; float* dst = nullptr;
                    if (r >= 8064 && r < 8192) dst = out + (pn == 8 ? O_KP : O_VP) + (size_t)(r - 8064) * 256;
                    else if (r >= 8192 && r < 8448) { const int b = (r - 8192) >> 4, t = (r - 8192) & 15; dst = out + (pn == 8 ? O_KS : O_VS) + (size_t)(b * 128 + 112 + t) * 256; }
                    if (dst) {
#pragma unroll
                        for (int bj = 0; bj < 2; ++bj) { const int c = bj * HALF + wc * 32 + 8 * fq; *(f32x4*)(dst + c) = acc[ai][bj][m][0]; *(f32x4*)(dst + c + 4) = acc[ai][bj][m][1]; } } }
        }
    }
};
struct EpiMerge {
    static constexpr bool PERM = true;
    const bf16_t* U; bf16_t* MG;
    DI void operator()(const f32x4 (&acc)[2][2][4][2], const Unit& u, int wr, int wc, int fr, int fq) const {
        const int row0 = u.pm * BM + wr * 64 + fr, col0 = u.pn * BM + wc * 32 + 8 * fq; const int gcol = u.sub ? GM : GA;
#pragma unroll
        for (int ai = 0; ai < 2; ++ai) {
            u32x4 g[4][2], o[4][2];
#pragma unroll
            for (int m = 0; m < 4; ++m)
#pragma unroll
                for (int bj = 0; bj < 2; ++bj) { const int r = row0 + ai * HALF + m * 16, c = col0 + bj * HALF;
                    g[m][bj] = *(const u32x4*)(U + uoff(r, gcol + c));
                    o[m][bj] = u.sub ? *(const u32x4*)(MG + (size_t)r * DM + c) : (u32x4){0u, 0u, 0u, 0u}; }
#pragma unroll
            for (int m = 0; m < 4; ++m)
#pragma unroll
                for (int bj = 0; bj < 2; ++bj) { const int r = row0 + ai * HALF + m * 16, c = col0 + bj * HALF;
                    const u32x4 gg = g[m][bj], oo = o[m][bj]; const f32x4 a0 = acc[ai][bj][m][0], a1 = acc[ai][bj][m][1];
                    float v[8];
                    v[0] = sigmoidf_(bflo(gg.x)) * a0[0] + bflo(oo.x); v[1] = sigmoidf_(bfhi(gg.x)) * a0[1] + bfhi(oo.x); v[2] = sigmoidf_(bflo(gg.y)) * a0[2] + bflo(oo.y); v[3] = sigmoidf_(bfhi(gg.y)) * a0[3] + bfhi(oo.y);
                    v[4] = sigmoidf_(bflo(gg.z)) * a1[0] + bflo(oo.z); v[5] = sigmoidf_(bfhi(gg.z)) * a1[1] + bfhi(oo.z); v[6] = sigmoidf_(bflo(gg.w)) * a1[2] + bflo(oo.w); v[7] = sigmoidf_(bfhi(gg.w)) * a1[3] + bfhi(oo.w);
                    u32x4 w; w.x = pk2(v[0], v[1]); w.y = pk2(v[2], v[3]); w.z = pk2(v[4], v[5]); w.w = pk2(v[6], v[7]);
                    *(u32x4*)(MG + (size_t)r * DM + c) = w; }
        }
    }
};
struct EpiOut {
    static constexpr bool PERM = false;
    const float *xp, *xs; bf16_t* X1; float* ssq;
    DI void operator()(const f32x4 (&acc)[2][2][4][2], const Unit& u, int wr, int wc, int fr, int fq) const {
        const int row0 = u.pm * BM + wr * 64 + fr, col0 = u.pn * BM + wc * 32 + 4 * fq;
#pragma unroll
        for (int ai = 0; ai < 2; ++ai) {
            f32x4 xv[4][2][2];
#pragma unroll
            for (int m = 0; m < 4; ++m) { const int r = row0 + ai * HALF + m * 16; const float* xrow = (r < ROW_S) ? xp + (size_t)r * DM : xs + (size_t)(r - ROW_S) * DM;
#pragma unroll
                for (int bj = 0; bj < 2; ++bj)
#pragma unroll
                    for (int n = 0; n < 2; ++n) xv[m][bj][n] = *(const f32x4*)(xrow + col0 + bj * HALF + n * 16); }
#pragma unroll
            for (int m = 0; m < 4; ++m) { const int r = row0 + ai * HALF + m * 16; bf16_t* orow = X1 + (size_t)u.pn * UT + (size_t)r * 256 + wc * 32 + 4 * fq; float ss = 0.f;
#pragma unroll
                for (int bj = 0; bj < 2; ++bj)
#pragma unroll
                    for (int n = 0; n < 2; ++n) { const f32x4 o = xv[m][bj][n] + acc[ai][bj][m][n];
                        u32x2 w; w.x = pk2(o[0], o[1]); w.y = pk2(o[2], o[3]); *(u32x2*)(orow + bj * HALF + n * 16) = w; ss += (o[0] * o[0] + o[1] * o[1]) + (o[2] * o[2] + o[3] * o[3]); }
                ss += __shfl_xor(ss, 16); ss += __shfl_xor(ss, 32);
                if (fq == 0) ssq[(size_t)r * 32 + u.pn * 4 + wc] = ss; }
        }
    }
};
}

DI int win_src_col(int n) { return n < 10752 ? n : (n < 16896 ? n + 16 : (n < 16912 ? 10752 + (n - 16896) : -1)); }

DI void p0_transpose_item(const float* W, int Nsrc, int srccol4, bf16_t* WT, int dstrow0, int k0, LAS float* scr, int lane) {
    f32x4 r[8];
#pragma unroll
    for (int i = 0; i < 8; ++i) { const int kk = (lane >> 3) + 8 * i; r[i] = (srccol4 >= 0) ? *(const f32x4*)(W + (size_t)(k0 + kk) * Nsrc + srccol4) : (f32x4){0.f, 0.f, 0.f, 0.f}; }
#pragma unroll
    for (int i = 0; i < 8; ++i) { const int kk = (lane >> 3) + 8 * i; LAS float* d = scr + kk * 33 + 4 * (lane & 7); d[0] = r[i][0]; d[1] = r[i][1]; d[2] = r[i][2]; d[3] = r[i][3]; }
    LDS_WAIT();
    const int c = lane & 7;
#pragma unroll
    for (int j = 0; j < 4; ++j) { const int n = (lane >> 3) + 8 * j; const LAS float* s = scr + (8 * c) * 33 + n;
        u32x4 o; o.x = pk2(s[0 * 33], s[1 * 33]); o.y = pk2(s[2 * 33], s[3 * 33]); o.z = pk2(s[4 * 33], s[5 * 33]); o.w = pk2(s[6 * 33], s[7 * 33]);
        *(u32x4*)(WT + (size_t)(dstrow0 + n) * 2048 + k0 + 8 * c) = o; }
    LDS_WAIT();
}

DI void p0_prologue(const Params& p, LAS unsigned char* lds) {
    const int tid = threadIdx.x, lane = tid & 63, wave = tid >> 6;
    const int gw = blockIdx.x * 8 + wave, NGW = gridDim.x * 8;
    bf16_t* WIN = (bf16_t*)(p.ws + WS_WIN); bf16_t* WP = (bf16_t*)(p.ws + WS_WP); bf16_t* WOUT = (bf16_t*)(p.ws + WS_WOUT); bf16_t* XN = (bf16_t*)(p.ws + WS_XN);
    LAS float* scr = (LAS float*)(lds + wave * 16384);
    constexpr int I_IN = 32 * (NW / 32), I_SQ = 32 * 64;
    for (int it = gw; it < I_IN + 3 * I_SQ; it += NGW) {
        int r = it;
        if (r < I_IN) { const int nb = r % (NW / 32), kb = r / (NW / 32); p0_transpose_item(p.win, 16912, win_src_col(nb * 32 + 4 * (lane & 7)), WIN, nb * 32, kb * 64, scr, lane); continue; }
        r -= I_IN; const int which = r / I_SQ; r -= which * I_SQ; const int nb = r % 64, kb = r / 64;
        const float* W = which == 0 ? p.wpa : (which == 1 ? p.wpm : p.wout);
        bf16_t* WT = which == 2 ? WOUT : WP; const int drow = (which == 1 ? 2048 : 0) + nb * 32;
        p0_transpose_item(W, 2048, nb * 32 + 4 * (lane & 7), WT, drow, kb * 64, scr, lane);
    }
    for (int m = gw; m < MPAD; m += NGW) {
        u32x2* o8 = (u32x2*)(XN + (size_t)m * DM) + lane;
        if (m >= MROWS) {
#pragma unroll
            for (int j = 0; j < 8; ++j) o8[64 * j] = (u32x2){0u, 0u};
            continue; }
        const float* xrow = m < ROW_S ? p.xp + (size_t)m * DM : (m < ROW_M ? p.xs + (size_t)(m - ROW_S) * DM : p.meta + (size_t)(m - ROW_M) * DM);
        const f32x4* xr = (const f32x4*)xrow + lane; const f32x4* gr = (const f32x4*)p.gnorm + lane;
        f32x4 v[8]; float s = 0.f;
#pragma unroll
        for (int j = 0; j < 8; ++j) { v[j] = xr[64 * j]; s += (v[j][0] * v[j][0] + v[j][1] * v[j][1]) + (v[j][2] * v[j][2] + v[j][3] * v[j][3]); }
        const float rstd = rsqrtf(wsum(s) * (1.f / DM) + EPS);
#pragma unroll
        for (int j = 0; j < 8; ++j) { const f32x4 g = gr[64 * j]; u32x2 w; w.x = pk2(v[j][0] * rstd * g[0], v[j][1] * rstd * g[1]); w.y = pk2(v[j][2] * rstd * g[2], v[j][3] * rstd * g[3]); o8[64 * j] = w; }
    }
    const int gt = blockIdx.x * 512 + tid, NGT = gridDim.x * 512;
    for (int i = gt; i < 2 * 16 * 112 * 64; i += NGT) {
        const int kv = i / (16 * 112 * 64); int r = i - kv * (16 * 112 * 64); const int b = r / (112 * 64); r -= b * (112 * 64);
        const f32x4* src = (const f32x4*)((kv ? p.cv : p.ck) + (size_t)(b * 128 + 16) * 256) + r;
        f32x4* dst = (f32x4*)(p.out + (kv ? O_VS : O_KS) + (size_t)(b * 128) * 256) + r;
        *dst = *src;
    }
}

DI u32x4 attn_fetch8(const Params& p, const bf16_t* U, int kind, int bidx, int g, int key, int ch, int colbase, const float* cache) {
    u32x4 z = (u32x4){0u, 0u, 0u, 0u};
    if (key < 16) return *(const u32x4*)(U + uoff(ROW_M + key, colbase + g * 64 + 8 * ch));
    if (kind == 0) {
        const int row = 64 * (bidx - 2) + (key - 16);
        if (key < 208 && row >= 0) return *(const u32x4*)(U + uoff(row, colbase + g * 64 + 8 * ch));
        return z;
    } else {
        if (key < 144) { const float* s = cache + ((size_t)(bidx * 128 + (key - 16)) * 4 + g) * 64 + 8 * ch; const f32x4 a = *(const f32x4*)s, b = *(const f32x4*)(s + 4);
            u32x4 w; w.x = pk2(a[0], a[1]); w.y = pk2(a[2], a[3]); w.z = pk2(b[0], b[1]); w.w = pk2(b[2], b[3]); return w; }
        if (key < 160) return *(const u32x4*)(U + uoff(ROW_S + 16 * bidx + (key - 144), colbase + g * 64 + 8 * ch));
        return z;
    }
}
DI void attn_item(const Params& p, LAS unsigned char* lds, int kind, int bidx, int g, int dry) {
    int tid_ = threadIdx.x; asm volatile("" : "+v"(tid_)); const int tid = tid_, lane = tid & 63, wave = tid >> 6, lr = lane & 15, q = lane >> 4;
    bf16_t* U = (bf16_t*)(p.ws + WS_U);
    LAS bf16_t* KAl = (LAS bf16_t*)lds; LAS bf16_t* VAl = (LAS bf16_t*)(lds + 32256);
    const int hq = 8 * g + wave; const float sink = p.sinks[hq] * 1.4426950408889634f;
    const int npair = kind == 0 ? 2 : 1, qrow0 = kind == 0 ? 64 * bidx : ROW_S + 16 * bidx;
    const int hi_t = kind == 0 ? 13 : 10; const int lo_t = kind == 0 ? 1 + (bidx < 2 ? 4 * (2 - bidx) : 0) : 1;
    u32x4 kreg[4], vreg[4];
#pragma unroll
    for (int i = 0; i < 4; ++i) { const int ci = tid + 512 * i; kreg[i] = (u32x4){0u, 0u, 0u, 0u}; vreg[i] = kreg[i];
        if (ci < 224 * 8) { kreg[i] = attn_fetch8(p, U, kind, bidx, g, ci >> 3, ci & 7, KA, p.ck); vreg[i] = attn_fetch8(p, U, kind, bidx, g, ci >> 3, ci & 7, VA, p.cv); } }
#pragma unroll
    for (int i = 0; i < 4; ++i) { const int ci = tid + 512 * i; if (ci < 224 * 8) { *(LAS u32x4*)(KAl + (ci >> 3) * 72 + 8 * (ci & 7)) = kreg[i]; *(LAS u32x4*)(VAl + (ci >> 3) * 72 + 8 * (ci & 7)) = vreg[i]; } }
    __syncthreads();
    for (int pr = 0; pr < npair; ++pr) {
        const int tA = 2 * pr, tB = kind == 0 ? 2 * pr + 1 : 0;
        const size_t rowA = (size_t)(qrow0 + 16 * tA + lr) * 256 + (size_t)(hq >> 2) * UT + (hq & 3) * 64, rowB = (size_t)(qrow0 + 16 * tB + lr) * 256 + (size_t)(hq >> 2) * UT + (hq & 3) * 64;
        constexpr size_t ZOFF = (size_t)(ZA >> 8) * UT;
        bf16x8 qa[2], qb[2]; u32x2 za[4], zb[4];
#pragma unroll
        for (int ks = 0; ks < 2; ++ks) { qa[ks] = *(const bf16x8*)(U + rowA + 32 * ks + 8 * q); qb[ks] = *(const bf16x8*)(U + rowB + 32 * ks + 8 * q); }
#pragma unroll
        for (int dt = 0; dt < 4; ++dt) { za[dt] = *(const u32x2*)(U + rowA + ZOFF + 16 * dt + 4 * q); zb[dt] = *(const u32x2*)(U + rowB + ZOFF + 16 * dt + 4 * q); }
        f32x4 accA[14], accB[14];
        float mxA = -1e30f, mxB = -1e30f;
#pragma unroll
        for (int kt = 0; kt < 14; ++kt) {
            if (kt == 0 || (kt >= lo_t && kt < hi_t)) {
                accA[kt] = (f32x4){0.f, 0.f, 0.f, 0.f}; accB[kt] = accA[kt];
#pragma unroll
                for (int ks = 0; ks < 2; ++ks) { const bf16x8 a = *(const LAS bf16x8*)(KAl + (16 * kt + lr) * 72 + 32 * ks + 8 * q); accA[kt] = MFMA16(a, qa[ks], accA[kt]); accB[kt] = MFMA16(a, qb[ks], accB[kt]); }
                mxA = fmaxf(mxA, fmaxf(fmaxf(accA[kt][0], accA[kt][1]), fmaxf(accA[kt][2], accA[kt][3])));
                mxB = fmaxf(mxB, fmaxf(fmaxf(accB[kt][0], accB[kt][1]), fmaxf(accB[kt][2], accB[kt][3])));
            } else { accA[kt] = (f32x4){-1e30f, -1e30f, -1e30f, -1e30f}; accB[kt] = accA[kt]; }
        }
        mxA = fmaxf(mxA, __shfl_xor(mxA, 16)); mxA = fmaxf(mxA, __shfl_xor(mxA, 32)); mxB = fmaxf(mxB, __shfl_xor(mxB, 16)); mxB = fmaxf(mxB, __shfl_xor(mxB, 32));
        const float MA = fmaxf(mxA, sink), MB = fmaxf(mxB, sink); float sumA = 0.f, sumB = 0.f;
#pragma unroll
        for (int kt = 0; kt < 14; ++kt)
#pragma unroll
            for (int j = 0; j < 4; ++j) { const float ea = __builtin_amdgcn_exp2f(accA[kt][j] - MA), eb = __builtin_amdgcn_exp2f(accB[kt][j] - MB); accA[kt][j] = ea; accB[kt][j] = eb; sumA += ea; sumB += eb; }
        sumA += __shfl_xor(sumA, 16); sumA += __shfl_xor(sumA, 32); sumB += __shfl_xor(sumB, 16); sumB += __shfl_xor(sumB, 32);
        const float invA = 1.0f / (sumA + __builtin_amdgcn_exp2f(sink - MA)), invB = 1.0f / (sumB + __builtin_amdgcn_exp2f(sink - MB));
        bf16x8 pA[7], pB[7];
#pragma unroll
        for (int u = 0; u < 7; ++u) { u32x4 w; w.x = pk2(accA[2 * u][0], accA[2 * u][1]); w.y = pk2(accA[2 * u][2], accA[2 * u][3]);
            w.z = pk2(accA[2 * u + 1][0], accA[2 * u + 1][1]); w.w = pk2(accA[2 * u + 1][2], accA[2 * u + 1][3]); pA[u] = __builtin_bit_cast(bf16x8, w);
            w.x = pk2(accB[2 * u][0], accB[2 * u][1]); w.y = pk2(accB[2 * u][2], accB[2 * u][3]);
            w.z = pk2(accB[2 * u + 1][0], accB[2 * u + 1][1]); w.w = pk2(accB[2 * u + 1][2], accB[2 * u + 1][3]); pB[u] = __builtin_bit_cast(bf16x8, w); }
        f32x4 oA[4], oB[4];
#pragma unroll
        for (int dt = 0; dt < 4; ++dt) { oA[dt] = (f32x4){0.f, 0.f, 0.f, 0.f}; oB[dt] = oA[dt];
#pragma unroll
            for (int u = 0; u < 7; ++u) { const LAS bf16_t* vp = VAl + (32 * u + 4 * q + (lr >> 2)) * 72 + 16 * dt + 4 * (lr & 3);
                const s16x4 lo = tr_read(vp), hi = tr_read(vp + 16 * 72);
                const bf16x8 a = __builtin_shufflevector(lo, hi, 0, 1, 2, 3, 4, 5, 6, 7); oA[dt] = MFMA16(a, pA[u], oA[dt]); oB[dt] = MFMA16(a, pB[u], oB[dt]); } }
#pragma unroll
        for (int dt = 0; dt < 4; ++dt) { const int col = hq * 64 + 16 * dt + 4 * q;
            { const u32x2 z = za[dt]; u32x2 w; w.x = pk2(oA[dt][0] * invA * siluf_(bflo(z.x)), oA[dt][1] * invA * siluf_(bfhi(z.x))); w.y = pk2(oA[dt][2] * invA * siluf_(bflo(z.y)), oA[dt][3] * invA * siluf_(bfhi(z.y)));
              if (dry) *(u32x2*)((bf16_t*)(p.ws + WS_XN) + (size_t)(qrow0 + 16 * tA + lr) * DM + col) = w; else *(u32x2*)(U + rowA + 16 * dt + 4 * q) = w; }
            if (kind == 0) { const u32x2 z = zb[dt]; u32x2 w; w.x = pk2(oB[dt][0] * invB * siluf_(bflo(z.x)), oB[dt][1] * invB * siluf_(bfhi(z.x))); w.y = pk2(oB[dt][2] * invB * siluf_(bflo(z.y)), oB[dt][3] * invB * siluf_(bfhi(z.y)));
              if (dry) *(u32x2*)((bf16_t*)(p.ws + WS_XN) + (size_t)(qrow0 + 16 * tB + lr) * DM + col) = w; else *(u32x2*)(U + rowB + 16 * dt + 4 * q) = w; } }
    }
    __syncthreads();
}

constexpr int ML_T2 = 69632, ML_SC = 106496;
constexpr int PV = 272, PKS = 144;
DI void mlstm_v_load(const bf16_t* U, int R0, int h, int tid, u32x4 (&v)[8]) {
#pragma unroll
    for (int it = 0; it < 8; ++it) { const int ci = tid + 512 * it, row = ci >> 5, ch = ci & 31; v[it] = *(const u32x4*)(U + uoff(R0 + row, VM + h * 256 + 8 * ch)); }
}
DI void mlstm_v_store(LAS unsigned char* lds, int tid, const u32x4 (&v)[8]) {
    LAS bf16_t* Vl = (LAS bf16_t*)lds;
#pragma unroll
    for (int it = 0; it < 8; ++it) { const int ci = tid + 512 * it, row = ci >> 5, ch = ci & 31; *(LAS u32x4*)(Vl + row * PV + 8 * ch) = v[it]; }
}

DI void mlstm_sum_item(const Params& p, LAS unsigned char* lds, int h, int j) {
    int tid_ = threadIdx.x; asm volatile("" : "+v"(tid_)); const int tid = tid_, lane = tid & 63, wave = tid >> 6, lr = lane & 15, q = lane >> 4;
    const bf16_t* U = (const bf16_t*)(p.ws + WS_U); const float* GATE = (const float*)(p.ws + WS_GATE);
    LAS float* wS = (LAS float*)(lds + ML_SC);
    const int R0 = 128 * j;
    u32x4 vreg[8], kreg[4];
    mlstm_v_load(U, R0, h, tid, vreg);
#pragma unroll
    for (int it = 0; it < 4; ++it) { const int ci = tid + 512 * it, row = ci >> 4, ch = ci & 15; kreg[it] = *(const u32x4*)(U + uoff(R0 + row, KM + h * 128 + 8 * ch)); }
    if (wave == 0) {
        const float bi = p.bi[h], bfb = p.bf[h];
        const float gi0 = GATE[(size_t)(R0 + lane) * 16 + h] + bi, gi1 = GATE[(size_t)(R0 + 64 + lane) * 16 + h] + bi;
        const float lf0 = logsigmoidf_(GATE[(size_t)(R0 + lane) * 16 + 8 + h] + bfb), lf1 = logsigmoidf_(GATE[(size_t)(R0 + 64 + lane) * 16 + 8 + h] + bfb);
        const float c0 = scan_add(lf0, lane); const float tot0 = __shfl(c0, 63); const float c1 = scan_add(lf1, lane) + tot0; const float blast = __shfl(c1, 63);
        const float x0 = blast - c0 + gi0, x1 = blast - c1 + gi1; const float ml = wmax(fmaxf(x0, x1));
        wS[lane] = __expf(x0 - ml); wS[64 + lane] = __expf(x1 - ml);
        if (lane == 0) { ((float*)(p.ws + WS_BS))[h * NCH + j] = blast; ((float*)(p.ws + WS_ML))[h * NCH + j] = ml; }
    }
    mlstm_v_store(lds, tid, vreg);
    __syncthreads();
    {
        LAS bf16_t* Kl = (LAS bf16_t*)(lds + ML_T2);
#pragma unroll
        for (int it = 0; it < 4; ++it) { const int ci = tid + 512 * it, row = ci >> 4, ch = ci & 15; const u32x4 a = kreg[it]; const float w = wS[row];
            u32x4 o; o.x = pk2(bflo(a.x) * w, bfhi(a.x) * w); o.y = pk2(bflo(a.y) * w, bfhi(a.y) * w); o.z = pk2(bflo(a.z) * w, bfhi(a.z) * w); o.w = pk2(bflo(a.w) * w, bfhi(a.w) * w);
            *(LAS u32x4*)(Kl + row * PKS + 8 * ch) = o; }
    }
    __syncthreads();
    const LAS bf16_t* Vl = (const LAS bf16_t*)lds; const LAS bf16_t* Kl = (const LAS bf16_t*)(lds + ML_T2);
    {
        LAS float* npart = (LAS float*)(lds + ML_SC + 512);
        const int d = tid & 127, part = tid >> 7; float sm = 0.f;
#pragma unroll 8
        for (int r = 0; r < 32; ++r) sm += bf2f(Kl[(32 * part + r) * PKS + d]);
        npart[part * 128 + d] = sm;
    }
    f32x4 acc[2][8];
#pragma unroll
    for (int i = 0; i < 2; ++i)
#pragma unroll
        for (int dt = 0; dt < 8; ++dt) acc[i][dt] = (f32x4){0.f, 0.f, 0.f, 0.f};
#pragma unroll
    for (int ks = 0; ks < 4; ++ks) {
        bf16x8 a[2];
#pragma unroll
        for (int i = 0; i < 2; ++i) { const LAS bf16_t* vp = Vl + (32 * ks + 8 * q + (lr >> 2)) * PV + 16 * (2 * wave + i) + 4 * (lr & 3);
            const s16x4 lo = tr_read(vp), hi = tr_read(vp + 4 * PV); a[i] = __builtin_shufflevector(lo, hi, 0, 1, 2, 3, 4, 5, 6, 7); }
#pragma unroll
        for (int dt = 0; dt < 8; ++dt) { const LAS bf16_t* kp = Kl + (32 * ks + 8 * q + (lr >> 2)) * PKS + 16 * dt + 4 * (lr & 3);
            const s16x4 lo = tr_read(kp), hi = tr_read(kp + 4 * PKS); const bf16x8 b = __builtin_shufflevector(lo, hi, 0, 1, 2, 3, 4, 5, 6, 7);
#pragma unroll
            for (int i = 0; i < 2; ++i) acc[i][dt] = MFMA16(b, a[i], acc[i][dt]); }
    }
    bf16_t* UP = (bf16_t*)(p.ws + WS_UP) + (size_t)(h * NCH + j) * 256 * 128;
#pragma unroll
    for (int i = 0; i < 2; ++i)
#pragma unroll
        for (int dt = 0; dt < 8; ++dt) { u32x2 w; w.x = f2bf_c(acc[i][dt][0]) | (f2bf_c(acc[i][dt][1]) << 16); w.y = f2bf_c(acc[i][dt][2]) | (f2bf_c(acc[i][dt][3]) << 16);
            *(u32x2*)(UP + (size_t)(16 * (2 * wave + i) + lr) * 128 + 16 * dt + 4 * q) = w; }
    __syncthreads();
    if (tid < 128) { const LAS float* npart = (const LAS float*)(lds + ML_SC + 512);
        ((float*)(p.ws + WS_NP))[(size_t)(h * NCH + j) * 128 + tid] = (npart[tid] + npart[128 + tid]) + (npart[256 + tid] + npart[384 + tid]); }
    __syncthreads();
}

DI void mlstm_small_item(const Params& p, LAS unsigned char* lds, int b, int h, int dry) {
    int tid_ = threadIdx.x; asm volatile("" : "+v"(tid_)); const int tid = tid_, lane = tid & 63, wave = tid >> 6;
    bf16_t* U = (bf16_t*)(p.ws + WS_U); const float* GATE = (const float*)(p.ws + WS_GATE);
    const bool meta = (b == 16); const int R0 = meta ? ROW_M : ROW_S + 16 * b;
    LAS float* qT = (LAS float*)lds; LAS float* kwT = (LAS float*)(lds + 8192); LAS float* kS = (LAS float*)(lds + 16384);
    LAS float* Wm = (LAS float*)(lds + 24832); LAS float* sc = (LAS float*)(lds + 25856); LAS float* red = (LAS float*)(lds + 26624);
    LAS float* am = sc, *cm = sc + 16, *bb = sc + 32, *wsS = sc + 48, *misc = sc + 64, *qnS = sc + 80;
    const float* Cin = p.sC + (size_t)(b * 8 + h) * 128 * 256; const float* nin = p.sn + (size_t)(b * 8 + h) * 128;
    float* Cout = meta ? (float*)(p.ws + WS_C0) + (size_t)h * 128 * 256 : p.out + O_CS + (size_t)(b * 8 + h) * 128 * 256;
    float* nout = meta ? (float*)(p.ws + WS_N0) + h * 128 : p.out + O_NS + (size_t)(b * 8 + h) * 128;
#pragma unroll
    for (int i = 0; i < 4; ++i) { const int idx = tid + 512 * i, t = idx >> 7, d = idx & 127;
        qT[d * 16 + t] = bf2f(U[uoff(R0 + t, QM + h * 128 + d)]); kS[t * 132 + d] = bf2f(U[uoff(R0 + t, KM + h * 128 + d)]); }
    if (wave == 0) {
        const bool act = lane < 16; const int tl = act ? lane : 15;
        const float gi = GATE[(size_t)(R0 + tl) * 16 + h] + p.bi[h];
        const float lf = act ? logsigmoidf_(GATE[(size_t)(R0 + tl) * 16 + 8 + h] + p.bf[h]) : 0.f;
        const float c = scan_add(lf, lane); const float a = act ? gi - c : -3e38f; const float pm = scan_max(a, lane);
        const float mprev = meta ? 0.f : p.sm[b * 8 + h]; const float cmv = fmaxf(mprev, pm);
        const float b15 = __shfl(c, 15), cm15 = __shfl(cmv, 15); const float mnew = b15 + cm15;
        if (act) { am[lane] = a; cm[lane] = cmv; bb[lane] = c; wsS[lane] = __expf(b15 + a - mnew); }
        if (lane == 0) { misc[0] = __expf(b15 + mprev - mnew); misc[1] = mnew; misc[2] = mprev;
            if (meta) ((float*)(p.ws + WS_M0))[h] = mnew; else p.out[O_MS + b * 8 + h] = mnew; }
    }
    __syncthreads();
#pragma unroll
    for (int i = 0; i < 4; ++i) { const int idx = tid + 512 * i, s = idx >> 7, d = idx & 127; kwT[d * 16 + s] = kS[s * 132 + d] * wsS[s]; }
    if (tid < 256) { const int t = tid >> 4, s = tid & 15; float dot = 0.f;
        for (int d = 0; d < 128; ++d) dot += qT[d * 16 + t] * kS[s * 132 + d];
        Wm[t * 16 + s] = (s <= t) ? dot * __expf(am[s] - cm[t]) : 0.f;
    } else if (tid < 272) { const int t = tid - 256; float dot = 0.f;
        if (!meta) for (int d = 0; d < 128; ++d) dot += qT[d * 16 + t] * nin[d];
        qnS[t] = dot; }
    __syncthreads();
    const int e0 = tid & 127, dq = tid >> 7;
    float v0[16], v1[16];
#pragma unroll
    for (int s = 0; s < 16; ++s) { v0[s] = bf2f(U[uoff(R0 + s, VM + h * 256 + e0)]); v1[s] = bf2f(U[uoff(R0 + s, VM + h * 256 + e0 + 128)]); }
    float acc0[16], acc1[16];
#pragma unroll
    for (int t = 0; t < 16; ++t) { acc0[t] = 0.f; acc1[t] = 0.f; }
    const float alast = misc[0], mprev = misc[2];
    for (int d0 = dq * 32; d0 < dq * 32 + 32; d0 += 16) {
        float cb0[16], cb1[16];
#pragma unroll
        for (int dd = 0; dd < 16; ++dd) { cb0[dd] = meta ? 0.f : Cin[(size_t)(d0 + dd) * 256 + e0]; cb1[dd] = meta ? 0.f : Cin[(size_t)(d0 + dd) * 256 + e0 + 128]; }
#pragma unroll
        for (int dd = 0; dd < 16; ++dd) { const int d = d0 + dd; const float c0 = cb0[dd], c1 = cb1[dd];
            float cn0 = alast * c0, cn1 = alast * c1;
#pragma unroll
            for (int i = 0; i < 4; ++i) { const f32x4 q4 = *(const LAS f32x4*)(qT + d * 16 + 4 * i), k4 = *(const LAS f32x4*)(kwT + d * 16 + 4 * i);
#pragma unroll
                for (int jj = 0; jj < 4; ++jj) { acc0[4 * i + jj] += q4[jj] * c0; acc1[4 * i + jj] += q4[jj] * c1; cn0 += k4[jj] * v0[4 * i + jj]; cn1 += k4[jj] * v1[4 * i + jj]; } }
            Cout[(size_t)d * 256 + e0] = cn0; Cout[(size_t)d * 256 + e0 + 128] = cn1; }
    }
#pragma unroll
    for (int t = 0; t < 16; ++t) { red[(dq * 16 + t) * 256 + e0] = acc0[t]; red[(dq * 16 + t) * 256 + e0 + 128] = acc1[t]; }
    if (tid < 128) { float nn = alast * (meta ? 0.f : nin[tid]);
#pragma unroll
        for (int s = 0; s < 16; ++s) nn += kwT[tid * 16 + s];
        nout[tid] = nn; }
    __syncthreads();
    if (!meta) {
#pragma unroll
        for (int tl = 0; tl < 4; ++tl) { const int t = dq * 4 + tl; const float sc_t = __expf(mprev - cm[t]); const float mt = bb[t] + cm[t];
            float den = sc_t * qnS[t];
            float num0 = sc_t * ((red[t * 256 + e0] + red[(16 + t) * 256 + e0]) + (red[(32 + t) * 256 + e0] + red[(48 + t) * 256 + e0]));
            float num1 = sc_t * ((red[t * 256 + e0 + 128] + red[(16 + t) * 256 + e0 + 128]) + (red[(32 + t) * 256 + e0 + 128] + red[(48 + t) * 256 + e0 + 128]));
#pragma unroll
            for (int s = 0; s < 16; ++s) { const float w = Wm[t * 16 + s]; num0 += w * v0[s]; num1 += w * v1[s]; den += w; }
            const float inv = 1.0f / fmaxf(fabsf(den), __expf(-mt));
            red[t * 256 + e0] = num0 * inv; red[t * 256 + e0 + 128] = num1 * inv; }
    }
    __syncthreads();
    if (!meta) {
#pragma unroll
        for (int r = 0; r < 2; ++r) { const int t = 2 * wave + r; float hv[4]; float ss = 0.f;
#pragma unroll
            for (int i = 0; i < 4; ++i) { hv[i] = red[t * 256 + lane + 64 * i]; ss += hv[i] * hv[i]; }
            const float rstd = rsqrtf(wsum(ss) * (1.f / 256.f) + EPS);
            float ov[4], zv[4], gv[4];
#pragma unroll
            for (int i = 0; i < 4; ++i) { const int ee = lane + 64 * i; const size_t ro = (size_t)(R0 + t) * 256 + (size_t)h * UT + ee;
                ov[i] = bf2f(U[ro + (size_t)(OM >> 8) * UT]); zv[i] = bf2f(U[ro + (size_t)(ZM >> 8) * UT]); gv[i] = p.gmh[h * 256 + ee]; }
#pragma unroll
            for (int i = 0; i < 4; ++i) { const int ee = lane + 64 * i; const size_t ro = (size_t)(R0 + t) * 256 + (size_t)h * UT + ee;
                const float val = hv[i] * rstd * gv[i] * sigmoidf_(ov[i]) * siluf_(zv[i]);
                if (!dry) U[ro + (size_t)(OM >> 8) * UT] = (bf16_t)(pk2(val, 0.f) & 0xffffu); } }
    }
    __syncthreads();
}

DI void mlstm_scan(const Params& p, LAS unsigned char* lds) {
    const float* BS = (const float*)(p.ws + WS_BS); const float* MLv = (const float*)(p.ws + WS_ML); float* MS = (float*)(p.ws + WS_MS);
    const float* NPv = (const float*)(p.ws + WS_NP); float* NS = (float*)(p.ws + WS_NS);
    const float* C0 = (const float*)(p.ws + WS_C0); const float* N0 = (const float*)(p.ws + WS_N0); const float* M0 = (const float*)(p.ws + WS_M0);
    LAS float* tb = (LAS float*)lds, *tm = tb + 64, *ca = tb + 128, *cb = tb + 192, *cm = tb + 256;
    const int tid = threadIdx.x;
    for (int gid0 = blockIdx.x * 512; gid0 < 8 * 256 * 64; gid0 += gridDim.x * 512) {
        const int gid = gid0 + tid, h = gid0 >> 14, e = (gid >> 6) & 255, d = 2 * (gid & 63);
        const bf16_t* UP = (const bf16_t*)(p.ws + WS_UP) + (size_t)h * NCH * 256 * 128 + (size_t)e * 128 + d;
        unsigned u[64];
#pragma unroll
        for (int i = 0; i < 64; ++i) u[i] = *(const unsigned*)(UP + (size_t)i * 256 * 128);
        float cx = C0[((size_t)h * 128 + d) * 256 + e], cy = C0[((size_t)h * 128 + d + 1) * 256 + e];
        __syncthreads();
        if (tid < 64) { tb[tid] = BS[h * NCH + tid]; tm[tid] = MLv[h * NCH + tid]; }
        __syncthreads();
        if (tid == 0) { float m = M0[h];
            for (int k = 0; k < NCH; ++k) { const float bs = tb[k], ml = tm[k]; const float mn = fmaxf(bs + m, ml); ca[k] = __expf(bs + m - mn); cb[k] = __expf(ml - mn); cm[k] = m; m = mn; }
            cm[64] = m; }
        __syncthreads();
        unsigned* CS = (unsigned*)((bf16_t*)(p.ws + WS_CST) + (size_t)h * NCH * 256 * 128 + (size_t)e * 128 + d);
#pragma unroll
        for (int k = 0; k < NCH; ++k) { CS[(size_t)k * 256 * 64] = pk2(cx, cy); const float a = ca[k], b = cb[k]; cx = a * cx + b * bflo(u[k]); cy = a * cy + b * bfhi(u[k]); }
        p.out[O_CP + ((size_t)h * 128 + d) * 256 + e] = cx; p.out[O_CP + ((size_t)h * 128 + d + 1) * 256 + e] = cy;
        if ((gid0 & 16383) == 0) {
            if (tid < 128) { float nv[64];
#pragma unroll
                for (int k = 0; k < 64; ++k) nv[k] = NPv[(size_t)(h * NCH + k) * 128 + tid];
                float n = N0[h * 128 + tid];
#pragma unroll
                for (int k = 0; k < 64; ++k) { NS[(size_t)(h * NCH + k) * 128 + tid] = n; n = ca[k] * n + cb[k] * nv[k]; }
                p.out[O_NP + h * 128 + tid] = n; }
            else if (tid < 192) { MS[h * NCH + (tid - 128)] = cm[tid - 128]; if (tid == 128) p.out[O_MP + h] = cm[64]; }
        }
    }
    __syncthreads();
}

DI void mlstm_sw_tile(const LAS bf16_t* KN, const LAS float* aS, const bf16x8 (&qf)[4], int tT, int t, float cmt, int lr, int q, bf16x8 (&wf)[4], float& dsum) {
    dsum = 0.f;
#pragma unroll
    for (int u = 0; u < 4; ++u) {
        u32x4 w = (u32x4){0u, 0u, 0u, 0u};
#pragma unroll
        for (int hh = 0; hh < 2; ++hh) { const int st = 2 * u + hh;
            if (st <= tT) {
                f32x4 s4 = (f32x4){0.f, 0.f, 0.f, 0.f};
#pragma unroll
                for (int ks = 0; ks < 4; ++ks) { const bf16x8 a = *(const LAS bf16x8*)(KN + (16 * st + lr) * 136 + 32 * ks + 8 * q); s4 = MFMA16(a, qf[ks], s4); }
                float wv[4];
#pragma unroll
                for (int jj = 0; jj < 4; ++jj) { const int sx = 16 * st + 4 * q + jj; const float wg = (sx <= t) ? __expf(aS[sx] - cmt) : 0.f; wv[jj] = s4[jj] * wg; dsum += wv[jj]; }
                if (hh == 0) { w.x = pk2(wv[0], wv[1]); w.y = pk2(wv[2], wv[3]); } else { w.z = pk2(wv[0], wv[1]); w.w = pk2(wv[2], wv[3]); }
            } }
        wf[u] = __builtin_bit_cast(bf16x8, w);
    }
}
DI void mlstm_out_item(const Params& p, LAS unsigned char* lds, int h, int j, int dry) {
    int tid_ = threadIdx.x; asm volatile("" : "+v"(tid_)); const int tid = tid_, lane = tid & 63, wave = __builtin_amdgcn_readfirstlane(tid >> 6), lr = lane & 15, q = lane >> 4;
    const int g = wave >> 2, w = wave & 3, tA = w, tB = 7 - w;
    bf16_t* U = (bf16_t*)(p.ws + WS_U); const float* GATE = (const float*)(p.ws + WS_GATE);
    LAS float* aS = (LAS float*)(lds + ML_SC), *cmS = aS + 128, *bS = aS + 256, *nK = aS + 384, *ssx = aS + 512;
    const int R0 = 128 * j; const float mk = ((const float*)(p.ws + WS_MS))[h * NCH + j];
    u32x4 vreg[8], kn[4];
    mlstm_v_load(U, R0, h, tid, vreg);
#pragma unroll
    for (int it = 0; it < 4; ++it) { const int ci = tid + 512 * it, row = ci >> 4, ch = ci & 15; kn[it] = *(const u32x4*)(U + uoff(R0 + row, KM + h * 128 + 8 * ch)); }
    const int tokA = 16 * tA + lr, tokB = 16 * tB + lr;
    const size_t rowA = (size_t)(R0 + tokA) * 256, rowB = (size_t)(R0 + tokB) * 256;
    const size_t qoff = (size_t)((QM >> 8) + (h >> 1)) * UT + (h & 1) * 128 + 8 * q;
    bf16x8 qfA[4], qfB[4];
#pragma unroll
    for (int ks = 0; ks < 4; ++ks) { qfA[ks] = *(const bf16x8*)(U + rowA + qoff + 32 * ks); qfB[ks] = *(const bf16x8*)(U + rowB + qoff + 32 * ks); }
    if (wave == 0) {
        const float bi = p.bi[h], bfb = p.bf[h];
        const float gi0 = GATE[(size_t)(R0 + lane) * 16 + h] + bi, gi1 = GATE[(size_t)(R0 + 64 + lane) * 16 + h] + bi;
        const float lf0 = logsigmoidf_(GATE[(size_t)(R0 + lane) * 16 + 8 + h] + bfb), lf1 = logsigmoidf_(GATE[(size_t)(R0 + 64 + lane) * 16 + 8 + h] + bfb);
        const float c0 = scan_add(lf0, lane); const float tot0 = __shfl(c0, 63); const float c1 = scan_add(lf1, lane) + tot0;
        const float a0 = gi0 - c0, a1 = gi1 - c1;
        const float p0 = scan_max(a0, lane); const float t0 = __shfl(p0, 63); const float p1 = fmaxf(scan_max(a1, lane), t0);
        aS[lane] = a0; aS[64 + lane] = a1; cmS[lane] = fmaxf(mk, p0); cmS[64 + lane] = fmaxf(mk, p1); bS[lane] = c0; bS[64 + lane] = c1;
    } else if (wave < 3) { const int d = tid - 64; nK[d] = ((const float*)(p.ws + WS_NS))[(size_t)(h * NCH + j) * 128 + d]; }
    mlstm_v_store(lds, tid, vreg);
    {
        LAS bf16_t* KNw = (LAS bf16_t*)(lds + ML_T2);
#pragma unroll
        for (int it = 0; it < 4; ++it) { const int ci = tid + 512 * it, row = ci >> 4, ch = ci & 15; *(LAS u32x4*)(KNw + row * 136 + 8 * ch) = kn[it]; }
    }
    __syncthreads();
    const LAS bf16_t* VT = (const LAS bf16_t*)lds; const LAS bf16_t* KN = (const LAS bf16_t*)(lds + ML_T2);
    const float cmA = cmS[tokA], cmB = cmS[tokB];
    const float scaleA = __expf(mk - cmA), scaleB = __expf(mk - cmB), floA = __expf(-(bS[tokA] + cmA)), floB = __expf(-(bS[tokB] + cmB));
    float qnA = 0.f, qnB = 0.f;
#pragma unroll
    for (int ks = 0; ks < 4; ++ks)
#pragma unroll
        for (int i = 0; i < 8; ++i) { const float nv = nK[32 * ks + 8 * q + i]; qnA += bf2f((unsigned short)qfA[ks][i]) * nv; qnB += bf2f((unsigned short)qfB[ks][i]) * nv; }
    qnA += __shfl_xor(qnA, 16); qnA += __shfl_xor(qnA, 32); qnB += __shfl_xor(qnB, 16); qnB += __shfl_xor(qnB, 32);
    f32x4 accA[8], accB[8];
    const bf16_t* CS = (const bf16_t*)(p.ws + WS_CST) + (size_t)(h * NCH + j) * 256 * 128 + (size_t)(128 * g) * 128;
#pragma unroll
    for (int et = 0; et < 8; ++et) { accA[et] = (f32x4){0.f, 0.f, 0.f, 0.f}; accB[et] = accA[et]; }
#pragma unroll
    for (int ks = 0; ks < 4; ++ks) {
        bf16x8 ca[8];
#pragma unroll
        for (int et = 0; et < 8; ++et) ca[et] = *(const bf16x8*)(CS + (size_t)(16 * et + lr) * 128 + 32 * ks + 8 * q);
#pragma unroll
        for (int et = 0; et < 8; ++et) { accA[et] = MFMA16(ca[et], qfA[ks], accA[et]); accB[et] = MFMA16(ca[et], qfB[ks], accB[et]); }
    }
#pragma unroll
    for (int et = 0; et < 8; ++et) { accA[et] = accA[et] * scaleA; accB[et] = accB[et] * scaleB; }
    asm volatile("" ::: "memory");
    bf16x8 wfA[4], wfB[4]; float dsA, dsB;
    mlstm_sw_tile(KN, aS, qfA, tA, tokA, cmA, lr, q, wfA, dsA);
    mlstm_sw_tile(KN, aS, qfB, tB, tokB, cmB, lr, q, wfB, dsB);
#pragma unroll
    for (int u = 0; u < 4; ++u) {
        if (2 * u <= tB) {
#pragma unroll
            for (int et = 0; et < 8; ++et) { const LAS bf16_t* vp = VT + (32 * u + 4 * q + (lr >> 2)) * PV + 16 * (8 * g + et) + 4 * (lr & 3);
                const s16x4 lo = tr_read(vp), hi = tr_read(vp + 16 * PV); const bf16x8 vf = __builtin_shufflevector(lo, hi, 0, 1, 2, 3, 4, 5, 6, 7);
                accB[et] = MFMA16(vf, wfB[u], accB[et]);
                if (2 * u <= tA) accA[et] = MFMA16(vf, wfA[u], accA[et]); } }
    }
    asm volatile("" ::: "memory");
    dsA += __shfl_xor(dsA, 16); dsA += __shfl_xor(dsA, 32); dsB += __shfl_xor(dsB, 16); dsB += __shfl_xor(dsB, 32);
    const float invA = 1.0f / fmaxf(fabsf(scaleA * qnA + dsA), floA), invB = 1.0f / fmaxf(fabsf(scaleB * qnB + dsB), floB);
    float ssA = 0.f, ssB = 0.f;
#pragma unroll
    for (int et = 0; et < 8; ++et) { accA[et] = accA[et] * invA; accB[et] = accB[et] * invB;
        ssA += (accA[et][0] * accA[et][0] + accA[et][1] * accA[et][1]) + (accA[et][2] * accA[et][2] + accA[et][3] * accA[et][3]);
        ssB += (accB[et][0] * accB[et][0] + accB[et][1] * accB[et][1]) + (accB[et][2] * accB[et][2] + accB[et][3] * accB[et][3]); }
    ssA += __shfl_xor(ssA, 16); ssA += __shfl_xor(ssA, 32); ssB += __shfl_xor(ssB, 16); ssB += __shfl_xor(ssB, 32);
    if (q == 0) { ssx[((g * 4 + w) * 2 + 0) * 16 + lr] = ssA; ssx[((g * 4 + w) * 2 + 1) * 16 + lr] = ssB; }
    __syncthreads();
    const float rstdA = rsqrtf((ssA + ssx[(((g ^ 1) * 4 + w) * 2 + 0) * 16 + lr]) * (1.f / 256.f) + EPS);
    const float rstdB = rsqrtf((ssB + ssx[(((g ^ 1) * 4 + w) * 2 + 1) * 16 + lr]) * (1.f / 256.f) + EPS);
    const size_t ooff = (size_t)((OM >> 8) + h) * UT + 128 * g + 4 * q, zoff = (size_t)((ZM >> 8) + h) * UT + 128 * g + 4 * q;
#pragma unroll
    for (int T = 0; T < 2; ++T) {
        const size_t rowT = T ? rowB : rowA; const float rstd = T ? rstdB : rstdA; const int tok = T ? tokB : tokA;
        u32x2 ov[8], zv[8]; f32x4 gv[8];
#pragma unroll
        for (int et = 0; et < 8; ++et) { ov[et] = *(const u32x2*)(U + rowT + ooff + 16 * et); zv[et] = *(const u32x2*)(U + rowT + zoff + 16 * et); gv[et] = *(const f32x4*)(p.gmh + h * 256 + 128 * g + 16 * et + 4 * q); }
#pragma unroll
        for (int et = 0; et < 8; ++et) { const f32x4 a = T ? accB[et] : accA[et]; const u32x2 o = ov[et], z = zv[et]; const f32x4 gg = gv[et];
            u32x2 wv; wv.x = pk2(a[0] * rstd * gg[0] * sigmoidf_(bflo(o.x)) * siluf_(bflo(z.x)), a[1] * rstd * gg[1] * sigmoidf_(bfhi(o.x)) * siluf_(bfhi(z.x)));
            wv.y = pk2(a[2] * rstd * gg[2] * sigmoidf_(bflo(o.y)) * siluf_(bflo(z.y)), a[3] * rstd * gg[3] * sigmoidf_(bfhi(o.y)) * siluf_(bfhi(z.y)));
            if (dry) *(u32x2*)((bf16_t*)(p.ws + WS_XN) + (size_t)(R0 + tok) * DM + h * 256 + 128 * g + 16 * et + 4 * q) = wv; else *(u32x2*)(U + rowT + ooff + 16 * et) = wv; }
    }
    __syncthreads();
}

DI void skinny_core(f32x4 (&acc)[2][4], const bf16_t* A, size_t lda, size_t wstride, const bf16_t* Bt, int row0, int col0, int wave, int lr, int q) {
    const bf16_t* ap = A + (size_t)(row0 + lr) * lda + wstride * wave + 8 * q;
    const bf16_t* bp = Bt + (size_t)(col0 + lr) * 2048 + 256 * wave + 8 * q;
#pragma unroll 4
    for (int ks = 0; ks < 8; ++ks) {
        bf16x8 a[2], b[4];
#pragma unroll
        for (int rt = 0; rt < 2; ++rt) a[rt] = *(const bf16x8*)(ap + (size_t)rt * 16 * lda + 32 * ks);
#pragma unroll
        for (int ct = 0; ct < 4; ++ct) b[ct] = *(const bf16x8*)(bp + (size_t)ct * 16 * 2048 + 32 * ks);
#pragma unroll
        for (int rt = 0; rt < 2; ++rt)
#pragma unroll
            for (int ct = 0; ct < 4; ++ct) acc[rt][ct] = MFMA16(b[ct], a[rt], acc[rt][ct]);
    }
}
DI void skinny_put(LAS float* red, const f32x4 (&acc)[2][4], int slot, int lr, int q) {
#pragma unroll
    for (int rt = 0; rt < 2; ++rt)
#pragma unroll
        for (int ct = 0; ct < 4; ++ct) *(LAS f32x4*)(red + ((size_t)slot * 32 + 16 * rt + lr) * 64 + 16 * ct + 4 * q) = acc[rt][ct];
}
DI void skinny_merge(const Params& p, LAS unsigned char* lds) {
    const int tid = threadIdx.x, lane = tid & 63, wave = tid >> 6, lr = lane & 15, q = lane >> 4;
    const bf16_t* U = (const bf16_t*)(p.ws + WS_U); const bf16_t* WP = (const bf16_t*)(p.ws + WS_WP); bf16_t* MG = (bf16_t*)(p.ws + WS_XN);
    LAS float* red = (LAS float*)lds;
    for (int tile = blockIdx.x; tile < 256; tile += gridDim.x) {
        const int row0 = ROW_S + 32 * (tile >> 5), col0 = 64 * (tile & 31);
        f32x4 aa[2][4], am[2][4];
#pragma unroll
        for (int rt = 0; rt < 2; ++rt)
#pragma unroll
            for (int ct = 0; ct < 4; ++ct) { aa[rt][ct] = (f32x4){0.f, 0.f, 0.f, 0.f}; am[rt][ct] = (f32x4){0.f, 0.f, 0.f, 0.f}; }
        skinny_core(aa, U + (size_t)(QA >> 8) * UT, 256, UT, WP, row0, col0, wave, lr, q);
        skinny_core(am, U + (size_t)(OM >> 8) * UT, 256, UT, WP + (size_t)2048 * 2048, row0, col0, wave, lr, q);
        skinny_put(red, aa, wave * 2, lr, q); skinny_put(red, am, wave * 2 + 1, lr, q);
        __syncthreads();
        const int row = tid >> 4, c4 = (tid & 15) * 4;
        f32x4 ya = (f32x4){0.f, 0.f, 0.f, 0.f}, ym = ya;
#pragma unroll
        for (int w = 0; w < 8; ++w) { ya += *(const LAS f32x4*)(red + ((size_t)(2 * w) * 32 + row) * 64 + c4); ym += *(const LAS f32x4*)(red + ((size_t)(2 * w + 1) * 32 + row) * 64 + c4); }
        const size_t r = row0 + row; const int col = col0 + c4;
        const u32x2 ga = *(const u32x2*)(U + uoff((int)r, GA + col)), gm = *(const u32x2*)(U + uoff((int)r, GM + col));
        u32x2 w; w.x = pk2(sigmoidf_(bflo(ga.x)) * ya[0] + sigmoidf_(bflo(gm.x)) * ym[0], sigmoidf_(bfhi(ga.x)) * ya[1] + sigmoidf_(bfhi(gm.x)) * ym[1]);
        w.y = pk2(sigmoidf_(bflo(ga.y)) * ya[2] + sigmoidf_(bflo(gm.y)) * ym[2], sigmoidf_(bfhi(ga.y)) * ya[3] + sigmoidf_(bfhi(gm.y)) * ym[3]);
        *(u32x2*)(MG + r * DM + col) = w;
        __syncthreads();
    }
}
DI void skinny_out(const Params& p, LAS unsigned char* lds) {
    const int tid = threadIdx.x, lane = tid & 63, wave = tid >> 6, lr = lane & 15, q = lane >> 4;
    const bf16_t* MG = (const bf16_t*)(p.ws + WS_XN); const bf16_t* WO = (const bf16_t*)(p.ws + WS_WOUT); float* ssq = (float*)(p.ws + WS_SSQ);
    LAS float* red = (LAS float*)lds;
    for (int tile = blockIdx.x; tile < 256; tile += gridDim.x) {
        const int row0 = ROW_S + 32 * (tile >> 5), col0 = 64 * (tile & 31);
        f32x4 aa[2][4];
#pragma unroll
        for (int rt = 0; rt < 2; ++rt)
#pragma unroll
            for (int ct = 0; ct < 4; ++ct) aa[rt][ct] = (f32x4){0.f, 0.f, 0.f, 0.f};
        skinny_core(aa, MG, DM, 256, WO, row0, col0, wave, lr, q);
        skinny_put(red, aa, wave, lr, q);
        __syncthreads();
        const int row = tid >> 4, c4 = (tid & 15) * 4;
        f32x4 y = (f32x4){0.f, 0.f, 0.f, 0.f};
#pragma unroll
        for (int w = 0; w < 8; ++w) y += *(const LAS f32x4*)(red + ((size_t)w * 32 + row) * 64 + c4);
        const size_t r = row0 + row; const int col = col0 + c4;
        const f32x4 o = *(const f32x4*)(p.xs + (r - ROW_S) * DM + col) + y;
        { u32x2 w; w.x = pk2(o[0], o[1]); w.y = pk2(o[2], o[3]); *(u32x2*)((bf16_t*)(p.ws + WS_U) + uoff((int)r, col)) = w; }
        float ss = (o[0] * o[0] + o[1] * o[1]) + (o[2] * o[2] + o[3] * o[3]);
        ss += __shfl_xor(ss, 1); ss += __shfl_xor(ss, 2); ss += __shfl_xor(ss, 4); ss += __shfl_xor(ss, 8);
        if ((tid & 15) == 0) ssq[r * 32 + (tile & 31)] = ss;
        __syncthreads();
    }
}

DI void final_norm(const Params& p) {
    const int lane = threadIdx.x & 63, gw = blockIdx.x * 8 + (threadIdx.x >> 6), NGW = gridDim.x * 8;
    const float* ssq = (const float*)(p.ws + WS_SSQ); const bf16_t* X1 = (const bf16_t*)(p.ws + WS_U);
    for (int r = gw; r < MOUT; r += NGW) {
        u32x2 xv[8];
#pragma unroll
        for (int j = 0; j < 8; ++j) xv[j] = *(const u32x2*)(X1 + (size_t)j * UT + (size_t)r * 256 + 4 * lane);
        const float s = wsum(lane < 32 ? ssq[(size_t)r * 32 + lane] : 0.f);
        const float rstd = rsqrtf(s * (1.f / DM) + EPS);
        f32x4* o = (f32x4*)(p.out + (size_t)r * DM) + lane; const f32x4* g = (const f32x4*)p.gfinal + lane;
#pragma unroll
        for (int j = 0; j < 8; ++j) { const f32x4 gg = g[64 * j]; f32x4 v; v[0] = bflo(xv[j].x) * rstd * gg[0]; v[1] = bfhi(xv[j].x) * rstd * gg[1]; v[2] = bflo(xv[j].y) * rstd * gg[2]; v[3] = bfhi(xv[j].y) * rstd * gg[3]; o[64 * j] = v; }
    }
}

__global__ void __launch_bounds__(512, 2) mega(Params p) {
    extern __shared__ __attribute__((aligned(16))) unsigned char lds_raw[];
    LAS unsigned char* lds = (LAS unsigned char*)lds_raw;
    cg::grid_group grid = cg::this_grid();
    const int lo = p.ph_lo, hi = p.ph_hi;
#define IN(k) (lo <= (k) && (k) < hi)
#define STAMP(i) do { if (TPROBE >= 0 && blockIdx.x == 0 && threadIdx.x == 0) tsl[i] = __builtin_amdgcn_s_memrealtime(); } while (0)
#define SEAM(k) do { if (IN(k) && IN((k) + 1)) xcd_barrier(bar); STAMP((k) + 1); } while (0)
    volatile LAS unsigned long long* tsl = (volatile LAS unsigned long long*)(lds + 131072 + 1040);
    volatile LAS unsigned* bst = (volatile LAS unsigned*)(lds + 131072 + 1024);
    if (threadIdx.x < 2) bst[threadIdx.x] = 0u;
    __syncthreads();
    XcdBarrier bar = xcd_barrier_post((unsigned*)(p.ws + WS_BAR), bst);
    if (hi > 1000) grid.sync();
    bf16_t* U = (bf16_t*)(p.ws + WS_U);
    STAMP(0);
    if (IN(0)) for (int rep = 0; rep < REP0; ++rep) p0_prologue(p, lds);
    SEAM(0);
    if (IN(1)) for (int rep = 0; rep < REP1; ++rep) {
        pg8::Order S; S.init(MPAD / 256, NW / 256, gridDim.x, blockIdx.x, 0);
        S.A0 = S.A1 = (const char*)(p.ws + WS_XN); S.B0 = S.B1 = (const char*)(p.ws + WS_WIN); S.a_tstep = (size_t)256 * DM * 2; S.b_tstep = (size_t)256 * 2048 * 2;
        pg8::EpiU E{U, (float*)(p.ws + WS_GATE), p.out};
        pg8::gemm_phase<pg8::EpiU>(lds, 2048, DM, 512, S, E);
    }
    SEAM(1);
    if (IN(2)) {
        for (int rep = 0; rep < REP2; ++rep) { const int dry = rep + 1 < REP2;
        for (int it = blockIdx.x; it < 1224; it += gridDim.x) {
            if (it < 512) { if (!dry || (PSEL & 1)) attn_item(p, lds, 0, it >> 2, it & 3, dry); }
            else if (it < 576) { if (!dry || (PSEL & 1)) attn_item(p, lds, 1, (it - 512) >> 2, (it - 512) & 3, dry); }
            else if (it < 1088) { if (!dry || (PSEL & 2)) mlstm_sum_item(p, lds, (it - 576) & 7, (it - 576) >> 3); }
            else { if (!dry || (PSEL & 4)) mlstm_small_item(p, lds, (it - 1088) >> 3, (it - 1088) & 7, dry); }
        } }
    }
    SEAM(2);
    if (IN(3)) for (int rep = 0; rep < REP3; ++rep) mlstm_scan(p, lds);
    for (int rep = 0; rep < REPSYNC; ++rep) xcd_barrier(bar);
    SEAM(3);
    if (IN(4)) for (int rep = 0; rep < REP4; ++rep) { for (int it = blockIdx.x; it < 512; it += gridDim.x) mlstm_out_item(p, lds, it & 7, it >> 3, rep + 1 < REP4); }
    SEAM(4);
    if (IN(5)) for (int rep = 0; rep < REP56; ++rep) {
        pg8::Order S; S.init(ROW_S / 256, DM / 256, gridDim.x, blockIdx.x, 1);
        S.A0 = (const char*)(U + (size_t)(QA >> 8) * UT); S.A1 = (const char*)(U + (size_t)(OM >> 8) * UT); S.B0 = (const char*)(p.ws + WS_WP); S.B1 = S.B0 + (size_t)2048 * 2048 * 2;
        S.a_tstep = (size_t)256 * 256 * 2; S.b_tstep = (size_t)256 * 2048 * 2;
        pg8::EpiMerge E{U, (bf16_t*)(p.ws + WS_XN)};
        const bool skinny_first = (blockIdx.x >> 3) & 1;
        if (skinny_first) skinny_merge(p, lds);
        pg8::gemm_phase<pg8::EpiMerge>(lds, 2048, 256, UT * 2, S, E);
        if (!skinny_first) skinny_merge(p, lds);
    }
    SEAM(5);
    if (IN(6)) for (int rep = 0; rep < REP56; ++rep) {
        pg8::Order S; S.init(ROW_S / 256, DM / 256, gridDim.x, blockIdx.x, 0);
        S.A0 = S.A1 = (const char*)(p.ws + WS_XN); S.B0 = S.B1 = (const char*)(p.ws + WS_WOUT); S.a_tstep = (size_t)256 * DM * 2; S.b_tstep = (size_t)256 * 2048 * 2;
        pg8::EpiOut E{p.xp, p.xs, U, (float*)(p.ws + WS_SSQ)};
        const bool skinny_first = (blockIdx.x >> 3) & 1;
        if (skinny_first) skinny_out(p, lds);
        pg8::gemm_phase<pg8::EpiOut>(lds, 2048, DM, 512, S, E);
        if (!skinny_first) skinny_out(p, lds);
    }
    SEAM(6);
    if (IN(7)) final_norm(p);
    if (TPROBE >= 0 && blockIdx.x == 0 && threadIdx.x == 0) { const unsigned long long te = __builtin_amdgcn_s_memrealtime(); tsl[8] = te;
        const unsigned long long d = tsl[TPROBE + 1] - tsl[TPROBE]; while (__builtin_amdgcn_s_memrealtime() - te < 9ull * d) __builtin_amdgcn_s_sleep(8); }
#undef IN
#undef SEAM
}

extern "C" void kernel_launch(void* const* d_in, const int* in_sizes, int n_in, void* d_out, int out_size, void* d_ws, size_t ws_size, hipStream_t stream) {
    static int grid = 0;
    if (grid == 0) {
        if (n_in != 18 || out_size != 22889608 || ws_size < WS_END) { fprintf(stderr, "kernel_launch: unexpected shapes (n_in %d out %d ws %zu need %zu)\n", n_in, out_size, ws_size, (size_t)WS_END); grid = -1; return; }
        int dev = 0, cus = 0, per_cu = 0;
        hipGetDevice(&dev); hipDeviceGetAttribute(&cus, hipDeviceAttributeMultiprocessorCount, dev);
        if (hipFuncSetAttribute((const void*)mega, hipFuncAttributeMaxDynamicSharedMemorySize, LDS_BYTES) != hipSuccess) { fprintf(stderr, "kernel_launch: hipFuncSetAttribute failed\n"); grid = -1; return; }
        if (hipOccupancyMaxActiveBlocksPerMultiprocessor(&per_cu, (const void*)mega, 512, LDS_BYTES) != hipSuccess || per_cu < 1) { fprintf(stderr, "kernel_launch: occupancy query says %d\n", per_cu); (void)hipGetLastError(); }
        grid = cus > 0 ? cus : 256;
    }
    if (grid < 0) return;
    Params p{};
    p.xp = (const float*)d_in[0]; p.xs = (const float*)d_in[1]; p.ck = (const float*)d_in[2]; p.cv = (const float*)d_in[3];
    p.sC = (const float*)d_in[4]; p.sn = (const float*)d_in[5]; p.sm = (const float*)d_in[6]; p.meta = (const float*)d_in[7];
    p.gnorm = (const float*)d_in[8]; p.win = (const float*)d_in[9]; p.bi = (const float*)d_in[10]; p.bf = (const float*)d_in[11];
    p.sinks = (const float*)d_in[12]; p.gmh = (const float*)d_in[13]; p.wpa = (const float*)d_in[14]; p.wpm = (const float*)d_in[15];
    p.wout = (const float*)d_in[16]; p.gfinal = (const float*)d_in[17];
    p.out = (float*)d_out; p.ws = (unsigned char*)d_ws;
#if N_LAUNCH == 1
    p.ph_lo = 0; p.ph_hi = 8;
    if (hipMemsetAsync((char*)d_ws + WS_BAR, 0, 16384, stream) != hipSuccess) { fprintf(stderr, "kernel_launch: memset failed\n"); return; }
    void* args[] = {&p};
    hipError_t e = hipLaunchCooperativeKernel((const void*)mega, dim3(grid), dim3(512), args, LDS_BYTES, stream);
    if (e != hipSuccess) fprintf(stderr, "cooperative launch failed: %s (grid %d)\n", hipGetErrorString(e), grid);
#else
    for (int ph = 0; ph < 8; ++ph) { p.ph_lo = ph; p.ph_hi = ph + 1; hipLaunchKernelGGL(mega, dim3(grid), dim3(512), LDS_BYTES, stream, p); }
#endif
}
```

```cpp
#include <hip/hip_runtime.h>
#include <hip/hip_cooperative_groups.h>
#include <cstdio>
#include <cstdint>
namespace cg = cooperative_groups;

#ifndef REP1
#define REP1 1
#endif
#ifndef REP3
#define REP3 1
#endif
#ifndef REP0
#define REP0 1
#endif
#ifndef REP2
#define REP2 1
#endif
#ifndef REP4
#define REP4 1
#endif
#ifndef PSEL
#define PSEL 7
#endif
#ifndef TPROBE
#define TPROBE -1
#endif
#ifndef REP56
#define REP56 1
#endif
#ifndef REPSYNC
#define REPSYNC 0
#endif
#ifndef N_LAUNCH
#define N_LAUNCH 1
#endif

#define LAS __attribute__((address_space(3)))
typedef unsigned short bf16_t;
typedef short bf16x8 __attribute__((ext_vector_type(8)));
typedef short s16x4 __attribute__((ext_vector_type(4)));
typedef float f32x4 __attribute__((ext_vector_type(4)));
typedef float f32x2 __attribute__((ext_vector_type(2)));
typedef unsigned u32x4 __attribute__((ext_vector_type(4)));
typedef unsigned u32x2 __attribute__((ext_vector_type(2)));
#define DI __device__ __forceinline__

constexpr int DM = 2048;
constexpr int ROW_S = 8192, ROW_M = 8448, MROWS = 8464, MPAD = 8704, MOUT = 8448;
constexpr int NU = 16896, NW = 17152;
constexpr size_t UT = (size_t)8704 * 256;
__device__ __forceinline__ size_t uoff(int row, int col) { return (size_t)(col >> 8) * UT + (size_t)row * 256 + (col & 255); }
constexpr int QA = 0, KA = 2048, VA = 2304, ZA = 2560, QM = 4608, KM = 5632, VM = 6656, OM = 8704, ZM = 10752, GA = 12800, GM = 14848;
constexpr int NCH = 64;
constexpr float EPS = 1e-6f;
constexpr size_t O_KP = 17301504, O_VP = 17334272, O_CP = 17367040, O_NP = 17629184, O_MP = 17630208,
                 O_KS = 17630216, O_VS = 18154504, O_CS = 18678792, O_NS = 22873096, O_MS = 22889480;
constexpr size_t WS_WIN = 4096;
constexpr size_t WS_WP = WS_WIN + (size_t)NW * 2048 * 2;
constexpr size_t WS_WOUT = WS_WP + (size_t)4096 * 2048 * 2;
constexpr size_t WS_XN = WS_WOUT + (size_t)2048 * 2048 * 2;
constexpr size_t WS_U = WS_XN + (size_t)MPAD * 2048 * 2;
constexpr size_t WS_GATE = WS_U + (size_t)MPAD * NU * 2;
constexpr size_t WS_UP = WS_GATE + (size_t)MPAD * 16 * 4;
constexpr size_t WS_CST = WS_UP + (size_t)8 * NCH * 256 * 128 * 4;
constexpr size_t WS_NP = WS_CST + (size_t)8 * NCH * 256 * 128 * 2;
constexpr size_t WS_NS = WS_NP + (size_t)8 * NCH * 128 * 4;
constexpr size_t WS_BS = WS_NS + (size_t)8 * NCH * 128 * 4;
constexpr size_t WS_ML = WS_BS + 4096;
constexpr size_t WS_MS = WS_ML + 4096;
constexpr size_t WS_C0 = WS_MS + 4096;
constexpr size_t WS_N0 = WS_C0 + (size_t)8 * 128 * 256 * 4;
constexpr size_t WS_M0 = WS_N0 + 4096;
constexpr size_t WS_SSQ = WS_M0 + 4096;
constexpr size_t WS_BAR = WS_SSQ + (size_t)MOUT * 32 * 4;
constexpr size_t WS_END = WS_BAR + 16384;
constexpr int LDS_BYTES = 131072 + 2048;

struct Params {
    const float *xp, *xs, *ck, *cv, *sC, *sn, *sm, *meta, *gnorm, *win, *bi, *bf, *sinks, *gmh, *wpa, *wpm, *wout, *gfinal;
    float* out; unsigned char* ws; int ph_lo, ph_hi;
};

DI float bf2f(unsigned short b) { return __uint_as_float(((unsigned)b) << 16); }
DI float bflo(unsigned w) { return __uint_as_float(w << 16); }
DI float bfhi(unsigned w) { return __uint_as_float(w & 0xffff0000u); }
DI unsigned pk2(float lo, float hi) { unsigned r; asm volatile("v_cvt_pk_bf16_f32 %0, %1, %2\n\ts_nop 1" : "=v"(r) : "v"(lo), "v"(hi)); return r; }
DI unsigned f2bf_c(float f) { const unsigned u = __float_as_uint(f); return (u + 0x7fffu + ((u >> 16) & 1u)) >> 16; }
DI float sigmoidf_(float x) { return __builtin_amdgcn_rcpf(1.0f + __expf(-x)); }
DI float siluf_(float x) { return x * __builtin_amdgcn_rcpf(1.0f + __expf(-x)); }
DI float logsigmoidf_(float x) { return fminf(x, 0.f) - log1pf(__expf(-fabsf(x))); }
DI float wsum(float v) {
#pragma unroll
    for (int o = 1; o < 64; o <<= 1) v += __shfl_xor(v, o);
    return v;
}
DI float wmax(float v) {
#pragma unroll
    for (int o = 1; o < 64; o <<= 1) v = fmaxf(v, __shfl_xor(v, o));
    return v;
}
DI float scan_add(float v, int lane) {
#pragma unroll
    for (int o = 1; o < 64; o <<= 1) { float t = __shfl_up(v, o); if (lane >= o) v += t; }
    return v;
}
DI float scan_max(float v, int lane) {
#pragma unroll
    for (int o = 1; o < 64; o <<= 1) { float t = __shfl_up(v, o); if (lane >= o) v = fmaxf(v, t); }
    return v;
}
#define ROWPTR(m) ((m) < ROW_S ? p.xp + (size_t)(m) * DM : ((m) < ROW_M ? p.xs + (size_t)((m) - ROW_S) * DM : p.meta + (size_t)((m) - ROW_M) * DM))
DI s16x4 tr_read(const LAS bf16_t* p) { return __builtin_amdgcn_ds_read_tr16_b64_v4i16((LAS s16x4*)p); }
#define LDS_WAIT() asm volatile("s_waitcnt lgkmcnt(0)" ::: "memory")
#define MFMA16(a, b, c) __builtin_amdgcn_mfma_f32_16x16x32_bf16((a), (b), (c), 0, 0, 0)

#define XB_TMO      128
#define XB_XCNT(j)  (256  + 64 * (j))
#define XB_XSUB(j)  (1280 + 64 * (j))
#define XB_XGEN(j)  (2304 + 64 * (j))
#define XB_TOP      3328
#define XB_TOPGEN   3392
#define XCD_BAR_WORDS 3456
#define XB_SPIN_CAP (1u << 18)
DI unsigned xb_ld(unsigned* p)              { return __hip_atomic_load(p, __ATOMIC_RELAXED, __HIP_MEMORY_SCOPE_AGENT); }
DI unsigned xb_add(unsigned* p, unsigned v) { return __hip_atomic_fetch_add(p, v, __ATOMIC_RELAXED, __HIP_MEMORY_SCOPE_AGENT); }
DI unsigned xb_xcc_id() { return (unsigned)__builtin_amdgcn_s_getreg((3 << 11) | 20) & 0xFu; }
#define XB_SPIN(cond, bar) do { unsigned _sp = 0; while (cond) { __builtin_amdgcn_s_sleep(1); \
    if ((++_sp & 255u) == 0u) { if (xb_ld(&(bar)[XB_TMO])) break; if (_sp > XB_SPIN_CAP) { atomicAdd(&(bar)[XB_TMO], 1u); break; } } } } while (0)
struct XcdBarrier { unsigned* bar; unsigned x; volatile LAS unsigned* st; };
DI XcdBarrier xcd_barrier_post(unsigned* bar, volatile LAS unsigned* st) {
    XcdBarrier b; b.bar = bar; b.x = xb_xcc_id(); b.st = st;
    if (threadIdx.x == 0) (void)xb_add(&bar[XB_XCNT(b.x)], 1u);
    return b;
}
DI void xcd_barrier_complete(unsigned* bar, unsigned x, unsigned& nloc, unsigned& nx) {
    const unsigned G = gridDim.x * gridDim.y * gridDim.z;
    unsigned sum, cnt, mine, sp = 0u;
    for (;;) {
        sum = 0u; cnt = 0u; mine = 0u;
#pragma unroll
        for (unsigned j = 0; j < 16; ++j) { const unsigned c = xb_ld(&bar[XB_XCNT(j)]); sum += c; cnt += (c > 0u) ? 1u : 0u; mine = (j == x) ? c : mine; }
        if (sum == G) break;
        __builtin_amdgcn_s_sleep(1);
        if ((++sp & 255u) == 0u) { if (xb_ld(&bar[XB_TMO])) break; if (sp > XB_SPIN_CAP) { atomicAdd(&bar[XB_TMO], 1u); break; } }
    }
    nloc = mine > 0u ? mine : 1u; nx = cnt > 0u ? cnt : 1u;
}
DI void xcd_barrier(const XcdBarrier& b) {
    asm volatile("s_waitcnt vmcnt(0)" ::: "memory");
    __syncthreads();
    if (threadIdx.x == 0) {
        unsigned* bar = b.bar;
        __builtin_amdgcn_s_waitcnt(0);
        unsigned nloc = b.st[0], nx = b.st[1];
        if (nloc == 0u) { xcd_barrier_complete(bar, b.x, nloc, nx); b.st[0] = nloc; b.st[1] = nx; }
        const unsigned old = xb_add(&bar[XB_XSUB(b.x)], 1u);
        const unsigned gen = old / nloc;
        if (old + 1u == (gen + 1u) * nloc) {
            __builtin_amdgcn_fence(__ATOMIC_RELEASE, "agent");
            asm volatile("s_waitcnt vmcnt(0)" ::: "memory");
            const unsigned og = xb_add(&bar[XB_TOP], 1u);
            const unsigned tg = og / nx;
            if (og + 1u == (tg + 1u) * nx) xb_add(&bar[XB_TOPGEN], 1u);
            else XB_SPIN(xb_ld(&bar[XB_TOPGEN]) == tg, bar);
            __builtin_amdgcn_fence(__ATOMIC_ACQUIRE, "agent");
            xb_add(&bar[XB_XGEN(b.x)], 1u);
            asm volatile("s_waitcnt vmcnt(0)" ::: "memory");
        } else {
            XB_SPIN(xb_ld(&bar[XB_XGEN(b.x)]) == gen, bar);
            __builtin_amdgcn_fence(__ATOMIC_ACQUIRE, "agent");
            asm volatile("s_waitcnt vmcnt(0)" ::: "memory");
        }
    }
    __syncthreads();
}

namespace pg8 {
constexpr int BM = 256, BK = 64, HALF = 128, HTB = HALF * BK * 2, STAGE_BYTES = 8 * HTB, NXCD = 8, WGM = 4;
DI int lds_byte(int r, int c) { const int st = (r >> 4) * 2 + (c >> 5), rr = r & 15, cc = c & 31, ob = rr * 64 + cc * 2; return st * 1024 + (ob ^ (((ob >> 9) & 1) << 5)); }
DI void stage_rc(int b, int& R, int& C) { const int st = b / 1024, sb = b % 1024, swz = sb ^ (((sb >> 9) & 1) << 5); R = (st >> 1) * 16 + swz / 64; C = (st & 1) * 32 + (swz % 64) / 2; }
DI int perm32(int rho) { const int n = rho >> 4, i = rho & 15; return 8 * (i >> 2) + 4 * n + (i & 3); }

struct Unit { int pm, pn, sub; };

struct Order {
    int nM, nN, nwg, G, c, pair;
    const char *A0, *A1, *B0, *B1; size_t a_tstep, b_tstep;
    DI void init(int nM_, int nN_, int G_, int c_, int pair_) { nM = nM_; nN = nN_; nwg = nM * nN; G = G_; c = c_; pair = pair_; }
    DI bool next(int i, Unit& u) const {
        const int t = pair ? (i >> 1) : i; u.sub = pair ? (i & 1) : 0;
        const long L = (long)t * G + c; if (L >= nwg) return false;
        int wgid = (int)L; { const int q = nwg / NXCD, r = nwg % NXCD, xcd = wgid % NXCD, off = wgid / NXCD; wgid = (xcd < r ? xcd * (q + 1) : r * (q + 1) + (xcd - r) * q) + off; }
        const int nig = WGM * nN, gid = wgid / nig, fm = gid * WGM, gsz = (nM - fm) < WGM ? (nM - fm) : WGM;
        u.pm = fm + ((wgid % nig) % gsz); u.pn = (wgid % nig) / gsz; return true;
    }
    DI const char* a_ptr(const Unit& u) const { return (u.sub ? A1 : A0) + (size_t)u.pm * a_tstep; }
    DI const char* b_ptr(const Unit& u) const { return (u.sub ? B1 : B0) + (size_t)u.pn * b_tstep; }
};

template <class Epi>
DI void gemm_phase(LAS unsigned char* lds, const int K, const int lda, const size_t a_kblk, const Order& S, const Epi& E) {
#define PG8_AK(x) ((size_t)((x) >> 2) * a_kblk + (size_t)((x) & 3) * 128)
    const int tid = threadIdx.x, wid = __builtin_amdgcn_readfirstlane(tid >> 6), lane = tid & 63, wr = wid >> 2, wc = wid & 3, fr = lane & 15, fq = lane >> 4;
    const int nt = K / BK;
    unsigned voffA[2], voffB[2];
#pragma unroll
    for (int i = 0; i < 2; ++i) { int R, C; stage_rc(tid * 16 + i * 8192, R, C); const int Rb = Epi::PERM ? ((R & ~31) + perm32(R & 31)) : R;
        voffA[i] = (unsigned)(R * lda + C) * 2u; voffB[i] = (unsigned)(Rb * K + C) * 2u; }
    const size_t kstep = (size_t)(BK * 2);
    const size_t hstepA = (size_t)HALF * lda * 2, hstepB = (size_t)HALF * K * 2;
    const unsigned ldsw = (unsigned)wid * 1024u;
    const int aoff = lds_byte(wr * 64 + fr, fq * 8), boff = lds_byte(wc * 32 + fr, fq * 8);
#define PG8_SA(b, h) (((b) * 2 + (h)) * HTB)
#define PG8_SB(b, h) ((4 + (b) * 2 + (h)) * HTB)
#define PG8_STAGE(bufoff, gbase, voff) do { _Pragma("unroll") for (int _i = 0; _i < 2; ++_i) \
        __builtin_amdgcn_global_load_lds((const unsigned*)((const char*)(gbase) + (voff)[_i]), (LAS unsigned*)(lds + (bufoff) + ldsw + _i * 8192), 16, 0, 0); } while (0)
#define PG8_LDA(dst, b, h) do { _Pragma("unroll") for (int m = 0; m < 4; ++m) _Pragma("unroll") for (int k = 0; k < 2; ++k) dst[m][k] = *(const LAS bf16x8*)(lds + PG8_SA(b, h) + aoff + m * 2048 + k * 1024); } while (0)
#define PG8_LDB(dst, b, h) do { _Pragma("unroll") for (int n = 0; n < 2; ++n) _Pragma("unroll") for (int k = 0; k < 2; ++k) dst[n][k] = *(const LAS bf16x8*)(lds + PG8_SB(b, h) + boff + n * 2048 + k * 1024); } while (0)
#define PG8_MMA(ai, bj, At, Bt) do { __builtin_amdgcn_s_setprio(1); _Pragma("unroll") for (int m = 0; m < 4; ++m) _Pragma("unroll") for (int n = 0; n < 2; ++n) _Pragma("unroll") for (int k = 0; k < 2; ++k) \
        acc[ai][bj][m][n] = __builtin_amdgcn_mfma_f32_16x16x32_bf16(Bt[n][k], At[m][k], acc[ai][bj][m][n], 0, 0, 0); __builtin_amdgcn_s_setprio(0); } while (0)
#define PG8_WAIT_V(n) asm volatile("s_waitcnt vmcnt(" #n ")" ::: "memory")
#define PG8_WAIT_L(n) asm volatile("s_waitcnt lgkmcnt(" #n ")" ::: "memory")
#define PG8_BAR __builtin_amdgcn_s_barrier()
#define PG8_SCHED __builtin_amdgcn_sched_barrier(0)
    Unit cur, nxt; int ui = 0;
    if (!S.next(0, cur)) return;
    f32x4 acc[2][2][4][2];
#pragma unroll
    for (int a = 0; a < 2; ++a)
#pragma unroll
        for (int b = 0; b < 2; ++b)
#pragma unroll
            for (int m = 0; m < 4; ++m)
#pragma unroll
                for (int n = 0; n < 2; ++n) acc[a][b][m][n] = (f32x4){0.f, 0.f, 0.f, 0.f};
    bf16x8 At[4][2], B0[2][2], B1[2][2];
    const char* cA = S.a_ptr(cur); const char* cB = S.b_ptr(cur);
    PG8_STAGE(PG8_SB(0, 0), cB, voffB); PG8_STAGE(PG8_SB(0, 1), cB + hstepB, voffB); PG8_STAGE(PG8_SA(0, 0), cA, voffA); PG8_STAGE(PG8_SA(0, 1), cA + hstepA, voffA);
    if (wr == 1) PG8_BAR;
    PG8_WAIT_V(2); PG8_BAR;
    PG8_STAGE(PG8_SB(1, 0), cB + kstep, voffB); PG8_STAGE(PG8_SA(1, 0), cA + kstep, voffA); PG8_STAGE(PG8_SB(1, 1), cB + hstepB + kstep, voffB);
    PG8_WAIT_V(6); PG8_BAR;
    for (;;) {
        const bool has_next = S.next(ui + 1, nxt);
        const char* nA = has_next ? S.a_ptr(nxt) : cA; const char* nB = has_next ? S.b_ptr(nxt) : cB;
        for (int t = 0; t < nt; t += 2) {
            const bool last = (t == nt - 2);
            const char* a1 = cA + PG8_AK(t + 1);
            const char* a2 = last ? nA : cA + PG8_AK(t + 2); const char* b2 = last ? nB : cB + (size_t)(t + 2) * kstep;
            const char* a3 = a2 + kstep; const char* b3 = b2 + kstep;
            PG8_LDB(B0, 0, 0); PG8_LDB(B1, 0, 1); PG8_SCHED; PG8_LDA(At, 0, 0); PG8_STAGE(PG8_SA(1, 1), a1 + hstepA, voffA);
            PG8_WAIT_V(8); PG8_WAIT_L(0); PG8_BAR; PG8_MMA(0, 0, At, B0); PG8_MMA(0, 1, At, B1); PG8_BAR; PG8_SCHED;
            PG8_LDA(At, 0, 1); PG8_STAGE(PG8_SB(0, 0), b2, voffB); PG8_STAGE(PG8_SB(0, 1), b2 + hstepB, voffB); PG8_STAGE(PG8_SA(0, 0), a2, voffA);
            PG8_WAIT_V(8); PG8_WAIT_L(0); PG8_BAR; PG8_MMA(1, 0, At, B0); PG8_MMA(1, 1, At, B1); PG8_BAR; PG8_SCHED;
            PG8_LDB(B0, 1, 0); PG8_LDB(B1, 1, 1); PG8_SCHED; PG8_LDA(At, 1, 0); PG8_STAGE(PG8_SA(0, 1), a2 + hstepA, voffA);
            PG8_WAIT_V(8); PG8_WAIT_L(0); PG8_BAR; PG8_MMA(0, 0, At, B0); PG8_MMA(0, 1, At, B1); PG8_BAR; PG8_SCHED;
            PG8_LDA(At, 1, 1); PG8_STAGE(PG8_SB(1, 0), b3, voffB); PG8_STAGE(PG8_SB(1, 1), b3 + hstepB, voffB); PG8_STAGE(PG8_SA(1, 0), a3, voffA);
            PG8_WAIT_V(8); PG8_WAIT_L(0); PG8_BAR; PG8_MMA(1, 0, At, B0); PG8_MMA(1, 1, At, B1); PG8_BAR; PG8_SCHED;
        }
        if (wr == 0) PG8_BAR;
        E(acc, cur, wr, wc, fr, fq);
        if (!has_next) break;
#pragma unroll
        for (int a = 0; a < 2; ++a)
#pragma unroll
            for (int b = 0; b < 2; ++b)
#pragma unroll
                for (int m = 0; m < 4; ++m)
#pragma unroll
                    for (int n = 0; n < 2; ++n) acc[a][b][m][n] = (f32x4){0.f, 0.f, 0.f, 0.f};
        cur = nxt; cA = nA; cB = nB; ++ui;
        if (wr == 1) PG8_BAR;
    }
    PG8_WAIT_V(0);
    PG8_BAR;
#undef PG8_AK
#undef PG8_SA
#undef PG8_SB
#undef PG8_STAGE
#undef PG8_LDA
#undef PG8_LDB
#undef PG8_MMA
#undef PG8_WAIT_V
#undef PG8_WAIT_L
#undef PG8_BAR
#undef PG8_SCHED
}

struct EpiU {
    static constexpr bool PERM = true;
    bf16_t* U; float* gate; float* out;
    DI void operator()(const f32x4 (&acc)[2][2][4][2], const Unit& u, int wr, int wc, int fr, int fq) const {
        const int row0 = u.pm * BM + wr * 64 + fr, pn = u.pn;
        if (pn == 66) {
            if (wc == 0 && fq < 2) {
#pragma unroll
                for (int ai = 0; ai < 2; ++ai)
#pragma unroll
                    for (int m = 0; m < 4; ++m) { float* g = gate + (size_t)(row0 + ai * HALF + m * 16) * 16 + 8 * fq;
                        *(f32x4*)g = acc[ai][0][m][0]; *(f32x4*)(g + 4) = acc[ai][0][m][1]; }
            }
            return;
        }
        const float scale = (pn < 8) ? 0.18033688011112042f : ((pn >= 22 && pn < 26) ? 0.08838834764831845f : 1.0f);
        const int col0 = pn * BM + wc * 32 + 8 * fq;
#pragma unroll
        for (int ai = 0; ai < 2; ++ai)
#pragma unroll
            for (int m = 0; m < 4; ++m) { bf16_t* rowp = U + (size_t)pn * UT + (size_t)(row0 + ai * HALF + m * 16) * 256 + (wc * 32 + 8 * fq);
#pragma unroll
                for (int bj = 0; bj < 2; ++bj) { const f32x4 v0 = acc[ai][bj][m][0] * scale, v1 = acc[ai][bj][m][1] * scale;
                    u32x4 w; w.x = pk2(v0[0], v0[1]); w.y = pk2(v0[2], v0[3]); w.z = pk2(v1[0], v1[1]); w.w = pk2(v1[2], v1[3]);
                    *(u32x4*)(rowp + bj * HALF) = w; } }
        if (pn == 8 || pn == 9) {
#pragma unroll
            for (int ai = 0; ai < 2; ++ai)
#pragma unroll
                for (int m = 0; m < 4; ++m) { const int r = row0 + ai * HALF + m * 16; float* dst = nullptr;
                    if (r >= 8064 && r < 8192) dst = out + (pn == 8 ? O_KP : O_VP) + (size_t)(r - 8064) * 256;
                    else if (r >= 8192 && r < 8448) { const int b = (r - 8192) >> 4, t = (r - 8192) & 15; dst = out + (pn == 8 ? O_KS : O_VS) + (size_t)(b * 128 + 112 + t) * 256; }
                    if (dst) {
#pragma unroll
                        for (int bj = 0; bj < 2; ++bj) { const int c = bj * HALF + wc * 32 + 8 * fq; *(f32x4*)(dst + c) = acc[ai][bj][m][0]; *(f32x4*)(dst + c + 4) = acc[ai][bj][m][1]; } } }
        }
    }
};
struct EpiMerge {
    static constexpr bool PERM = true;
    const bf16_t* U; bf16_t* MG;
    DI void operator()(const f32x4 (&acc)[2][2][4][2], const Unit& u, int wr, int wc, int fr, int fq) const {
        const int row0 = u.pm * BM + wr * 64 + fr, col0 = u.pn * BM + wc * 32 + 8 * fq; const int gcol = u.sub ? GM : GA;
#pragma unroll
        for (int ai = 0; ai < 2; ++ai) {
            u32x4 g[4][2], o[4][2];
#pragma unroll
            for (int m = 0; m < 4; ++m)
#pragma unroll
                for (int bj = 0; bj < 2; ++bj) { const int r = row0 + ai * HALF + m * 16, c = col0 + bj * HALF;
                    g[m][bj] = *(const u32x4*)(U + uoff(r, gcol + c));
                    o[m][bj] = u.sub ? *(const u32x4*)(MG + (size_t)r * DM + c) : (u32x4){0u, 0u, 0u, 0u}; }
#pragma unroll
            for (int m = 0; m < 4; ++m)
#pragma unroll
                for (int bj = 0; bj < 2; ++bj) { const int r = row0 + ai * HALF + m * 16, c = col0 + bj * HALF;
                    const u32x4 gg = g[m][bj], oo = o[m][bj]; const f32x4 a0 = acc[ai][bj][m][0], a1 = acc[ai][bj][m][1];
                    float v[8];
                    v[0] = sigmoidf_(bflo(gg.x)) * a0[0] + bflo(oo.x); v[1] = sigmoidf_(bfhi(gg.x)) * a0[1] + bfhi(oo.x); v[2] = sigmoidf_(bflo(gg.y)) * a0[2] + bflo(oo.y); v[3] = sigmoidf_(bfhi(gg.y)) * a0[3] + bfhi(oo.y);
                    v[4] = sigmoidf_(bflo(gg.z)) * a1[0] + bflo(oo.z); v[5] = sigmoidf_(bfhi(gg.z)) * a1[1] + bfhi(oo.z); v[6] = sigmoidf_(bflo(gg.w)) * a1[2] + bflo(oo.w); v[7] = sigmoidf_(bfhi(gg.w)) * a1[3] + bfhi(oo.w);
                    u32x4 w; w.x = pk2(v[0], v[1]); w.y = pk2(v[2], v[3]); w.z = pk2(v[4], v[5]); w.w = pk2(v[6], v[7]);
                    *(u32x4*)(MG + (size_t)r * DM + c) = w; }
        }
    }
};
struct EpiOut {
    static constexpr bool PERM = false;
    const float *xp, *xs; bf16_t* X1; float* ssq;
    DI void operator()(const f32x4 (&acc)[2][2][4][2], const Unit& u, int wr, int wc, int fr, int fq) const {
        const int row0 = u.pm * BM + wr * 64 + fr, col0 = u.pn * BM + wc * 32 + 4 * fq;
#pragma unroll
        for (int ai = 0; ai < 2; ++ai) {
            f32x4 xv[4][2][2];
#pragma unroll
            for (int m = 0; m < 4; ++m) { const int r = row0 + ai * HALF + m * 16; const float* xrow = (r < ROW_S) ? xp + (size_t)r * DM : xs + (size_t)(r - ROW_S) * DM;
#pragma unroll
                for (int bj = 0; bj < 2; ++bj)
#pragma unroll
                    for (int n = 0; n < 2; ++n) xv[m][bj][n] = *(const f32x4*)(xrow + col0 + bj * HALF + n * 16); }
#pragma unroll
            for (int m = 0; m < 4; ++m) { const int r = row0 + ai * HALF + m * 16; bf16_t* orow = X1 + (size_t)u.pn * UT + (size_t)r * 256 + wc * 32 + 4 * fq; float ss = 0.f;
#pragma unroll
                for (int bj = 0; bj < 2; ++bj)
#pragma unroll
                    for (int n = 0; n < 2; ++n) { const f32x4 o = xv[m][bj][n] + acc[ai][bj][m][n];
                        u32x2 w; w.x = pk2(o[0], o[1]); w.y = pk2(o[2], o[3]); *(u32x2*)(orow + bj * HALF + n * 16) = w; ss += (o[0] * o[0] + o[1] * o[1]) + (o[2] * o[2] + o[3] * o[3]); }
                ss += __shfl_xor(ss, 16); ss += __shfl_xor(ss, 32);
                if (fq == 0) ssq[(size_t)r * 32 + u.pn * 4 + wc] = ss; }
        }
    }
};
}

DI int win_src_col(int n) { return n < 10752 ? n : (n < 16896 ? n + 16 : (n < 16912 ? 10752 + (n - 16896) : -1)); }

DI void p0_transpose_item(const float* W, int Nsrc, int srccol4, bf16_t* WT, int dstrow0, int k0, LAS float* scr, int lane) {
    f32x4 r[8];
#pragma unroll
    for (int i = 0; i < 8; ++i) { const int kk = (lane >> 3) + 8 * i; r[i] = (srccol4 >= 0) ? *(const f32x4*)(W + (size_t)(k0 + kk) * Nsrc + srccol4) : (f32x4){0.f, 0.f, 0.f, 0.f}; }
#pragma unroll
    for (int i = 0; i < 8; ++i) { const int kk = (lane >> 3) + 8 * i; LAS float* d = scr + kk * 33 + 4 * (lane & 7); d[0] = r[i][0]; d[1] = r[i][1]; d[2] = r[i][2]; d[3] = r[i][3]; }
    LDS_WAIT();
    const int c = lane & 7;
#pragma unroll
    for (int j = 0; j < 4; ++j) { const int n = (lane >> 3) + 8 * j; const LAS float* s = scr + (8 * c) * 33 + n;
        u32x4 o; o.x = pk2(s[0 * 33], s[1 * 33]); o.y = pk2(s[2 * 33], s[3 * 33]); o.z = pk2(s[4 * 33], s[5 * 33]); o.w = pk2(s[6 * 33], s[7 * 33]);
        *(u32x4*)(WT + (size_t)(dstrow0 + n) * 2048 + k0 + 8 * c) = o; }
    LDS_WAIT();
}

DI void p0_prologue(const Params& p, LAS unsigned char* lds) {
    const int tid = threadIdx.x, lane = tid & 63, wave = tid >> 6;
    const int gw = blockIdx.x * 8 + wave, NGW = gridDim.x * 8;
    bf16_t* WIN = (bf16_t*)(p.ws + WS_WIN); bf16_t* WP = (bf16_t*)(p.ws + WS_WP); bf16_t* WOUT = (bf16_t*)(p.ws + WS_WOUT); bf16_t* XN = (bf16_t*)(p.ws + WS_XN);
    LAS float* scr = (LAS float*)(lds + wave * 16384);
    constexpr int I_IN = 32 * (NW / 32), I_SQ = 32 * 64;
    for (int it = gw; it < I_IN + 3 * I_SQ; it += NGW) {
        int r = it;
        if (r < I_IN) { const int nb = r % (NW / 32), kb = r / (NW / 32); p0_transpose_item(p.win, 16912, win_src_col(nb * 32 + 4 * (lane & 7)), WIN, nb * 32, kb * 64, scr, lane); continue; }
        r -= I_IN; const int which = r / I_SQ; r -= which * I_SQ; const int nb = r % 64, kb = r / 64;
        const float* W = which == 0 ? p.wpa : (which == 1 ? p.wpm : p.wout);
        bf16_t* WT = which == 2 ? WOUT : WP; const int drow = (which == 1 ? 2048 : 0) + nb * 32;
        p0_transpose_item(W, 2048, nb * 32 + 4 * (lane & 7), WT, drow, kb * 64, scr, lane);
    }
    for (int m = gw; m < MPAD; m += NGW) {
        u32x2* o8 = (u32x2*)(XN + (size_t)m * DM) + lane;
        if (m >= MROWS) {
#pragma unroll
            for (int j = 0; j < 8; ++j) o8[64 * j] = (u32x2){0u, 0u};
            continue; }
        const float* xrow = m < ROW_S ? p.xp + (size_t)m * DM : (m < ROW_M ? p.xs + (size_t)(m - ROW_S) * DM : p.meta + (size_t)(m - ROW_M) * DM);
        const f32x4* xr = (const f32x4*)xrow + lane; const f32x4* gr = (const f32x4*)p.gnorm + lane;
        f32x4 v[8]; float s = 0.f;
#pragma unroll
        for (int j = 0; j < 8; ++j) { v[j] = xr[64 * j]; s += (v[j][0] * v[j][0] + v[j][1] * v[j][1]) + (v[j][2] * v[j][2] + v[j][3] * v[j][3]); }
        const float rstd = rsqrtf(wsum(s) * (1.f / DM) + EPS);
#pragma unroll
        for (int j = 0; j < 8; ++j) { const f32x4 g = gr[64 * j]; u32x2 w; w.x = pk2(v[j][0] * rstd * g[0], v[j][1] * rstd * g[1]); w.y = pk2(v[j][2] * rstd * g[2], v[j][3] * rstd * g[3]); o8[64 * j] = w; }
    }
    const int gt = blockIdx.x * 512 + tid, NGT = gridDim.x * 512;
    for (int i = gt; i < 2 * 16 * 112 * 64; i += NGT) {
        const int kv = i / (16 * 112 * 64); int r = i - kv * (16 * 112 * 64); const int b = r / (112 * 64); r -= b * (112 * 64);
        const f32x4* src = (const f32x4*)((kv ? p.cv : p.ck) + (size_t)(b * 128 + 16) * 256) + r;
        f32x4* dst = (f32x4*)(p.out + (kv ? O_VS : O_KS) + (size_t)(b * 128) * 256) + r;
        *dst = *src;
    }
}

DI u32x4 attn_fetch8(const Params& p, const bf16_t* U, int kind, int bidx, int g, int key, int ch, int colbase, const float* cache) {
    u32x4 z = (u32x4){0u, 0u, 0u, 0u};
    if (key < 16) return *(const u32x4*)(U + uoff(ROW_M + key, colbase + g * 64 + 8 * ch));
    if (kind == 0) {
        const int row = 64 * (bidx - 2) + (key - 16);
        if (key < 208 && row >= 0) return *(const u32x4*)(U + uoff(row, colbase + g * 64 + 8 * ch));
        return z;
    } else {
        if (key < 144) { const float* s = cache + ((size_t)(bidx * 128 + (key - 16)) * 4 + g) * 64 + 8 * ch; const f32x4 a = *(const f32x4*)s, b = *(const f32x4*)(s + 4);
            u32x4 w; w.x = pk2(a[0], a[1]); w.y = pk2(a[2], a[3]); w.z = pk2(b[0], b[1]); w.w = pk2(b[2], b[3]); return w; }
        if (key < 160) return *(const u32x4*)(U + uoff(ROW_S + 16 * bidx + (key - 144), colbase + g * 64 + 8 * ch));
        return z;
    }
}
DI void attn_item(const Params& p, LAS unsigned char* lds, int kind, int bidx, int g, int dry) {
    int tid_ = threadIdx.x; asm volatile("" : "+v"(tid_)); const int tid = tid_, lane = tid & 63, wave = tid >> 6, lr = lane & 15, q = lane >> 4;
    bf16_t* U = (bf16_t*)(p.ws + WS_U);
    LAS bf16_t* KAl = (LAS bf16_t*)lds; LAS bf16_t* VAl = (LAS bf16_t*)(lds + 32256);
    const int hq = 8 * g + wave; const float sink = p.sinks[hq] * 1.4426950408889634f;
    const int npair = kind == 0 ? 2 : 1, qrow0 = kind == 0 ? 64 * bidx : ROW_S + 16 * bidx;
    const int hi_t = kind == 0 ? 13 : 10; const int lo_t = kind == 0 ? 1 + (bidx < 2 ? 4 * (2 - bidx) : 0) : 1;
    u32x4 kreg[4], vreg[4];
#pragma unroll
    for (int i = 0; i < 4; ++i) { const int ci = tid + 512 * i; kreg[i] = (u32x4){0u, 0u, 0u, 0u}; vreg[i] = kreg[i];
        if (ci < 224 * 8) { kreg[i] = attn_fetch8(p, U, kind, bidx, g, ci >> 3, ci & 7, KA, p.ck); vreg[i] = attn_fetch8(p, U, kind, bidx, g, ci >> 3, ci & 7, VA, p.cv); } }
#pragma unroll
    for (int i = 0; i < 4; ++i) { const int ci = tid + 512 * i; if (ci < 224 * 8) { *(LAS u32x4*)(KAl + (ci >> 3) * 72 + 8 * (ci & 7)) = kreg[i]; *(LAS u32x4*)(VAl + (ci >> 3) * 72 + 8 * (ci & 7)) = vreg[i]; } }
    __syncthreads();
    for (int pr = 0; pr < npair; ++pr) {
        const int tA = 2 * pr, tB = kind == 0 ? 2 * pr + 1 : 0;
        const size_t rowA = (size_t)(qrow0 + 16 * tA + lr) * 256 + (size_t)(hq >> 2) * UT + (hq & 3) * 64, rowB = (size_t)(qrow0 + 16 * tB + lr) * 256 + (size_t)(hq >> 2) * UT + (hq & 3) * 64;
        constexpr size_t ZOFF = (size_t)(ZA >> 8) * UT;
        bf16x8 qa[2], qb[2]; u32x2 za[4], zb[4];
#pragma unroll
        for (int ks = 0; ks < 2; ++ks) { qa[ks] = *(const bf16x8*)(U + rowA + 32 * ks + 8 * q); qb[ks] = *(const bf16x8*)(U + rowB + 32 * ks + 8 * q); }
#pragma unroll
        for (int dt = 0; dt < 4; ++dt) { za[dt] = *(const u32x2*)(U + rowA + ZOFF + 16 * dt + 4 * q); zb[dt] = *(const u32x2*)(U + rowB + ZOFF + 16 * dt + 4 * q); }
        f32x4 accA[14], accB[14];
        float mxA = -1e30f, mxB = -1e30f;
#pragma unroll
        for (int kt = 0; kt < 14; ++kt) {
            if (kt == 0 || (kt >= lo_t && kt < hi_t)) {
                accA[kt] = (f32x4){0.f, 0.f, 0.f, 0.f}; accB[kt] = accA[kt];
#pragma unroll
                for (int ks = 0; ks < 2; ++ks) { const bf16x8 a = *(const LAS bf16x8*)(KAl + (16 * kt + lr) * 72 + 32 * ks + 8 * q); accA[kt] = MFMA16(a, qa[ks], accA[kt]); accB[kt] = MFMA16(a, qb[ks], accB[kt]); }
                mxA = fmaxf(mxA, fmaxf(fmaxf(accA[kt][0], accA[kt][1]), fmaxf(accA[kt][2], accA[kt][3])));
                mxB = fmaxf(mxB, fmaxf(fmaxf(accB[kt][0], accB[kt][1]), fmaxf(accB[kt][2], accB[kt][3])));
            } else { accA[kt] = (f32x4){-1e30f, -1e30f, -1e30f, -1e30f}; accB[kt] = accA[kt]; }
        }
        mxA = fmaxf(mxA, __shfl_xor(mxA, 16)); mxA = fmaxf(mxA, __shfl_xor(mxA, 32)); mxB = fmaxf(mxB, __shfl_xor(mxB, 16)); mxB = fmaxf(mxB, __shfl_xor(mxB, 32));
        const float MA = fmaxf(mxA, sink), MB = fmaxf(mxB, sink); float sumA = 0.f, sumB = 0.f;
#pragma unroll
        for (int kt = 0; kt < 14; ++kt)
#pragma unroll
            for (int j = 0; j < 4; ++j) { const float ea = __builtin_amdgcn_exp2f(accA[kt][j] - MA), eb = __builtin_amdgcn_exp2f(accB[kt][j] - MB); accA[kt][j] = ea; accB[kt][j] = eb; sumA += ea; sumB += eb; }
        sumA += __shfl_xor(sumA, 16); sumA += __shfl_xor(sumA, 32); sumB += __shfl_xor(sumB, 16); sumB += __shfl_xor(sumB, 32);
        const float invA = 1.0f / (sumA + __builtin_amdgcn_exp2f(sink - MA)), invB = 1.0f / (sumB + __builtin_amdgcn_exp2f(sink - MB));
        bf16x8 pA[7], pB[7];
#pragma unroll
        for (int u = 0; u < 7; ++u) { u32x4 w; w.x = pk2(accA[2 * u][0], accA[2 * u][1]); w.y = pk2(accA[2 * u][2], accA[2 * u][3]);
            w.z = pk2(accA[2 * u + 1][0], accA[2 * u + 1][1]); w.w = pk2(accA[2 * u + 1][2], accA[2 * u + 1][3]); pA[u] = __builtin_bit_cast(bf16x8, w);
            w.x = pk2(accB[2 * u][0], accB[2 * u][1]); w.y = pk2(accB[2 * u][2], accB[2 * u][3]);
            w.z = pk2(accB[2 * u + 1][0], accB[2 * u + 1][1]); w.w = pk2(accB[2 * u + 1][2], accB[2 * u + 1][3]); pB[u] = __builtin_bit_cast(bf16x8, w); }
        f32x4 oA[4], oB[4];
#pragma unroll
        for (int dt = 0; dt < 4; ++dt) { oA[dt] = (f32x4){0.f, 0.f, 0.f, 0.f}; oB[dt] = oA[dt];
#pragma unroll
            for (int u = 0; u < 7; ++u) { const LAS bf16_t* vp = VAl + (32 * u + 4 * q + (lr >> 2)) * 72 + 16 * dt + 4 * (lr & 3);
                const s16x4 lo = tr_read(vp), hi = tr_read(vp + 16 * 72);
                const bf16x8 a = __builtin_shufflevector(lo, hi, 0, 1, 2, 3, 4, 5, 6, 7); oA[dt] = MFMA16(a, pA[u], oA[dt]); oB[dt] = MFMA16(a, pB[u], oB[dt]); } }
#pragma unroll
        for (int dt = 0; dt < 4; ++dt) { const int col = hq * 64 + 16 * dt + 4 * q;
            { const u32x2 z = za[dt]; u32x2 w; w.x = pk2(oA[dt][0] * invA * siluf_(bflo(z.x)), oA[dt][1] * invA * siluf_(bfhi(z.x))); w.y = pk2(oA[dt][2] * invA * siluf_(bflo(z.y)), oA[dt][3] * invA * siluf_(bfhi(z.y)));
              if (dry) *(u32x2*)((bf16_t*)(p.ws + WS_XN) + (size_t)(qrow0 + 16 * tA + lr) * DM + col) = w; else *(u32x2*)(U + rowA + 16 * dt + 4 * q) = w; }
            if (kind == 0) { const u32x2 z = zb[dt]; u32x2 w; w.x = pk2(oB[dt][0] * invB * siluf_(bflo(z.x)), oB[dt][1] * invB * siluf_(bfhi(z.x))); w.y = pk2(oB[dt][2] * invB * siluf_(bflo(z.y)), oB[dt][3] * invB * siluf_(bfhi(z.y)));
              if (dry) *(u32x2*)((bf16_t*)(p.ws + WS_XN) + (size_t)(qrow0 + 16 * tB + lr) * DM + col) = w; else *(u32x2*)(U + rowB + 16 * dt + 4 * q) = w; } }
    }
    __syncthreads();
}

constexpr int ML_T2 = 69632, ML_SC = 106496;
constexpr int PV = 272, PKS = 144;
DI void mlstm_v_load(const bf16_t* U, int R0, int h, int tid, u32x4 (&v)[8]) {
#pragma unroll
    for (int it = 0; it < 8; ++it) { const int ci = tid + 512 * it, row = ci >> 5, ch = ci & 31; v[it] = *(const u32x4*)(U + uoff(R0 + row, VM + h * 256 + 8 * ch)); }
}
DI void mlstm_v_store(LAS unsigned char* lds, int tid, const u32x4 (&v)[8]) {
    LAS bf16_t* Vl = (LAS bf16_t*)lds;
#pragma unroll
    for (int it = 0; it < 8; ++it) { const int ci = tid + 512 * it, row = ci >> 5, ch = ci & 31; *(LAS u32x4*)(Vl + row * PV + 8 * ch) = v[it]; }
}

DI void mlstm_sum_item(const Params& p, LAS unsigned char* lds, int h, int j) {
    int tid_ = threadIdx.x; asm volatile("" : "+v"(tid_)); const int tid = tid_, lane = tid & 63, wave = tid >> 6, lr = lane & 15, q = lane >> 4;
    const bf16_t* U = (const bf16_t*)(p.ws + WS_U); const float* GATE = (const float*)(p.ws + WS_GATE);
    LAS float* wS = (LAS float*)(lds + ML_SC);
    const int R0 = 128 * j;
    u32x4 vreg[8], kreg[4];
    mlstm_v_load(U, R0, h, tid, vreg);
#pragma unroll
    for (int it = 0; it < 4; ++it) { const int ci = tid + 512 * it, row = ci >> 4, ch = ci & 15; kreg[it] = *(const u32x4*)(U + uoff(R0 + row, KM + h * 128 + 8 * ch)); }
    if (wave == 0) {
        const float bi = p.bi[h], bfb = p.bf[h];
        const float gi0 = GATE[(size_t)(R0 + lane) * 16 + h] + bi, gi1 = GATE[(size_t)(R0 + 64 + lane) * 16 + h] + bi;
        const float lf0 = logsigmoidf_(GATE[(size_t)(R0 + lane) * 16 + 8 + h] + bfb), lf1 = logsigmoidf_(GATE[(size_t)(R0 + 64 + lane) * 16 + 8 + h] + bfb);
        const float c0 = scan_add(lf0, lane); const float tot0 = __shfl(c0, 63); const float c1 = scan_add(lf1, lane) + tot0; const float blast = __shfl(c1, 63);
        const float x0 = blast - c0 + gi0, x1 = blast - c1 + gi1; const float ml = wmax(fmaxf(x0, x1));
        wS[lane] = __expf(x0 - ml); wS[64 + lane] = __expf(x1 - ml);
        if (lane == 0) { ((float*)(p.ws + WS_BS))[h * NCH + j] = blast; ((float*)(p.ws + WS_ML))[h * NCH + j] = ml; }
    }
    mlstm_v_store(lds, tid, vreg);
    __syncthreads();
    {
        LAS bf16_t* Kl = (LAS bf16_t*)(lds + ML_T2);
#pragma unroll
        for (int it = 0; it < 4; ++it) { const int ci = tid + 512 * it, row = ci >> 4, ch = ci & 15; const u32x4 a = kreg[it]; const float w = wS[row];
            u32x4 o; o.x = pk2(bflo(a.x) * w, bfhi(a.x) * w); o.y = pk2(bflo(a.y) * w, bfhi(a.y) * w); o.z = pk2(bflo(a.z) * w, bfhi(a.z) * w); o.w = pk2(bflo(a.w) * w, bfhi(a.w) * w);
            *(LAS u32x4*)(Kl + row * PKS + 8 * ch) = o; }
    }
    __syncthreads();
    const LAS bf16_t* Vl = (const LAS bf16_t*)lds; const LAS bf16_t* Kl = (const LAS bf16_t*)(lds + ML_T2);
    {
        LAS float* npart = (LAS float*)(lds + ML_SC + 512);
        const int d = tid & 127, part = tid >> 7; float sm = 0.f;
#pragma unroll 8
        for (int r = 0; r < 32; ++r) sm += bf2f(Kl[(32 * part + r) * PKS + d]);
        npart[part * 128 + d] = sm;
    }
    f32x4 acc[2][8];
#pragma unroll
    for (int i = 0; i < 2; ++i)
#pragma unroll
        for (int dt = 0; dt < 8; ++dt) acc[i][dt] = (f32x4){0.f, 0.f, 0.f, 0.f};
#pragma unroll
    for (int ks = 0; ks < 4; ++ks) {
        bf16x8 a[2];
#pragma unroll
        for (int i = 0; i < 2; ++i) { const LAS bf16_t* vp = Vl + (32 * ks + 8 * q + (lr >> 2)) * PV + 16 * (2 * wave + i) + 4 * (lr & 3);
            const s16x4 lo = tr_read(vp), hi = tr_read(vp + 4 * PV); a[i] = __builtin_shufflevector(lo, hi, 0, 1, 2, 3, 4, 5, 6, 7); }
#pragma unroll
        for (int dt = 0; dt < 8; ++dt) { const LAS bf16_t* kp = Kl + (32 * ks + 8 * q + (lr >> 2)) * PKS + 16 * dt + 4 * (lr & 3);
            const s16x4 lo = tr_read(kp), hi = tr_read(kp + 4 * PKS); const bf16x8 b = __builtin_shufflevector(lo, hi, 0, 1, 2, 3, 4, 5, 6, 7);
#pragma unroll
            for (int i = 0; i < 2; ++i) acc[i][dt] = MFMA16(b, a[i], acc[i][dt]); }
    }
    bf16_t* UP = (bf16_t*)(p.ws + WS_UP) + (size_t)(h * NCH + j) * 256 * 128;
#pragma unroll
    for (int i = 0; i < 2; ++i)
#pragma unroll
        for (int dt = 0; dt < 8; ++dt) { u32x2 w; w.x = f2bf_c(acc[i][dt][0]) | (f2bf_c(acc[i][dt][1]) << 16); w.y = f2bf_c(acc[i][dt][2]) | (f2bf_c(acc[i][dt][3]) << 16);
            *(u32x2*)(UP + (size_t)(16 * (2 * wave + i) + lr) * 128 + 16 * dt + 4 * q) = w; }
    __syncthreads();
    if (tid < 128) { const LAS float* npart = (const LAS float*)(lds + ML_SC + 512);
        ((float*)(p.ws + WS_NP))[(size_t)(h * NCH + j) * 128 + tid] = (npart[tid] + npart[128 + tid]) + (npart[256 + tid] + npart[384 + tid]); }
    __syncthreads();
}

DI void mlstm_small_item(const Params& p, LAS unsigned char* lds, int b, int h, int dry) {
    int tid_ = threadIdx.x; asm volatile("" : "+v"(tid_)); const int tid = tid_, lane = tid & 63, wave = tid >> 6;
    bf16_t* U = (bf16_t*)(p.ws + WS_U); const float* GATE = (const float*)(p.ws + WS_GATE);
    const bool meta = (b == 16); const int R0 = meta ? ROW_M : ROW_S + 16 * b;
    LAS float* qT = (LAS float*)lds; LAS float* kwT = (LAS float*)(lds + 8192); LAS float* kS = (LAS float*)(lds + 16384);
    LAS float* Wm = (LAS float*)(lds + 24832); LAS float* sc = (LAS float*)(lds + 25856); LAS float* red = (LAS float*)(lds + 26624);
    LAS float* am = sc, *cm = sc + 16, *bb = sc + 32, *wsS = sc + 48, *misc = sc + 64, *qnS = sc + 80;
    const float* Cin = p.sC + (size_t)(b * 8 + h) * 128 * 256; const float* nin = p.sn + (size_t)(b * 8 + h) * 128;
    float* Cout = meta ? (float*)(p.ws + WS_C0) + (size_t)h * 128 * 256 : p.out + O_CS + (size_t)(b * 8 + h) * 128 * 256;
    float* nout = meta ? (float*)(p.ws + WS_N0) + h * 128 : p.out + O_NS + (size_t)(b * 8 + h) * 128;
#pragma unroll
    for (int i = 0; i < 4; ++i) { const int idx = tid + 512 * i, t = idx >> 7, d = idx & 127;
        qT[d * 16 + t] = bf2f(U[uoff(R0 + t, QM + h * 128 + d)]); kS[t * 132 + d] = bf2f(U[uoff(R0 + t, KM + h * 128 + d)]); }
    if (tid >= 128 && tid < 256) red[tid - 128] = meta ? 0.f : nin[tid - 128];
    if (wave == 0) {
        const bool act = lane < 16; const int tl = act ? lane : 15;
        const float gi = GATE[(size_t)(R0 + tl) * 16 + h] + p.bi[h];
        const float lf = act ? logsigmoidf_(GATE[(size_t)(R0 + tl) * 16 + 8 + h] + p.bf[h]) : 0.f;
        const float c = scan_add(lf, lane); const float a = act ? gi - c : -3e38f; const float pm = scan_max(a, lane);
        const float mprev = meta ? 0.f : p.sm[b * 8 + h]; const float cmv = fmaxf(mprev, pm);
        const float b15 = __shfl(c, 15), cm15 = __shfl(cmv, 15); const float mnew = b15 + cm15;
        if (act) { am[lane] = a; cm[lane] = cmv; bb[lane] = c; wsS[lane] = __expf(b15 + a - mnew); }
        if (lane == 0) { misc[0] = __expf(b15 + mprev - mnew); misc[1] = mnew; misc[2] = mprev;
            if (meta) ((float*)(p.ws + WS_M0))[h] = mnew; else p.out[O_MS + b * 8 + h] = mnew; }
    }
    __syncthreads();
#pragma unroll
    for (int i = 0; i < 4; ++i) { const int idx = tid + 512 * i, s = idx >> 7, d = idx & 127; kwT[d * 16 + s] = kS[s * 132 + d] * wsS[s]; }
    if (tid < 256) { const int t = tid >> 4, s = tid & 15; float dot = 0.f;
        for (int d = 0; d < 128; ++d) dot += qT[d * 16 + t] * kS[s * 132 + d];
        Wm[t * 16 + s] = (s <= t) ? dot * __expf(am[s] - cm[t]) : 0.f;
    } else { const int t = (tid - 256) >> 4, part = tid & 15; float dot = 0.f;
#pragma unroll
        for (int i = 0; i < 8; ++i) dot += qT[(8 * part + i) * 16 + t] * red[8 * part + i];
        dot += __shfl_xor(dot, 1); dot += __shfl_xor(dot, 2); dot += __shfl_xor(dot, 4); dot += __shfl_xor(dot, 8);
        if (part == 0) qnS[t] = dot; }
    __syncthreads();
    const int e0 = tid & 127, dq = tid >> 7;
    float v0[16], v1[16];
#pragma unroll
    for (int s = 0; s < 16; ++s) { v0[s] = bf2f(U[uoff(R0 + s, VM + h * 256 + e0)]); v1[s] = bf2f(U[uoff(R0 + s, VM + h * 256 + e0 + 128)]); }
    float acc0[16], acc1[16];
#pragma unroll
    for (int t = 0; t < 16; ++t) { acc0[t] = 0.f; acc1[t] = 0.f; }
    const float alast = misc[0], mprev = misc[2];
    for (int d0 = dq * 32; d0 < dq * 32 + 32; d0 += 16) {
        float cb0[16], cb1[16];
#pragma unroll
        for (int dd = 0; dd < 16; ++dd) { cb0[dd] = meta ? 0.f : Cin[(size_t)(d0 + dd) * 256 + e0]; cb1[dd] = meta ? 0.f : Cin[(size_t)(d0 + dd) * 256 + e0 + 128]; }
#pragma unroll
        for (int dd = 0; dd < 16; ++dd) { const int d = d0 + dd; const float c0 = cb0[dd], c1 = cb1[dd];
            float cn0 = alast * c0, cn1 = alast * c1;
#pragma unroll
            for (int i = 0; i < 4; ++i) { const f32x4 q4 = *(const LAS f32x4*)(qT + d * 16 + 4 * i), k4 = *(const LAS f32x4*)(kwT + d * 16 + 4 * i);
#pragma unroll
                for (int jj = 0; jj < 4; ++jj) { acc0[4 * i + jj] += q4[jj] * c0; acc1[4 * i + jj] += q4[jj] * c1; cn0 += k4[jj] * v0[4 * i + jj]; cn1 += k4[jj] * v1[4 * i + jj]; } }
            Cout[(size_t)d * 256 + e0] = cn0; Cout[(size_t)d * 256 + e0 + 128] = cn1; }
    }
#pragma unroll
    for (int t = 0; t < 16; ++t) { red[(dq * 16 + t) * 256 + e0] = acc0[t]; red[(dq * 16 + t) * 256 + e0 + 128] = acc1[t]; }
    if (tid < 128) { float nn = alast * (meta ? 0.f : nin[tid]);
#pragma unroll
        for (int s = 0; s < 16; ++s) nn += kwT[tid * 16 + s];
        nout[tid] = nn; }
    __syncthreads();
    if (!meta) {
#pragma unroll
        for (int tl = 0; tl < 4; ++tl) { const int t = dq * 4 + tl; const float sc_t = __expf(mprev - cm[t]); const float mt = bb[t] + cm[t];
            float den = sc_t * qnS[t];
            float num0 = sc_t * ((red[t * 256 + e0] + red[(16 + t) * 256 + e0]) + (red[(32 + t) * 256 + e0] + red[(48 + t) * 256 + e0]));
            float num1 = sc_t * ((red[t * 256 + e0 + 128] + red[(16 + t) * 256 + e0 + 128]) + (red[(32 + t) * 256 + e0 + 128] + red[(48 + t) * 256 + e0 + 128]));
#pragma unroll
            for (int s = 0; s < 16; ++s) { const float w = Wm[t * 16 + s]; num0 += w * v0[s]; num1 += w * v1[s]; den += w; }
            const float inv = 1.0f / fmaxf(fabsf(den), __expf(-mt));
            red[t * 256 + e0] = num0 * inv; red[t * 256 + e0 + 128] = num1 * inv; }
    }
    __syncthreads();
    if (!meta) {
#pragma unroll
        for (int r = 0; r < 2; ++r) { const int t = 2 * wave + r; float hv[4]; float ss = 0.f;
#pragma unroll
            for (int i = 0; i < 4; ++i) { hv[i] = red[t * 256 + lane + 64 * i]; ss += hv[i] * hv[i]; }
            const float rstd = rsqrtf(wsum(ss) * (1.f / 256.f) + EPS);
            float ov[4], zv[4], gv[4];
#pragma unroll
            for (int i = 0; i < 4; ++i) { const int ee = lane + 64 * i; const size_t ro = (size_t)(R0 + t) * 256 + (size_t)h * UT + ee;
                ov[i] = bf2f(U[ro + (size_t)(OM >> 8) * UT]); zv[i] = bf2f(U[ro + (size_t)(ZM >> 8) * UT]); gv[i] = p.gmh[h * 256 + ee]; }
#pragma unroll
            for (int i = 0; i < 4; ++i) { const int ee = lane + 64 * i; const size_t ro = (size_t)(R0 + t) * 256 + (size_t)h * UT + ee;
                const float val = hv[i] * rstd * gv[i] * sigmoidf_(ov[i]) * siluf_(zv[i]);
                if (!dry) U[ro + (size_t)(OM >> 8) * UT] = (bf16_t)(pk2(val, 0.f) & 0xffffu); } }
    }
    __syncthreads();
}

DI void mlstm_scan(const Params& p, LAS unsigned char* lds) {
    const float* BS = (const float*)(p.ws + WS_BS); const float* MLv = (const float*)(p.ws + WS_ML); float* MS = (float*)(p.ws + WS_MS);
    const float* NPv = (const float*)(p.ws + WS_NP); float* NS = (float*)(p.ws + WS_NS);
    const float* C0 = (const float*)(p.ws + WS_C0); const float* N0 = (const float*)(p.ws + WS_N0); const float* M0 = (const float*)(p.ws + WS_M0);
    LAS float* tb = (LAS float*)lds, *tm = tb + 64, *ca = tb + 128, *cb = tb + 192, *cm = tb + 256;
    const int tid = threadIdx.x;
    for (int gid0 = blockIdx.x * 512; gid0 < 8 * 256 * 64; gid0 += gridDim.x * 512) {
        const int gid = gid0 + tid, h = gid0 >> 14, e = (gid >> 6) & 255, d = 2 * (gid & 63);
        const bf16_t* UP = (const bf16_t*)(p.ws + WS_UP) + (size_t)h * NCH * 256 * 128 + (size_t)e * 128 + d;
        unsigned u[64];
#pragma unroll
        for (int i = 0; i < 64; ++i) u[i] = *(const unsigned*)(UP + (size_t)i * 256 * 128);
        float cx = C0[((size_t)h * 128 + d) * 256 + e], cy = C0[((size_t)h * 128 + d + 1) * 256 + e];
        __syncthreads();
        if (tid < 64) { tb[tid] = BS[h * NCH + tid]; tm[tid] = MLv[h * NCH + tid]; }
        __syncthreads();
        if (tid == 0) { float m = M0[h];
            for (int k = 0; k < NCH; ++k) { const float bs = tb[k], ml = tm[k]; const float mn = fmaxf(bs + m, ml); ca[k] = __expf(bs + m - mn); cb[k] = __expf(ml - mn); cm[k] = m; m = mn; }
            cm[64] = m; }
        __syncthreads();
        unsigned* CS = (unsigned*)((bf16_t*)(p.ws + WS_CST) + (size_t)h * NCH * 256 * 128 + (size_t)e * 128 + d);
#pragma unroll
        for (int k = 0; k < NCH; ++k) { CS[(size_t)k * 256 * 64] = pk2(cx, cy); const float a = ca[k], b = cb[k]; cx = a * cx + b * bflo(u[k]); cy = a * cy + b * bfhi(u[k]); }
        p.out[O_CP + ((size_t)h * 128 + d) * 256 + e] = cx; p.out[O_CP + ((size_t)h * 128 + d + 1) * 256 + e] = cy;
        if ((gid0 & 16383) == 0) {
            if (tid < 128) { float nv[64];
#pragma unroll
                for (int k = 0; k < 64; ++k) nv[k] = NPv[(size_t)(h * NCH + k) * 128 + tid];
                float n = N0[h * 128 + tid];
#pragma unroll
                for (int k = 0; k < 64; ++k) { NS[(size_t)(h * NCH + k) * 128 + tid] = n; n = ca[k] * n + cb[k] * nv[k]; }
                p.out[O_NP + h * 128 + tid] = n; }
            else if (tid < 192) { MS[h * NCH + (tid - 128)] = cm[tid - 128]; if (tid == 128) p.out[O_MP + h] = cm[64]; }
        }
    }
    __syncthreads();
}

DI void mlstm_sw_tile(const LAS bf16_t* KN, const LAS float* aS, const bf16x8 (&qf)[4], int tT, int t, float cmt, int lr, int q, bf16x8 (&wf)[4], float& dsum) {
    dsum = 0.f;
#pragma unroll
    for (int u = 0; u < 4; ++u) {
        u32x4 w = (u32x4){0u, 0u, 0u, 0u};
#pragma unroll
        for (int hh = 0; hh < 2; ++hh) { const int st = 2 * u + hh;
            if (st <= tT) {
                f32x4 s4 = (f32x4){0.f, 0.f, 0.f, 0.f};
#pragma unroll
                for (int ks = 0; ks < 4; ++ks) { const bf16x8 a = *(const LAS bf16x8*)(KN + (16 * st + lr) * 136 + 32 * ks + 8 * q); s4 = MFMA16(a, qf[ks], s4); }
                float wv[4];
#pragma unroll
                for (int jj = 0; jj < 4; ++jj) { const int sx = 16 * st + 4 * q + jj; const float wg = (sx <= t) ? __expf(aS[sx] - cmt) : 0.f; wv[jj] = s4[jj] * wg; dsum += wv[jj]; }
                if (hh == 0) { w.x = pk2(wv[0], wv[1]); w.y = pk2(wv[2], wv[3]); } else { w.z = pk2(wv[0], wv[1]); w.w = pk2(wv[2], wv[3]); }
            } }
        wf[u] = __builtin_bit_cast(bf16x8, w);
    }
}
DI void mlstm_out_item(const Params& p, LAS unsigned char* lds, int h, int j, int dry) {
    int tid_ = threadIdx.x; asm volatile("" : "+v"(tid_)); const int tid = tid_, lane = tid & 63, wave = __builtin_amdgcn_readfirstlane(tid >> 6), lr = lane & 15, q = lane >> 4;
    const int g = wave >> 2, w = wave & 3, tA = w, tB = 7 - w;
    bf16_t* U = (bf16_t*)(p.ws + WS_U); const float* GATE = (const float*)(p.ws + WS_GATE);
    LAS float* aS = (LAS float*)(lds + ML_SC), *cmS = aS + 128, *bS = aS + 256, *nK = aS + 384, *ssx = aS + 512;
    const int R0 = 128 * j; const float mk = ((const float*)(p.ws + WS_MS))[h * NCH + j];
    u32x4 vreg[8], kn[4];
    mlstm_v_load(U, R0, h, tid, vreg);
#pragma unroll
    for (int it = 0; it < 4; ++it) { const int ci = tid + 512 * it, row = ci >> 4, ch = ci & 15; kn[it] = *(const u32x4*)(U + uoff(R0 + row, KM + h * 128 + 8 * ch)); }
    const int tokA = 16 * tA + lr, tokB = 16 * tB + lr;
    const size_t rowA = (size_t)(R0 + tokA) * 256, rowB = (size_t)(R0 + tokB) * 256;
    const size_t qoff = (size_t)((QM >> 8) + (h >> 1)) * UT + (h & 1) * 128 + 8 * q;
    bf16x8 qfA[4], qfB[4];
#pragma unroll
    for (int ks = 0; ks < 4; ++ks) { qfA[ks] = *(const bf16x8*)(U + rowA + qoff + 32 * ks); qfB[ks] = *(const bf16x8*)(U + rowB + qoff + 32 * ks); }
    if (wave == 0) {
        const float bi = p.bi[h], bfb = p.bf[h];
        const float gi0 = GATE[(size_t)(R0 + lane) * 16 + h] + bi, gi1 = GATE[(size_t)(R0 + 64 + lane) * 16 + h] + bi;
        const float lf0 = logsigmoidf_(GATE[(size_t)(R0 + lane) * 16 + 8 + h] + bfb), lf1 = logsigmoidf_(GATE[(size_t)(R0 + 64 + lane) * 16 + 8 + h] + bfb);
        const float c0 = scan_add(lf0, lane); const float tot0 = __shfl(c0, 63); const float c1 = scan_add(lf1, lane) + tot0;
        const float a0 = gi0 - c0, a1 = gi1 - c1;
        const float p0 = scan_max(a0, lane); const float t0 = __shfl(p0, 63); const float p1 = fmaxf(scan_max(a1, lane), t0);
        aS[lane] = a0; aS[64 + lane] = a1; cmS[lane] = fmaxf(mk, p0); cmS[64 + lane] = fmaxf(mk, p1); bS[lane] = c0; bS[64 + lane] = c1;
    } else if (wave < 3) { const int d = tid - 64; nK[d] = ((const float*)(p.ws + WS_NS))[(size_t)(h * NCH + j) * 128 + d]; }
    mlstm_v_store(lds, tid, vreg);
    {
        LAS bf16_t* KNw = (LAS bf16_t*)(lds + ML_T2);
#pragma unroll
        for (int it = 0; it < 4; ++it) { const int ci = tid + 512 * it, row = ci >> 4, ch = ci & 15; *(LAS u32x4*)(KNw + row * 136 + 8 * ch) = kn[it]; }
    }
    __syncthreads();
    const LAS bf16_t* VT = (const LAS bf16_t*)lds; const LAS bf16_t* KN = (const LAS bf16_t*)(lds + ML_T2);
    const float cmA = cmS[tokA], cmB = cmS[tokB];
    const float scaleA = __expf(mk - cmA), scaleB = __expf(mk - cmB), floA = __expf(-(bS[tokA] + cmA)), floB = __expf(-(bS[tokB] + cmB));
    float qnA = 0.f, qnB = 0.f;
#pragma unroll
    for (int ks = 0; ks < 4; ++ks)
#pragma unroll
        for (int i = 0; i < 8; ++i) { const float nv = nK[32 * ks + 8 * q + i]; qnA += bf2f((unsigned short)qfA[ks][i]) * nv; qnB += bf2f((unsigned short)qfB[ks][i]) * nv; }
    qnA += __shfl_xor(qnA, 16); qnA += __shfl_xor(qnA, 32); qnB += __shfl_xor(qnB, 16); qnB += __shfl_xor(qnB, 32);
    f32x4 accA[8], accB[8];
    const bf16_t* CS = (const bf16_t*)(p.ws + WS_CST) + (size_t)(h * NCH + j) * 256 * 128 + (size_t)(128 * g) * 128;
#pragma unroll
    for (int et = 0; et < 8; ++et) { accA[et] = (f32x4){0.f, 0.f, 0.f, 0.f}; accB[et] = accA[et]; }
#pragma unroll
    for (int ks = 0; ks < 4; ++ks) {
        bf16x8 ca[8];
#pragma unroll
        for (int et = 0; et < 8; ++et) ca[et] = *(const bf16x8*)(CS + (size_t)(16 * et + lr) * 128 + 32 * ks + 8 * q);
#pragma unroll
        for (int et = 0; et < 8; ++et) { accA[et] = MFMA16(ca[et], qfA[ks], accA[et]); accB[et] = MFMA16(ca[et], qfB[ks], accB[et]); }
    }
#pragma unroll
    for (int et = 0; et < 8; ++et) { accA[et] = accA[et] * scaleA; accB[et] = accB[et] * scaleB; }
    asm volatile("" ::: "memory");
    bf16x8 wfA[4], wfB[4]; float dsA, dsB;
    mlstm_sw_tile(KN, aS, qfA, tA, tokA, cmA, lr, q, wfA, dsA);
    mlstm_sw_tile(KN, aS, qfB, tB, tokB, cmB, lr, q, wfB, dsB);
#pragma unroll
    for (int u = 0; u < 4; ++u) {
        if (2 * u <= tB) {
#pragma unroll
            for (int et = 0; et < 8; ++et) { const LAS bf16_t* vp = VT + (32 * u + 4 * q + (lr >> 2)) * PV + 16 * (8 * g + et) + 4 * (lr & 3);
                const s16x4 lo = tr_read(vp), hi = tr_read(vp + 16 * PV); const bf16x8 vf = __builtin_shufflevector(lo, hi, 0, 1, 2, 3, 4, 5, 6, 7);
                accB[et] = MFMA16(vf, wfB[u], accB[et]);
                if (2 * u <= tA) accA[et] = MFMA16(vf, wfA[u], accA[et]); } }
    }
    asm volatile("" ::: "memory");
    dsA += __shfl_xor(dsA, 16); dsA += __shfl_xor(dsA, 32); dsB += __shfl_xor(dsB, 16); dsB += __shfl_xor(dsB, 32);
    const float invA = 1.0f / fmaxf(fabsf(scaleA * qnA + dsA), floA), invB = 1.0f / fmaxf(fabsf(scaleB * qnB + dsB), floB);
    float ssA = 0.f, ssB = 0.f;
#pragma unroll
    for (int et = 0; et < 8; ++et) { accA[et] = accA[et] * invA; accB[et] = accB[et] * invB;
        ssA += (accA[et][0] * accA[et][0] + accA[et][1] * accA[et][1]) + (accA[et][2] * accA[et][2] + accA[et][3] * accA[et][3]);
        ssB += (accB[et][0] * accB[et][0] + accB[et][1] * accB[et][1]) + (accB[et][2] * accB[et][2] + accB[et][3] * accB[et][3]); }
    ssA += __shfl_xor(ssA, 16); ssA += __shfl_xor(ssA, 32); ssB += __shfl_xor(ssB, 16); ssB += __shfl_xor(ssB, 32);
    if (q == 0) { ssx[((g * 4 + w) * 2 + 0) * 16 + lr] = ssA; ssx[((g * 4 + w) * 2 + 1) * 16 + lr] = ssB; }
    __syncthreads();
    const float rstdA = rsqrtf((ssA + ssx[(((g ^ 1) * 4 + w) * 2 + 0) * 16 + lr]) * (1.f / 256.f) + EPS);
    const float rstdB = rsqrtf((ssB + ssx[(((g ^ 1) * 4 + w) * 2 + 1) * 16 + lr]) * (1.f / 256.f) + EPS);
    const size_t ooff = (size_t)((OM >> 8) + h) * UT + 128 * g + 4 * q, zoff = (size_t)((ZM >> 8) + h) * UT + 128 * g + 4 * q;
#pragma unroll
    for (int T = 0; T < 2; ++T) {
        const size_t rowT = T ? rowB : rowA; const float rstd = T ? rstdB : rstdA; const int tok = T ? tokB : tokA;
        u32x2 ov[8], zv[8]; f32x4 gv[8];
#pragma unroll
        for (int et = 0; et < 8; ++et) { ov[et] = *(const u32x2*)(U + rowT + ooff + 16 * et); zv[et] = *(const u32x2*)(U + rowT + zoff + 16 * et); gv[et] = *(const f32x4*)(p.gmh + h * 256 + 128 * g + 16 * et + 4 * q); }
#pragma unroll
        for (int et = 0; et < 8; ++et) { const f32x4 a = T ? accB[et] : accA[et]; const u32x2 o = ov[et], z = zv[et]; const f32x4 gg = gv[et];
            u32x2 wv; wv.x = pk2(a[0] * rstd * gg[0] * sigmoidf_(bflo(o.x)) * siluf_(bflo(z.x)), a[1] * rstd * gg[1] * sigmoidf_(bfhi(o.x)) * siluf_(bfhi(z.x)));
            wv.y = pk2(a[2] * rstd * gg[2] * sigmoidf_(bflo(o.y)) * siluf_(bflo(z.y)), a[3] * rstd * gg[3] * sigmoidf_(bfhi(o.y)) * siluf_(bfhi(z.y)));
            if (dry) *(u32x2*)((bf16_t*)(p.ws + WS_XN) + (size_t)(R0 + tok) * DM + h * 256 + 128 * g + 16 * et + 4 * q) = wv; else *(u32x2*)(U + rowT + ooff + 16 * et) = wv; }
    }
    __syncthreads();
}

DI void skinny_core(f32x4 (&acc)[2][4], const bf16_t* A, size_t lda, size_t wstride, const bf16_t* Bt, int row0, int col0, int wave, int lr, int q) {
    const bf16_t* ap = A + (size_t)(row0 + lr) * lda + wstride * wave + 8 * q;
    const bf16_t* bp = Bt + (size_t)(col0 + lr) * 2048 + 256 * wave + 8 * q;
#pragma unroll 4
    for (int ks = 0; ks < 8; ++ks) {
        bf16x8 a[2], b[4];
#pragma unroll
        for (int rt = 0; rt < 2; ++rt) a[rt] = *(const bf16x8*)(ap + (size_t)rt * 16 * lda + 32 * ks);
#pragma unroll
        for (int ct = 0; ct < 4; ++ct) b[ct] = *(const bf16x8*)(bp + (size_t)ct * 16 * 2048 + 32 * ks);
#pragma unroll
        for (int rt = 0; rt < 2; ++rt)
#pragma unroll
            for (int ct = 0; ct < 4; ++ct) acc[rt][ct] = MFMA16(b[ct], a[rt], acc[rt][ct]);
    }
}
DI void skinny_put(LAS float* red, const f32x4 (&acc)[2][4], int slot, int lr, int q) {
#pragma unroll
    for (int rt = 0; rt < 2; ++rt)
#pragma unroll
        for (int ct = 0; ct < 4; ++ct) *(LAS f32x4*)(red + ((size_t)slot * 32 + 16 * rt + lr) * 64 + 16 * ct + 4 * q) = acc[rt][ct];
}
DI void skinny_merge(const Params& p, LAS unsigned char* lds) {
    const int tid = threadIdx.x, lane = tid & 63, wave = tid >> 6, lr = lane & 15, q = lane >> 4;
    const bf16_t* U = (const bf16_t*)(p.ws + WS_U); const bf16_t* WP = (const bf16_t*)(p.ws + WS_WP); bf16_t* MG = (bf16_t*)(p.ws + WS_XN);
    LAS float* red = (LAS float*)lds;
    for (int tile = blockIdx.x; tile < 256; tile += gridDim.x) {
        const int row0 = ROW_S + 32 * (tile >> 5), col0 = 64 * (tile & 31);
        f32x4 aa[2][4], am[2][4];
#pragma unroll
        for (int rt = 0; rt < 2; ++rt)
#pragma unroll
            for (int ct = 0; ct < 4; ++ct) { aa[rt][ct] = (f32x4){0.f, 0.f, 0.f, 0.f}; am[rt][ct] = (f32x4){0.f, 0.f, 0.f, 0.f}; }
        skinny_core(aa, U + (size_t)(QA >> 8) * UT, 256, UT, WP, row0, col0, wave, lr, q);
        skinny_core(am, U + (size_t)(OM >> 8) * UT, 256, UT, WP + (size_t)2048 * 2048, row0, col0, wave, lr, q);
        skinny_put(red, aa, wave * 2, lr, q); skinny_put(red, am, wave * 2 + 1, lr, q);
        __syncthreads();
        const int row = tid >> 4, c4 = (tid & 15) * 4;
        f32x4 ya = (f32x4){0.f, 0.f, 0.f, 0.f}, ym = ya;
#pragma unroll
        for (int w = 0; w < 8; ++w) { ya += *(const LAS f32x4*)(red + ((size_t)(2 * w) * 32 + row) * 64 + c4); ym += *(const LAS f32x4*)(red + ((size_t)(2 * w + 1) * 32 + row) * 64 + c4); }
        const size_t r = row0 + row; const int col = col0 + c4;
        const u32x2 ga = *(const u32x2*)(U + uoff((int)r, GA + col)), gm = *(const u32x2*)(U + uoff((int)r, GM + col));
        u32x2 w; w.x = pk2(sigmoidf_(bflo(ga.x)) * ya[0] + sigmoidf_(bflo(gm.x)) * ym[0], sigmoidf_(bfhi(ga.x)) * ya[1] + sigmoidf_(bfhi(gm.x)) * ym[1]);
        w.y = pk2(sigmoidf_(bflo(ga.y)) * ya[2] + sigmoidf_(bflo(gm.y)) * ym[2], sigmoidf_(bfhi(ga.y)) * ya[3] + sigmoidf_(bfhi(gm.y)) * ym[3]);
        *(u32x2*)(MG + r * DM + col) = w;
        __syncthreads();
    }
}
DI void skinny_out(const Params& p, LAS unsigned char* lds) {
    const int tid = threadIdx.x, lane = tid & 63, wave = tid >> 6, lr = lane & 15, q = lane >> 4;
    const bf16_t* MG = (const bf16_t*)(p.ws + WS_XN); const bf16_t* WO = (const bf16_t*)(p.ws + WS_WOUT); float* ssq = (float*)(p.ws + WS_SSQ);
    LAS float* red = (LAS float*)lds;
    for (int tile = blockIdx.x; tile < 256; tile += gridDim.x) {
        const int row0 = ROW_S + 32 * (tile >> 5), col0 = 64 * (tile & 31);
        f32x4 aa[2][4];
#pragma unroll
        for (int rt = 0; rt < 2; ++rt)
#pragma unroll
            for (int ct = 0; ct < 4; ++ct) aa[rt][ct] = (f32x4){0.f, 0.f, 0.f, 0.f};
        skinny_core(aa, MG, DM, 256, WO, row0, col0, wave, lr, q);
        skinny_put(red, aa, wave, lr, q);
        __syncthreads();
        const int row = tid >> 4, c4 = (tid & 15) * 4;
        f32x4 y = (f32x4){0.f, 0.f, 0.f, 0.f};
#pragma unroll
        for (int w = 0; w < 8; ++w) y += *(const LAS f32x4*)(red + ((size_t)w * 32 + row) * 64 + c4);
        const size_t r = row0 + row; const int col = col0 + c4;
        const f32x4 o = *(const f32x4*)(p.xs + (r - ROW_S) * DM + col) + y;
        { u32x2 w; w.x = pk2(o[0], o[1]); w.y = pk2(o[2], o[3]); *(u32x2*)((bf16_t*)(p.ws + WS_U) + uoff((int)r, col)) = w; }
        float ss = (o[0] * o[0] + o[1] * o[1]) + (o[2] * o[2] + o[3] * o[3]);
        ss += __shfl_xor(ss, 1); ss += __shfl_xor(ss, 2); ss += __shfl_xor(ss, 4); ss += __shfl_xor(ss, 8);
        if ((tid & 15) == 0) ssq[r * 32 + (tile & 31)] = ss;
        __syncthreads();
    }
}

DI void final_norm(const Params& p) {
    const int lane = threadIdx.x & 63, gw = blockIdx.x * 8 + (threadIdx.x >> 6), NGW = gridDim.x * 8;
    const float* ssq = (const float*)(p.ws + WS_SSQ); const bf16_t* X1 = (const bf16_t*)(p.ws + WS_U);
    for (int r = gw; r < MOUT; r += NGW) {
        u32x2 xv[8];
#pragma unroll
        for (int j = 0; j < 8; ++j) xv[j] = *(const u32x2*)(X1 + (size_t)j * UT + (size_t)r * 256 + 4 * lane);
        const float s = wsum(lane < 32 ? ssq[(size_t)r * 32 + lane] : 0.f);
        const float rstd = rsqrtf(s * (1.f / DM) + EPS);
        f32x4* o = (f32x4*)(p.out + (size_t)r * DM) + lane; const f32x4* g = (const f32x4*)p.gfinal + lane;
#pragma unroll
        for (int j = 0; j < 8; ++j) { const f32x4 gg = g[64 * j]; f32x4 v; v[0] = bflo(xv[j].x) * rstd * gg[0]; v[1] = bfhi(xv[j].x) * rstd * gg[1]; v[2] = bflo(xv[j].y) * rstd * gg[2]; v[3] = bfhi(xv[j].y) * rstd * gg[3]; o[64 * j] = v; }
    }
}

__global__ void __launch_bounds__(512, 2) mega(Params p) {
    extern __shared__ __attribute__((aligned(16))) unsigned char lds_raw[];
    LAS unsigned char* lds = (LAS unsigned char*)lds_raw;
    cg::grid_group grid = cg::this_grid();
    const int lo = p.ph_lo, hi = p.ph_hi;
#define IN(k) (lo <= (k) && (k) < hi)
#define STAMP(i) do { if (TPROBE >= 0 && blockIdx.x == 0 && threadIdx.x == 0) tsl[i] = __builtin_amdgcn_s_memrealtime(); } while (0)
#define SEAM(k) do { if (IN(k) && IN((k) + 1)) xcd_barrier(bar); STAMP((k) + 1); } while (0)
    volatile LAS unsigned long long* tsl = (volatile LAS unsigned long long*)(lds + 131072 + 1040);
    volatile LAS unsigned* bst = (volatile LAS unsigned*)(lds + 131072 + 1024);
    if (threadIdx.x < 2) bst[threadIdx.x] = 0u;
    __syncthreads();
    XcdBarrier bar = xcd_barrier_post((unsigned*)(p.ws + WS_BAR), bst);
    if (hi > 1000) grid.sync();
    bf16_t* U = (bf16_t*)(p.ws + WS_U);
    STAMP(0);
    if (IN(0)) for (int rep = 0; rep < REP0; ++rep) p0_prologue(p, lds);
    SEAM(0);
    if (IN(1)) for (int rep = 0; rep < REP1; ++rep) {
        pg8::Order S; S.init(MPAD / 256, NW / 256, gridDim.x, blockIdx.x, 0);
        S.A0 = S.A1 = (const char*)(p.ws + WS_XN); S.B0 = S.B1 = (const char*)(p.ws + WS_WIN); S.a_tstep = (size_t)256 * DM * 2; S.b_tstep = (size_t)256 * 2048 * 2;
        pg8::EpiU E{U, (float*)(p.ws + WS_GATE), p.out};
        pg8::gemm_phase<pg8::EpiU>(lds, 2048, DM, 512, S, E);
    }
    SEAM(1);
    if (IN(2)) {
        for (int rep = 0; rep < REP2; ++rep) { const int dry = rep + 1 < REP2;
        for (int it = blockIdx.x; it < 1224; it += gridDim.x) {
            if (it < 512) { if (!dry || (PSEL & 1)) attn_item(p, lds, 0, it >> 2, it & 3, dry); }
            else if (it < 576) { if (!dry || (PSEL & 1)) attn_item(p, lds, 1, (it - 512) >> 2, (it - 512) & 3, dry); }
            else if (it < 1088) { if (!dry || (PSEL & 2)) mlstm_sum_item(p, lds, (it - 576) & 7, (it - 576) >> 3); }
            else { if (!dry || (PSEL & 4)) mlstm_small_item(p, lds, (it - 1088) >> 3, (it - 1088) & 7, dry); }
        } }
    }
    SEAM(2);
    if (IN(3)) for (int rep = 0; rep < REP3; ++rep) mlstm_scan(p, lds);
    for (int rep = 0; rep < REPSYNC; ++rep) xcd_barrier(bar);
    SEAM(3);
    if (IN(4)) for (int rep = 0; rep < REP4; ++rep) { for (int it = blockIdx.x; it < 512; it += gridDim.x) mlstm_out_item(p, lds, it & 7, it >> 3, rep + 1 < REP4); }
    SEAM(4);
    if (IN(5)) for (int rep = 0; rep < REP56; ++rep) {
        pg8::Order S; S.init(ROW_S / 256, DM / 256, gridDim.x, blockIdx.x, 1);
        S.A0 = (const char*)(U + (size_t)(QA >> 8) * UT); S.A1 = (const char*)(U + (size_t)(OM >> 8) * UT); S.B0 = (const char*)(p.ws + WS_WP); S.B1 = S.B0 + (size_t)2048 * 2048 * 2;
        S.a_tstep = (size_t)256 * 256 * 2; S.b_tstep = (size_t)256 * 2048 * 2;
        pg8::EpiMerge E{U, (bf16_t*)(p.ws + WS_XN)};
        const bool skinny_first = (blockIdx.x >> 3) & 1;
        if (skinny_first) skinny_merge(p, lds);
        pg8::gemm_phase<pg8::EpiMerge>(lds, 2048, 256, UT * 2, S, E);
        if (!skinny_first) skinny_merge(p, lds);
    }
    SEAM(5);
    if (IN(6)) for (int rep = 0; rep < REP56; ++rep) {
        pg8::Order S; S.init(ROW_S / 256, DM / 256, gridDim.x, blockIdx.x, 0);
        S.A0 = S.A1 = (const char*)(p.ws + WS_XN); S.B0 = S.B1 = (const char*)(p.ws + WS_WOUT); S.a_tstep = (size_t)256 * DM * 2; S.b_tstep = (size_t)256 * 2048 * 2;
        pg8::EpiOut E{p.xp, p.xs, U, (float*)(p.ws + WS_SSQ)};
        const bool skinny_first = (blockIdx.x >> 3) & 1;
        if (skinny_first) skinny_out(p, lds);
        pg8::gemm_phase<pg8::EpiOut>(lds, 2048, DM, 512, S, E);
        if (!skinny_first) skinny_out(p, lds);
    }
    SEAM(6);
    if (IN(7)) final_norm(p);
    if (TPROBE >= 0 && blockIdx.x == 0 && threadIdx.x == 0) { const unsigned long long te = __builtin_amdgcn_s_memrealtime(); tsl[8] = te;
        const unsigned long long d = tsl[TPROBE + 1] - tsl[TPROBE]; while (__builtin_amdgcn_s_memrealtime() - te < 9ull * d) __builtin_amdgcn_s_sleep(8); }
#undef IN
#undef SEAM
}

extern "C" void kernel_launch(void* const* d_in, const int* in_sizes, int n_in, void* d_out, int out_size, void* d_ws, size_t ws_size, hipStream_t stream) {
    static int grid = 0;
    if (grid == 0) {
        if (n_in != 18 || out_size != 22889608 || ws_size < WS_END) { fprintf(stderr, "kernel_launch: unexpected shapes (n_in %d out %d ws %zu need %zu)\n", n_in, out_size, ws_size, (size_t)WS_END); grid = -1; return; }
        int dev = 0, cus = 0, per_cu = 0;
        hipGetDevice(&dev); hipDeviceGetAttribute(&cus, hipDeviceAttributeMultiprocessorCount, dev);
        if (hipFuncSetAttribute((const void*)mega, hipFuncAttributeMaxDynamicSharedMemorySize, LDS_BYTES) != hipSuccess) { fprintf(stderr, "kernel_launch: hipFuncSetAttribute failed\n"); grid = -1; return; }
        if (hipOccupancyMaxActiveBlocksPerMultiprocessor(&per_cu, (const void*)mega, 512, LDS_BYTES) != hipSuccess || per_cu < 1) { fprintf(stderr, "kernel_launch: occupancy query says %d\n", per_cu); (void)hipGetLastError(); }
        grid = cus > 0 ? cus : 256;
    }
    if (grid < 0) return;
    Params p{};
    p.xp = (const float*)d_in[0]; p.xs = (const float*)d_in[1]; p.ck = (const float*)d_in[2]; p.cv = (const float*)d_in[3];
    p.sC = (const float*)d_in[4]; p.sn = (const float*)d_in[5]; p.sm = (const float*)d_in[6]; p.meta = (const float*)d_in[7];
    p.gnorm = (const float*)d_in[8]; p.win = (const float*)d_in[9]; p.bi = (const float*)d_in[10]; p.bf = (const float*)d_in[11];
    p.sinks = (const float*)d_in[12]; p.gmh = (const float*)d_in[13]; p.wpa = (const float*)d_in[14]; p.wpm = (const float*)d_in[15];
    p.wout = (const float*)d_in[16]; p.gfinal = (const float*)d_in[17];
    p.out = (float*)d_out; p.ws = (unsigned char*)d_ws;
#if N_LAUNCH == 1
    p.ph_lo = 0; p.ph_hi = 8;
    if (hipMemsetAsync((char*)d_ws + WS_BAR, 0, 16384, stream) != hipSuccess) { fprintf(stderr, "kernel_launch: memset failed\n"); return; }
    void* args[] = {&p};
    hipError_t e = hipLaunchCooperativeKernel((const void*)mega, dim3(grid), dim3(512), args, LDS_BYTES, stream);
    if (e != hipSuccess) fprintf(stderr, "cooperative launch failed: %s (grid %d)\n", hipGetErrorString(e), grid);
#else
    for (int ph = 0; ph < 8; ++ph) { p.ph_lo = ph; p.ph_hi = ph + 1; hipLaunchKernelGGL(mega, dim3(grid), dim3(512), LDS_BYTES, stream, p); }
#endif
}
```

```cpp
#include <hip/hip_runtime.h>
#include <hip/hip_cooperative_groups.h>
#include <cstdio>
#include <cstdint>
namespace cg = cooperative_groups;

#ifndef REP1
#define REP1 1
#endif
#ifndef REP3
#define REP3 1
#endif
#ifndef REP0
#define REP0 1
#endif
#ifndef REP2
#define REP2 1
#endif
#ifndef REP4
#define REP4 1
#endif
#ifndef PSEL
#define PSEL 7
#endif
#ifndef TPROBE
#define TPROBE -1
#endif
#ifndef REP56
#define REP56 1
#endif
#ifndef REPSYNC
#define REPSYNC 0
#endif
#ifndef N_LAUNCH
#define N_LAUNCH 1
#endif

#define LAS __attribute__((address_space(3)))
typedef unsigned short bf16_t;
typedef short bf16x8 __attribute__((ext_vector_type(8)));
typedef short s16x4 __attribute__((ext_vector_type(4)));
typedef float f32x4 __attribute__((ext_vector_type(4)));
typedef float f32x2 __attribute__((ext_vector_type(2)));
typedef unsigned u32x4 __attribute__((ext_vector_type(4)));
typedef unsigned u32x2 __attribute__((ext_vector_type(2)));
#define DI __device__ __forceinline__

constexpr int DM = 2048;
constexpr int ROW_S = 8192, ROW_M = 8448, MROWS = 8464, MPAD = 8704, MOUT = 8448;
constexpr int NU = 16896, NW = 17152;
constexpr size_t UT = (size_t)8704 * 256;
__device__ __forceinline__ size_t uoff(int row, int col) { return (size_t)(col >> 8) * UT + (size_t)row * 256 + (col & 255); }
constexpr int QA = 0, KA = 2048, VA = 2304, ZA = 2560, QM = 4608, KM = 5632, VM = 6656, OM = 8704, ZM = 10752, GA = 12800, GM = 14848;
constexpr int NCH = 64;
constexpr float EPS = 1e-6f;
constexpr size_t O_KP = 17301504, O_VP = 17334272, O_CP = 17367040, O_NP = 17629184, O_MP = 17630208,
                 O_KS = 17630216, O_VS = 18154504, O_CS = 18678792, O_NS = 22873096, O_MS = 22889480;
constexpr size_t WS_WIN = 4096;
constexpr size_t WS_WP = WS_WIN + (size_t)NW * 2048 * 2;
constexpr size_t WS_WOUT = WS_WP + (size_t)4096 * 2048 * 2;
constexpr size_t WS_XN = WS_WOUT + (size_t)2048 * 2048 * 2;
constexpr size_t WS_U = WS_XN + (size_t)MPAD * 2048 * 2;
constexpr size_t WS_GATE = WS_U + (size_t)MPAD * NU * 2;
constexpr size_t WS_UP = WS_GATE + (size_t)MPAD * 16 * 4;
constexpr size_t WS_CST = WS_UP + (size_t)8 * NCH * 256 * 128 * 4;
constexpr size_t WS_NP = WS_CST + (size_t)8 * NCH * 256 * 128 * 2;
constexpr size_t WS_NS = WS_NP + (size_t)8 * NCH * 128 * 4;
constexpr size_t WS_BS = WS_NS + (size_t)8 * NCH * 128 * 4;
constexpr size_t WS_ML = WS_BS + 4096;
constexpr size_t WS_MS = WS_ML + 4096;
constexpr size_t WS_C0 = WS_MS + 4096;
constexpr size_t WS_N0 = WS_C0 + (size_t)8 * 128 * 256 * 4;
constexpr size_t WS_M0 = WS_N0 + 4096;
constexpr size_t WS_SSQ = WS_M0 + 4096;
constexpr size_t WS_BAR = WS_SSQ + (size_t)MOUT * 32 * 4;
constexpr size_t WS_GS = WS_BAR + 16384;
constexpr size_t WS_END = WS_GS + (size_t)8 * NCH * 384 * 4;
constexpr int LDS_BYTES = 131072 + 2048;

struct Params {
    const float *xp, *xs, *ck, *cv, *sC, *sn, *sm, *meta, *gnorm, *win, *bi, *bf, *sinks, *gmh, *wpa, *wpm, *wout, *gfinal;
    float* out; unsigned char* ws; int ph_lo, ph_hi;
};

DI float bf2f(unsigned short b) { return __uint_as_float(((unsigned)b) << 16); }
DI float bflo(unsigned w) { return __uint_as_float(w << 16); }
DI float bfhi(unsigned w) { return __uint_as_float(w & 0xffff0000u); }
DI unsigned pk2(float lo, float hi) { unsigned r; asm volatile("v_cvt_pk_bf16_f32 %0, %1, %2\n\ts_nop 1" : "=v"(r) : "v"(lo), "v"(hi)); return r; }
DI unsigned f2bf_c(float f) { const unsigned u = __float_as_uint(f); return (u + 0x7fffu + ((u >> 16) & 1u)) >> 16; }
DI float sigmoidf_(float x) { return __builtin_amdgcn_rcpf(1.0f + __expf(-x)); }
DI float siluf_(float x) { return x * __builtin_amdgcn_rcpf(1.0f + __expf(-x)); }
DI float logsigmoidf_(float x) { return fminf(x, 0.f) - log1pf(__expf(-fabsf(x))); }
DI float wsum(float v) {
#pragma unroll
    for (int o = 1; o < 64; o <<= 1) v += __shfl_xor(v, o);
    return v;
}
DI float wmax(float v) {
#pragma unroll
    for (int o = 1; o < 64; o <<= 1) v = fmaxf(v, __shfl_xor(v, o));
    return v;
}
DI float scan_add(float v, int lane) {
#pragma unroll
    for (int o = 1; o < 64; o <<= 1) { float t = __shfl_up(v, o); if (lane >= o) v += t; }
    return v;
}
DI float scan_max(float v, int lane) {
#pragma unroll
    for (int o = 1; o < 64; o <<= 1) { float t = __shfl_up(v, o); if (lane >= o) v = fmaxf(v, t); }
    return v;
}
#define ROWPTR(m) ((m) < ROW_S ? p.xp + (size_t)(m) * DM : ((m) < ROW_M ? p.xs + (size_t)((m) - ROW_S) * DM : p.meta + (size_t)((m) - ROW_M) * DM))
DI s16x4 tr_read(const LAS bf16_t* p) { return __builtin_amdgcn_ds_read_tr16_b64_v4i16((LAS s16x4*)p); }
#define LDS_WAIT() asm volatile("s_waitcnt lgkmcnt(0)" ::: "memory")
#define MFMA16(a, b, c) __builtin_amdgcn_mfma_f32_16x16x32_bf16((a), (b), (c), 0, 0, 0)

#define XB_TMO      128
#define XB_XCNT(j)  (256  + 64 * (j))
#define XB_XSUB(j)  (1280 + 64 * (j))
#define XB_XGEN(j)  (2304 + 64 * (j))
#define XB_TOP      3328
#define XB_TOPGEN   3392
#define XCD_BAR_WORDS 3456
#define XB_SPIN_CAP (1u << 18)
DI unsigned xb_ld(unsigned* p)              { return __hip_atomic_load(p, __ATOMIC_RELAXED, __HIP_MEMORY_SCOPE_AGENT); }
DI unsigned xb_add(unsigned* p, unsigned v) { return __hip_atomic_fetch_add(p, v, __ATOMIC_RELAXED, __HIP_MEMORY_SCOPE_AGENT); }
DI unsigned xb_xcc_id() { return (unsigned)__builtin_amdgcn_s_getreg((3 << 11) | 20) & 0xFu; }
#define XB_SPIN(cond, bar) do { unsigned _sp = 0; while (cond) { __builtin_amdgcn_s_sleep(1); \
    if ((++_sp & 255u) == 0u) { if (xb_ld(&(bar)[XB_TMO])) break; if (_sp > XB_SPIN_CAP) { atomicAdd(&(bar)[XB_TMO], 1u); break; } } } } while (0)
struct XcdBarrier { unsigned* bar; unsigned x; volatile LAS unsigned* st; };
DI XcdBarrier xcd_barrier_post(unsigned* bar, volatile LAS unsigned* st) {
    XcdBarrier b; b.bar = bar; b.x = xb_xcc_id(); b.st = st;
    if (threadIdx.x == 0) (void)xb_add(&bar[XB_XCNT(b.x)], 1u);
    return b;
}
DI void xcd_barrier_complete(unsigned* bar, unsigned x, unsigned& nloc, unsigned& nx) {
    const unsigned G = gridDim.x * gridDim.y * gridDim.z;
    unsigned sum, cnt, mine, sp = 0u;
    for (;;) {
        sum = 0u; cnt = 0u; mine = 0u;
#pragma unroll
        for (unsigned j = 0; j < 16; ++j) { const unsigned c = xb_ld(&bar[XB_XCNT(j)]); sum += c; cnt += (c > 0u) ? 1u : 0u; mine = (j == x) ? c : mine; }
        if (sum == G) break;
        __builtin_amdgcn_s_sleep(1);
        if ((++sp & 255u) == 0u) { if (xb_ld(&bar[XB_TMO])) break; if (sp > XB_SPIN_CAP) { atomicAdd(&bar[XB_TMO], 1u); break; } }
    }
    nloc = mine > 0u ? mine : 1u; nx = cnt > 0u ? cnt : 1u;
}
DI void xcd_barrier(const XcdBarrier& b) {
    asm volatile("s_waitcnt vmcnt(0)" ::: "memory");
    __syncthreads();
    if (threadIdx.x == 0) {
        unsigned* bar = b.bar;
        __builtin_amdgcn_s_waitcnt(0);
        unsigned nloc = b.st[0], nx = b.st[1];
        if (nloc == 0u) { xcd_barrier_complete(bar, b.x, nloc, nx); b.st[0] = nloc; b.st[1] = nx; }
        const unsigned old = xb_add(&bar[XB_XSUB(b.x)], 1u);
        const unsigned gen = old / nloc;
        if (old + 1u == (gen + 1u) * nloc) {
            __builtin_amdgcn_fence(__ATOMIC_RELEASE, "agent");
            asm volatile("s_waitcnt vmcnt(0)" ::: "memory");
            const unsigned og = xb_add(&bar[XB_TOP], 1u);
            const unsigned tg = og / nx;
            if (og + 1u == (tg + 1u) * nx) xb_add(&bar[XB_TOPGEN], 1u);
            else XB_SPIN(xb_ld(&bar[XB_TOPGEN]) == tg, bar);
            __builtin_amdgcn_fence(__ATOMIC_ACQUIRE, "agent");
            xb_add(&bar[XB_XGEN(b.x)], 1u);
            asm volatile("s_waitcnt vmcnt(0)" ::: "memory");
        } else {
            XB_SPIN(xb_ld(&bar[XB_XGEN(b.x)]) == gen, bar);
            __builtin_amdgcn_fence(__ATOMIC_ACQUIRE, "agent");
            asm volatile("s_waitcnt vmcnt(0)" ::: "memory");
        }
    }
    __syncthreads();
}

namespace pg8 {
constexpr int BM = 256, BK = 64, HALF = 128, HTB = HALF * BK * 2, STAGE_BYTES = 8 * HTB, NXCD = 8, WGM = 4;
DI int lds_byte(int r, int c) { const int st = (r >> 4) * 2 + (c >> 5), rr = r & 15, cc = c & 31, ob = rr * 64 + cc * 2; return st * 1024 + (ob ^ (((ob >> 9) & 1) << 5)); }
DI void stage_rc(int b, int& R, int& C) { const int st = b / 1024, sb = b % 1024, swz = sb ^ (((sb >> 9) & 1) << 5); R = (st >> 1) * 16 + swz / 64; C = (st & 1) * 32 + (swz % 64) / 2; }
DI int perm32(int rho) { const int n = rho >> 4, i = rho & 15; return 8 * (i >> 2) + 4 * n + (i & 3); }

struct Unit { int pm, pn, sub; };

struct Order {
    int nM, nN, nwg, G, c, pair;
    const char *A0, *A1, *B0, *B1; size_t a_tstep, b_tstep;
    DI void init(int nM_, int nN_, int G_, int c_, int pair_) { nM = nM_; nN = nN_; nwg = nM * nN; G = G_; c = c_; pair = pair_; }
    DI bool next(int i, Unit& u) const {
        const int t = pair ? (i >> 1) : i; u.sub = pair ? (i & 1) : 0;
        const long L = (long)t * G + c; if (L >= nwg) return false;
        int wgid = (int)L; { const int q = nwg / NXCD, r = nwg % NXCD, xcd = wgid % NXCD, off = wgid / NXCD; wgid = (xcd < r ? xcd * (q + 1) : r * (q + 1) + (xcd - r) * q) + off; }
        const int nig = WGM * nN, gid = wgid / nig, fm = gid * WGM, gsz = (nM - fm) < WGM ? (nM - fm) : WGM;
        u.pm = fm + ((wgid % nig) % gsz); u.pn = (wgid % nig) / gsz; return true;
    }
    DI const char* a_ptr(const Unit& u) const { return (u.sub ? A1 : A0) + (size_t)u.pm * a_tstep; }
    DI const char* b_ptr(const Unit& u) const { return (u.sub ? B1 : B0) + (size_t)u.pn * b_tstep; }
};

template <class Epi>
DI void gemm_phase(LAS unsigned char* lds, const int K, const int lda, const size_t a_kblk, const Order& S, const Epi& E) {
#define PG8_AK(x) ((size_t)((x) >> 2) * a_kblk + (size_t)((x) & 3) * 128)
    const int tid = threadIdx.x, wid = __builtin_amdgcn_readfirstlane(tid >> 6), lane = tid & 63, wr = wid >> 2, wc = wid & 3, fr = lane & 15, fq = lane >> 4;
    const int nt = K / BK;
    unsigned voffA[2], voffB[2];
#pragma unroll
    for (int i = 0; i < 2; ++i) { int R, C; stage_rc(tid * 16 + i * 8192, R, C); const int Rb = Epi::PERM ? ((R & ~31) + perm32(R & 31)) : R;
        voffA[i] = (unsigned)(R * lda + C) * 2u; voffB[i] = (unsigned)(Rb * K + C) * 2u; }
    const size_t kstep = (size_t)(BK * 2);
    const size_t hstepA = (size_t)HALF * lda * 2, hstepB = (size_t)HALF * K * 2;
    const unsigned ldsw = (unsigned)wid * 1024u;
    const int aoff = lds_byte(wr * 64 + fr, fq * 8), boff = lds_byte(wc * 32 + fr, fq * 8);
#define PG8_SA(b, h) (((b) * 2 + (h)) * HTB)
#define PG8_SB(b, h) ((4 + (b) * 2 + (h)) * HTB)
#define PG8_STAGE(bufoff, gbase, voff) do { _Pragma("unroll") for (int _i = 0; _i < 2; ++_i) \
        __builtin_amdgcn_global_load_lds((const unsigned*)((const char*)(gbase) + (voff)[_i]), (LAS unsigned*)(lds + (bufoff) + ldsw + _i * 8192), 16, 0, 0); } while (0)
#define PG8_LDA(dst, b, h) do { _Pragma("unroll") for (int m = 0; m < 4; ++m) _Pragma("unroll") for (int k = 0; k < 2; ++k) dst[m][k] = *(const LAS bf16x8*)(lds + PG8_SA(b, h) + aoff + m * 2048 + k * 1024); } while (0)
#define PG8_LDB(dst, b, h) do { _Pragma("unroll") for (int n = 0; n < 2; ++n) _Pragma("unroll") for (int k = 0; k < 2; ++k) dst[n][k] = *(const LAS bf16x8*)(lds + PG8_SB(b, h) + boff + n * 2048 + k * 1024); } while (0)
#define PG8_MMA(ai, bj, At, Bt) do { __builtin_amdgcn_s_setprio(1); _Pragma("unroll") for (int m = 0; m < 4; ++m) _Pragma("unroll") for (int n = 0; n < 2; ++n) _Pragma("unroll") for (int k = 0; k < 2; ++k) \
        acc[ai][bj][m][n] = __builtin_amdgcn_mfma_f32_16x16x32_bf16(Bt[n][k], At[m][k], acc[ai][bj][m][n], 0, 0, 0); __builtin_amdgcn_s_setprio(0); } while (0)
#define PG8_WAIT_V(n) asm volatile("s_waitcnt vmcnt(" #n ")" ::: "memory")
#define PG8_WAIT_L(n) asm volatile("s_waitcnt lgkmcnt(" #n ")" ::: "memory")
#define PG8_BAR __builtin_amdgcn_s_barrier()
#define PG8_SCHED __builtin_amdgcn_sched_barrier(0)
    Unit cur, nxt; int ui = 0;
    if (!S.next(0, cur)) return;
    f32x4 acc[2][2][4][2];
#pragma unroll
    for (int a = 0; a < 2; ++a)
#pragma unroll
        for (int b = 0; b < 2; ++b)
#pragma unroll
            for (int m = 0; m < 4; ++m)
#pragma unroll
                for (int n = 0; n < 2; ++n) acc[a][b][m][n] = (f32x4){0.f, 0.f, 0.f, 0.f};
    bf16x8 At[4][2], B0[2][2], B1[2][2];
    const char* cA = S.a_ptr(cur); const char* cB = S.b_ptr(cur);
    PG8_STAGE(PG8_SB(0, 0), cB, voffB); PG8_STAGE(PG8_SB(0, 1), cB + hstepB, voffB); PG8_STAGE(PG8_SA(0, 0), cA, voffA); PG8_STAGE(PG8_SA(0, 1), cA + hstepA, voffA);
    if (wr == 1) PG8_BAR;
    PG8_WAIT_V(2); PG8_BAR;
    PG8_STAGE(PG8_SB(1, 0), cB + kstep, voffB); PG8_STAGE(PG8_SA(1, 0), cA + kstep, voffA); PG8_STAGE(PG8_SB(1, 1), cB + hstepB + kstep, voffB);
    PG8_WAIT_V(6); PG8_BAR;
    for (;;) {
        const bool has_next = S.next(ui + 1, nxt);
        const char* nA = has_next ? S.a_ptr(nxt) : cA; const char* nB = has_next ? S.b_ptr(nxt) : cB;
        for (int t = 0; t < nt; t += 2) {
            const bool last = (t == nt - 2);
            const char* a1 = cA + PG8_AK(t + 1);
            const char* a2 = last ? nA : cA + PG8_AK(t + 2); const char* b2 = last ? nB : cB + (size_t)(t + 2) * kstep;
            const char* a3 = a2 + kstep; const char* b3 = b2 + kstep;
            PG8_LDB(B0, 0, 0); PG8_LDB(B1, 0, 1); PG8_SCHED; PG8_LDA(At, 0, 0); PG8_STAGE(PG8_SA(1, 1), a1 + hstepA, voffA);
            PG8_WAIT_V(8); PG8_WAIT_L(0); PG8_BAR; PG8_MMA(0, 0, At, B0); PG8_MMA(0, 1, At, B1); PG8_BAR; PG8_SCHED;
            PG8_LDA(At, 0, 1); PG8_STAGE(PG8_SB(0, 0), b2, voffB); PG8_STAGE(PG8_SB(0, 1), b2 + hstepB, voffB); PG8_STAGE(PG8_SA(0, 0), a2, voffA);
            PG8_WAIT_V(8); PG8_WAIT_L(0); PG8_BAR; PG8_MMA(1, 0, At, B0); PG8_MMA(1, 1, At, B1); PG8_BAR; PG8_SCHED;
            PG8_LDB(B0, 1, 0); PG8_LDB(B1, 1, 1); PG8_SCHED; PG8_LDA(At, 1, 0); PG8_STAGE(PG8_SA(0, 1), a2 + hstepA, voffA);
            PG8_WAIT_V(8); PG8_WAIT_L(0); PG8_BAR; PG8_MMA(0, 0, At, B0); PG8_MMA(0, 1, At, B1); PG8_BAR; PG8_SCHED;
            PG8_LDA(At, 1, 1); PG8_STAGE(PG8_SB(1, 0), b3, voffB); PG8_STAGE(PG8_SB(1, 1), b3 + hstepB, voffB); PG8_STAGE(PG8_SA(1, 0), a3, voffA);
            PG8_WAIT_V(8); PG8_WAIT_L(0); PG8_BAR; PG8_MMA(1, 0, At, B0); PG8_MMA(1, 1, At, B1); PG8_BAR; PG8_SCHED;
        }
        if (wr == 0) PG8_BAR;
        E(acc, cur, wr, wc, fr, fq);
        if (!has_next) break;
#pragma unroll
        for (int a = 0; a < 2; ++a)
#pragma unroll
            for (int b = 0; b < 2; ++b)
#pragma unroll
                for (int m = 0; m < 4; ++m)
#pragma unroll
                    for (int n = 0; n < 2; ++n) acc[a][b][m][n] = (f32x4){0.f, 0.f, 0.f, 0.f};
        cur = nxt; cA = nA; cB = nB; ++ui;
        if (wr == 1) PG8_BAR;
    }
    PG8_WAIT_V(0);
    PG8_BAR;
#undef PG8_AK
#undef PG8_SA
#undef PG8_SB
#undef PG8_STAGE
#undef PG8_LDA
#undef PG8_LDB
#undef PG8_MMA
#undef PG8_WAIT_V
#undef PG8_WAIT_L
#undef PG8_BAR
#undef PG8_SCHED
}

struct EpiU {
    static constexpr bool PERM = true;
    bf16_t* U; float* gate; float* out;
    DI void operator()(const f32x4 (&acc)[2][2][4][2], const Unit& u, int wr, int wc, int fr, int fq) const {
        const int row0 = u.pm * BM + wr * 64 + fr, pn = u.pn;
        if (pn == 66) {
            if (wc == 0 && fq < 2) {
#pragma unroll
                for (int ai = 0; ai < 2; ++ai)
#pragma unroll
                    for (int m = 0; m < 4; ++m) { float* g = gate + (size_t)(row0 + ai * HALF + m * 16) * 16 + 8 * fq;
                        *(f32x4*)g = acc[ai][0][m][0]; *(f32x4*)(g + 4) = acc[ai][0][m][1]; }
            }
            return;
        }
        const float scale = (pn < 8) ? 0.18033688011112042f : ((pn >= 22 && pn < 26) ? 0.08838834764831845f : 1.0f);
        const int col0 = pn * BM + wc * 32 + 8 * fq;
#pragma unroll
        for (int ai = 0; ai < 2; ++ai)
#pragma unroll
            for (int m = 0; m < 4; ++m) { bf16_t* rowp = U + (size_t)pn * UT + (size_t)(row0 + ai * HALF + m * 16) * 256 + (wc * 32 + 8 * fq);
#pragma unroll
                for (int bj = 0; bj < 2; ++bj) { const f32x4 v0 = acc[ai][bj][m][0] * scale, v1 = acc[ai][bj][m][1] * scale;
                    u32x4 w; w.x = pk2(v0[0], v0[1]); w.y = pk2(v0[2], v0[3]); w.z = pk2(v1[0], v1[1]); w.w = pk2(v1[2], v1[3]);
                    *(u32x4*)(rowp + bj * HALF) = w; } }
        if (pn == 8 || pn == 9) {
#pragma unroll
            for (int ai = 0; ai < 2; ++ai)
#pragma unroll
                for (int m = 0; m < 4; ++m) { const int r = row0 + ai * HALF + m * 16; float* dst = nullptr;
                    if (r >= 8064 && r < 8192) dst = out + (pn == 8 ? O_KP : O_VP) + (size_t)(r - 8064) * 256;
                    else if (r >= 8192 && r < 8448) { const int b = (r - 8192) >> 4, t = (r - 8192) & 15; dst = out + (pn == 8 ? O_KS : O_VS) + (size_t)(b * 128 + 112 + t) * 256; }
                    if (dst) {
#pragma unroll
                        for (int bj = 0; bj < 2; ++bj) { const int c = bj * HALF + wc * 32 + 8 * fq; *(f32x4*)(dst + c) = acc[ai][bj][m][0]; *(f32x4*)(dst + c + 4) = acc[ai][bj][m][1]; } } }
        }
    }
};
struct EpiMerge {
    static constexpr bool PERM = true;
    const bf16_t* U; bf16_t* MG;
    DI void operator()(const f32x4 (&acc)[2][2][4][2], const Unit& u, int wr, int wc, int fr, int fq) const {
        const int row0 = u.pm * BM + wr * 64 + fr, col0 = u.pn * BM + wc * 32 + 8 * fq; const int gcol = u.sub ? GM : GA;
#pragma unroll
        for (int ai = 0; ai < 2; ++ai) {
            u32x4 g[4][2], o[4][2];
#pragma unroll
            for (int m = 0; m < 4; ++m)
#pragma unroll
                for (int bj = 0; bj < 2; ++bj) { const int r = row0 + ai * HALF + m * 16, c = col0 + bj * HALF;
                    g[m][bj] = *(const u32x4*)(U + uoff(r, gcol + c));
                    o[m][bj] = u.sub ? *(const u32x4*)(MG + (size_t)r * DM + c) : (u32x4){0u, 0u, 0u, 0u}; }
#pragma unroll
            for (int m = 0; m < 4; ++m)
#pragma unroll
                for (int bj = 0; bj < 2; ++bj) { const int r = row0 + ai * HALF + m * 16, c = col0 + bj * HALF;
                    const u32x4 gg = g[m][bj], oo = o[m][bj]; const f32x4 a0 = acc[ai][bj][m][0], a1 = acc[ai][bj][m][1];
                    float v[8];
                    v[0] = sigmoidf_(bflo(gg.x)) * a0[0] + bflo(oo.x); v[1] = sigmoidf_(bfhi(gg.x)) * a0[1] + bfhi(oo.x); v[2] = sigmoidf_(bflo(gg.y)) * a0[2] + bflo(oo.y); v[3] = sigmoidf_(bfhi(gg.y)) * a0[3] + bfhi(oo.y);
                    v[4] = sigmoidf_(bflo(gg.z)) * a1[0] + bflo(oo.z); v[5] = sigmoidf_(bfhi(gg.z)) * a1[1] + bfhi(oo.z); v[6] = sigmoidf_(bflo(gg.w)) * a1[2] + bflo(oo.w); v[7] = sigmoidf_(bfhi(gg.w)) * a1[3] + bfhi(oo.w);
                    u32x4 w; w.x = pk2(v[0], v[1]); w.y = pk2(v[2], v[3]); w.z = pk2(v[4], v[5]); w.w = pk2(v[6], v[7]);
                    *(u32x4*)(MG + (size_t)r * DM + c) = w; }
        }
    }
};
struct EpiOut {
    static constexpr bool PERM = false;
    const float *xp, *xs; bf16_t* X1; float* ssq;
    DI void operator()(const f32x4 (&acc)[2][2][4][2], const Unit& u, int wr, int wc, int fr, int fq) const {
        const int row0 = u.pm * BM + wr * 64 + fr, col0 = u.pn * BM + wc * 32 + 4 * fq;
#pragma unroll
        for (int ai = 0; ai < 2; ++ai) {
            f32x4 xv[4][2][2];
#pragma unroll
            for (int m = 0; m < 4; ++m) { const int r = row0 + ai * HALF + m * 16; const float* xrow = (r < ROW_S) ? xp + (size_t)r * DM : xs + (size_t)(r - ROW_S) * DM;
#pragma unroll
                for (int bj = 0; bj < 2; ++bj)
#pragma unroll
                    for (int n = 0; n < 2; ++n) xv[m][bj][n] = *(const f32x4*)(xrow + col0 + bj * HALF + n * 16); }
#pragma unroll
            for (int m = 0; m < 4; ++m) { const int r = row0 + ai * HALF + m * 16; bf16_t* orow = X1 + (size_t)u.pn * UT + (size_t)r * 256 + wc * 32 + 4 * fq; float ss = 0.f;
#pragma unroll
                for (int bj = 0; bj < 2; ++bj)
#pragma unroll
                    for (int n = 0; n < 2; ++n) { const f32x4 o = xv[m][bj][n] + acc[ai][bj][m][n];
                        u32x2 w; w.x = pk2(o[0], o[1]); w.y = pk2(o[2], o[3]); *(u32x2*)(orow + bj * HALF + n * 16) = w; ss += (o[0] * o[0] + o[1] * o[1]) + (o[2] * o[2] + o[3] * o[3]); }
                ss += __shfl_xor(ss, 16); ss += __shfl_xor(ss, 32);
                if (fq == 0) ssq[(size_t)r * 32 + u.pn * 4 + wc] = ss; }
        }
    }
};
}

DI int win_src_col(int n) { return n < 10752 ? n : (n < 16896 ? n + 16 : (n < 16912 ? 10752 + (n - 16896) : -1)); }

DI void p0_transpose_item(const float* W, int Nsrc, int srccol4, bf16_t* WT, int dstrow0, int k0, LAS float* scr, int lane) {
    f32x4 r[8];
#pragma unroll
    for (int i = 0; i < 8; ++i) { const int kk = (lane >> 3) + 8 * i; r[i] = (srccol4 >= 0) ? *(const f32x4*)(W + (size_t)(k0 + kk) * Nsrc + srccol4) : (f32x4){0.f, 0.f, 0.f, 0.f}; }
#pragma unroll
    for (int i = 0; i < 8; ++i) { const int kk = (lane >> 3) + 8 * i; LAS float* d = scr + kk * 33 + 4 * (lane & 7); d[0] = r[i][0]; d[1] = r[i][1]; d[2] = r[i][2]; d[3] = r[i][3]; }
    LDS_WAIT();
    const int c = lane & 7;
#pragma unroll
    for (int j = 0; j < 4; ++j) { const int n = (lane >> 3) + 8 * j; const LAS float* s = scr + (8 * c) * 33 + n;
        u32x4 o; o.x = pk2(s[0 * 33], s[1 * 33]); o.y = pk2(s[2 * 33], s[3 * 33]); o.z = pk2(s[4 * 33], s[5 * 33]); o.w = pk2(s[6 * 33], s[7 * 33]);
        *(u32x4*)(WT + (size_t)(dstrow0 + n) * 2048 + k0 + 8 * c) = o; }
    LDS_WAIT();
}

DI void p0_prologue(const Params& p, LAS unsigned char* lds) {
    const int tid = threadIdx.x, lane = tid & 63, wave = tid >> 6;
    const int gw = blockIdx.x * 8 + wave, NGW = gridDim.x * 8;
    bf16_t* WIN = (bf16_t*)(p.ws + WS_WIN); bf16_t* WP = (bf16_t*)(p.ws + WS_WP); bf16_t* WOUT = (bf16_t*)(p.ws + WS_WOUT); bf16_t* XN = (bf16_t*)(p.ws + WS_XN);
    LAS float* scr = (LAS float*)(lds + wave * 16384);
    constexpr int I_IN = 32 * (NW / 32), I_SQ = 32 * 64;
    for (int it = gw; it < I_IN + 3 * I_SQ; it += NGW) {
        int r = it;
        if (r < I_IN) { const int nb = r % (NW / 32), kb = r / (NW / 32); p0_transpose_item(p.win, 16912, win_src_col(nb * 32 + 4 * (lane & 7)), WIN, nb * 32, kb * 64, scr, lane); continue; }
        r -= I_IN; const int which = r / I_SQ; r -= which * I_SQ; const int nb = r % 64, kb = r / 64;
        const float* W = which == 0 ? p.wpa : (which == 1 ? p.wpm : p.wout);
        bf16_t* WT = which == 2 ? WOUT : WP; const int drow = (which == 1 ? 2048 : 0) + nb * 32;
        p0_transpose_item(W, 2048, nb * 32 + 4 * (lane & 7), WT, drow, kb * 64, scr, lane);
    }
    for (int m = gw; m < MPAD; m += NGW) {
        u32x2* o8 = (u32x2*)(XN + (size_t)m * DM) + lane;
        if (m >= MROWS) {
#pragma unroll
            for (int j = 0; j < 8; ++j) o8[64 * j] = (u32x2){0u, 0u};
            continue; }
        const float* xrow = m < ROW_S ? p.xp + (size_t)m * DM : (m < ROW_M ? p.xs + (size_t)(m - ROW_S) * DM : p.meta + (size_t)(m - ROW_M) * DM);
        const f32x4* xr = (const f32x4*)xrow + lane; const f32x4* gr = (const f32x4*)p.gnorm + lane;
        f32x4 v[8]; float s = 0.f;
#pragma unroll
        for (int j = 0; j < 8; ++j) { v[j] = xr[64 * j]; s += (v[j][0] * v[j][0] + v[j][1] * v[j][1]) + (v[j][2] * v[j][2] + v[j][3] * v[j][3]); }
        const float rstd = rsqrtf(wsum(s) * (1.f / DM) + EPS);
#pragma unroll
        for (int j = 0; j < 8; ++j) { const f32x4 g = gr[64 * j]; u32x2 w; w.x = pk2(v[j][0] * rstd * g[0], v[j][1] * rstd * g[1]); w.y = pk2(v[j][2] * rstd * g[2], v[j][3] * rstd * g[3]); o8[64 * j] = w; }
    }
    const int gt = blockIdx.x * 512 + tid, NGT = gridDim.x * 512;
    for (int i = gt; i < 2 * 16 * 112 * 64; i += NGT) {
        const int kv = i / (16 * 112 * 64); int r = i - kv * (16 * 112 * 64); const int b = r / (112 * 64); r -= b * (112 * 64);
        const f32x4* src = (const f32x4*)((kv ? p.cv : p.ck) + (size_t)(b * 128 + 16) * 256) + r;
        f32x4* dst = (f32x4*)(p.out + (kv ? O_VS : O_KS) + (size_t)(b * 128) * 256) + r;
        *dst = *src;
    }
}

DI u32x4 attn_fetch8(const Params& p, const bf16_t* U, int kind, int bidx, int g, int key, int ch, int colbase, const float* cache) {
    u32x4 z = (u32x4){0u, 0u, 0u, 0u};
    if (key < 16) return *(const u32x4*)(U + uoff(ROW_M + key, colbase + g * 64 + 8 * ch));
    if (kind == 0) {
        const int row = 64 * (bidx - 2) + (key - 16);
        if (key < 208 && row >= 0) return *(const u32x4*)(U + uoff(row, colbase + g * 64 + 8 * ch));
        return z;
    } else {
        if (key < 144) { const float* s = cache + ((size_t)(bidx * 128 + (key - 16)) * 4 + g) * 64 + 8 * ch; const f32x4 a = *(const f32x4*)s, b = *(const f32x4*)(s + 4);
            u32x4 w; w.x = pk2(a[0], a[1]); w.y = pk2(a[2], a[3]); w.z = pk2(b[0], b[1]); w.w = pk2(b[2], b[3]); return w; }
        if (key < 160) return *(const u32x4*)(U + uoff(ROW_S + 16 * bidx + (key - 144), colbase + g * 64 + 8 * ch));
        return z;
    }
}
DI void attn_item(const Params& p, LAS unsigned char* lds, int kind, int bidx, int g, int dry) {
    int tid_ = threadIdx.x; asm volatile("" : "+v"(tid_)); const int tid = tid_, lane = tid & 63, wave = tid >> 6, lr = lane & 15, q = lane >> 4;
    bf16_t* U = (bf16_t*)(p.ws + WS_U);
    LAS bf16_t* KAl = (LAS bf16_t*)lds; LAS bf16_t* VAl = (LAS bf16_t*)(lds + 32256);
    const int hq = 8 * g + wave; const float sink = p.sinks[hq] * 1.4426950408889634f;
    const int npair = kind == 0 ? 2 : 1, qrow0 = kind == 0 ? 64 * bidx : ROW_S + 16 * bidx;
    const int hi_t = kind == 0 ? 13 : 10; const int lo_t = kind == 0 ? 1 + (bidx < 2 ? 4 * (2 - bidx) : 0) : 1;
    u32x4 kreg[4], vreg[4];
#pragma unroll
    for (int i = 0; i < 4; ++i) { const int ci = tid + 512 * i; kreg[i] = (u32x4){0u, 0u, 0u, 0u}; vreg[i] = kreg[i];
        if (ci < 224 * 8) { kreg[i] = attn_fetch8(p, U, kind, bidx, g, ci >> 3, ci & 7, KA, p.ck); vreg[i] = attn_fetch8(p, U, kind, bidx, g, ci >> 3, ci & 7, VA, p.cv); } }
#pragma unroll
    for (int i = 0; i < 4; ++i) { const int ci = tid + 512 * i; if (ci < 224 * 8) { *(LAS u32x4*)(KAl + (ci >> 3) * 72 + 8 * (ci & 7)) = kreg[i]; *(LAS u32x4*)(VAl + (ci >> 3) * 72 + 8 * (ci & 7)) = vreg[i]; } }
    __syncthreads();
    for (int pr = 0; pr < npair; ++pr) {
        const int tA = 2 * pr, tB = kind == 0 ? 2 * pr + 1 : 0;
        const size_t rowA = (size_t)(qrow0 + 16 * tA + lr) * 256 + (size_t)(hq >> 2) * UT + (hq & 3) * 64, rowB = (size_t)(qrow0 + 16 * tB + lr) * 256 + (size_t)(hq >> 2) * UT + (hq & 3) * 64;
        constexpr size_t ZOFF = (size_t)(ZA >> 8) * UT;
        bf16x8 qa[2], qb[2]; u32x2 za[4], zb[4];
#pragma unroll
        for (int ks = 0; ks < 2; ++ks) { qa[ks] = *(const bf16x8*)(U + rowA + 32 * ks + 8 * q); qb[ks] = *(const bf16x8*)(U + rowB + 32 * ks + 8 * q); }
#pragma unroll
        for (int dt = 0; dt < 4; ++dt) { za[dt] = *(const u32x2*)(U + rowA + ZOFF + 16 * dt + 4 * q); zb[dt] = *(const u32x2*)(U + rowB + ZOFF + 16 * dt + 4 * q); }
        f32x4 accA[14], accB[14];
        float mxA = -1e30f, mxB = -1e30f;
#pragma unroll
        for (int kt = 0; kt < 14; ++kt) {
            if (kt == 0 || (kt >= lo_t && kt < hi_t)) {
                accA[kt] = (f32x4){0.f, 0.f, 0.f, 0.f}; accB[kt] = accA[kt];
#pragma unroll
                for (int ks = 0; ks < 2; ++ks) { const bf16x8 a = *(const LAS bf16x8*)(KAl + (16 * kt + lr) * 72 + 32 * ks + 8 * q); accA[kt] = MFMA16(a, qa[ks], accA[kt]); accB[kt] = MFMA16(a, qb[ks], accB[kt]); }
                mxA = fmaxf(mxA, fmaxf(fmaxf(accA[kt][0], accA[kt][1]), fmaxf(accA[kt][2], accA[kt][3])));
                mxB = fmaxf(mxB, fmaxf(fmaxf(accB[kt][0], accB[kt][1]), fmaxf(accB[kt][2], accB[kt][3])));
            } else { accA[kt] = (f32x4){-1e30f, -1e30f, -1e30f, -1e30f}; accB[kt] = accA[kt]; }
        }
        mxA = fmaxf(mxA, __shfl_xor(mxA, 16)); mxA = fmaxf(mxA, __shfl_xor(mxA, 32)); mxB = fmaxf(mxB, __shfl_xor(mxB, 16)); mxB = fmaxf(mxB, __shfl_xor(mxB, 32));
        const float MA = fmaxf(mxA, sink), MB = fmaxf(mxB, sink); float sumA = 0.f, sumB = 0.f;
#pragma unroll
        for (int kt = 0; kt < 14; ++kt)
#pragma unroll
            for (int j = 0; j < 4; ++j) { const float ea = __builtin_amdgcn_exp2f(accA[kt][j] - MA), eb = __builtin_amdgcn_exp2f(accB[kt][j] - MB); accA[kt][j] = ea; accB[kt][j] = eb; sumA += ea; sumB += eb; }
        sumA += __shfl_xor(sumA, 16); sumA += __shfl_xor(sumA, 32); sumB += __shfl_xor(sumB, 16); sumB += __shfl_xor(sumB, 32);
        const float invA = 1.0f / (sumA + __builtin_amdgcn_exp2f(sink - MA)), invB = 1.0f / (sumB + __builtin_amdgcn_exp2f(sink - MB));
        bf16x8 pA[7], pB[7];
#pragma unroll
        for (int u = 0; u < 7; ++u) { u32x4 w; w.x = pk2(accA[2 * u][0], accA[2 * u][1]); w.y = pk2(accA[2 * u][2], accA[2 * u][3]);
            w.z = pk2(accA[2 * u + 1][0], accA[2 * u + 1][1]); w.w = pk2(accA[2 * u + 1][2], accA[2 * u + 1][3]); pA[u] = __builtin_bit_cast(bf16x8, w);
            w.x = pk2(accB[2 * u][0], accB[2 * u][1]); w.y = pk2(accB[2 * u][2], accB[2 * u][3]);
            w.z = pk2(accB[2 * u + 1][0], accB[2 * u + 1][1]); w.w = pk2(accB[2 * u + 1][2], accB[2 * u + 1][3]); pB[u] = __builtin_bit_cast(bf16x8, w); }
        f32x4 oA[4], oB[4];
#pragma unroll
        for (int dt = 0; dt < 4; ++dt) { oA[dt] = (f32x4){0.f, 0.f, 0.f, 0.f}; oB[dt] = oA[dt];
#pragma unroll
            for (int u = 0; u < 7; ++u) { const LAS bf16_t* vp = VAl + (32 * u + 4 * q + (lr >> 2)) * 72 + 16 * dt + 4 * (lr & 3);
                const s16x4 lo = tr_read(vp), hi = tr_read(vp + 16 * 72);
                const bf16x8 a = __builtin_shufflevector(lo, hi, 0, 1, 2, 3, 4, 5, 6, 7); oA[dt] = MFMA16(a, pA[u], oA[dt]); oB[dt] = MFMA16(a, pB[u], oB[dt]); } }
#pragma unroll
        for (int dt = 0; dt < 4; ++dt) { const int col = hq * 64 + 16 * dt + 4 * q;
            { const u32x2 z = za[dt]; u32x2 w; w.x = pk2(oA[dt][0] * invA * siluf_(bflo(z.x)), oA[dt][1] * invA * siluf_(bfhi(z.x))); w.y = pk2(oA[dt][2] * invA * siluf_(bflo(z.y)), oA[dt][3] * invA * siluf_(bfhi(z.y)));
              if (dry) *(u32x2*)((bf16_t*)(p.ws + WS_XN) + (size_t)(qrow0 + 16 * tA + lr) * DM + col) = w; else *(u32x2*)(U + rowA + 16 * dt + 4 * q) = w; }
            if (kind == 0) { const u32x2 z = zb[dt]; u32x2 w; w.x = pk2(oB[dt][0] * invB * siluf_(bflo(z.x)), oB[dt][1] * invB * siluf_(bfhi(z.x))); w.y = pk2(oB[dt][2] * invB * siluf_(bflo(z.y)), oB[dt][3] * invB * siluf_(bfhi(z.y)));
              if (dry) *(u32x2*)((bf16_t*)(p.ws + WS_XN) + (size_t)(qrow0 + 16 * tB + lr) * DM + col) = w; else *(u32x2*)(U + rowB + 16 * dt + 4 * q) = w; } }
    }
    __syncthreads();
}

constexpr int ML_T2 = 69632, ML_SC = 106496;
constexpr int PV = 272, PKS = 144;
DI void mlstm_v_load(const bf16_t* U, int R0, int h, int tid, u32x4 (&v)[8]) {
#pragma unroll
    for (int it = 0; it < 8; ++it) { const int ci = tid + 512 * it, row = ci >> 5, ch = ci & 31; v[it] = *(const u32x4*)(U + uoff(R0 + row, VM + h * 256 + 8 * ch)); }
}
DI void mlstm_v_store(LAS unsigned char* lds, int tid, const u32x4 (&v)[8]) {
    LAS bf16_t* Vl = (LAS bf16_t*)lds;
#pragma unroll
    for (int it = 0; it < 8; ++it) { const int ci = tid + 512 * it, row = ci >> 5, ch = ci & 31; *(LAS u32x4*)(Vl + row * PV + 8 * ch) = v[it]; }
}

DI void mlstm_sum_item(const Params& p, LAS unsigned char* lds, int h, int j) {
    int tid_ = threadIdx.x; asm volatile("" : "+v"(tid_)); const int tid = tid_, lane = tid & 63, wave = tid >> 6, lr = lane & 15, q = lane >> 4;
    const bf16_t* U = (const bf16_t*)(p.ws + WS_U); const float* GATE = (const float*)(p.ws + WS_GATE);
    LAS float* wS = (LAS float*)(lds + ML_SC);
    const int R0 = 128 * j;
    u32x4 vreg[8], kreg[4];
    mlstm_v_load(U, R0, h, tid, vreg);
#pragma unroll
    for (int it = 0; it < 4; ++it) { const int ci = tid + 512 * it, row = ci >> 4, ch = ci & 15; kreg[it] = *(const u32x4*)(U + uoff(R0 + row, KM + h * 128 + 8 * ch)); }
    if (wave == 0) {
        const float bi = p.bi[h], bfb = p.bf[h];
        const float gi0 = GATE[(size_t)(R0 + lane) * 16 + h] + bi, gi1 = GATE[(size_t)(R0 + 64 + lane) * 16 + h] + bi;
        const float lf0 = logsigmoidf_(GATE[(size_t)(R0 + lane) * 16 + 8 + h] + bfb), lf1 = logsigmoidf_(GATE[(size_t)(R0 + 64 + lane) * 16 + 8 + h] + bfb);
        const float c0 = scan_add(lf0, lane); const float tot0 = __shfl(c0, 63); const float c1 = scan_add(lf1, lane) + tot0; const float blast = __shfl(c1, 63);
        const float x0 = blast - c0 + gi0, x1 = blast - c1 + gi1; const float ml = wmax(fmaxf(x0, x1));
        wS[lane] = __expf(x0 - ml); wS[64 + lane] = __expf(x1 - ml);
        if (lane == 0) { ((float*)(p.ws + WS_BS))[h * NCH + j] = blast; ((float*)(p.ws + WS_ML))[h * NCH + j] = ml; }
    } else if (wave == 1) {
        const float bi = p.bi[h], bfb = p.bf[h];
        const float gi0 = GATE[(size_t)(R0 + lane) * 16 + h] + bi, gi1 = GATE[(size_t)(R0 + 64 + lane) * 16 + h] + bi;
        const float lf0 = logsigmoidf_(GATE[(size_t)(R0 + lane) * 16 + 8 + h] + bfb), lf1 = logsigmoidf_(GATE[(size_t)(R0 + 64 + lane) * 16 + 8 + h] + bfb);
        const float c0 = scan_add(lf0, lane); const float tot0 = __shfl(c0, 63); const float c1 = scan_add(lf1, lane) + tot0;
        const float a0 = gi0 - c0, a1 = gi1 - c1;
        const float p0 = scan_max(a0, lane); const float t0 = __shfl(p0, 63); const float p1 = fmaxf(scan_max(a1, lane), t0);
        float* gs = (float*)(p.ws + WS_GS) + (size_t)(h * NCH + j) * 384;
        gs[lane] = a0; gs[64 + lane] = a1; gs[128 + lane] = p0; gs[192 + lane] = p1; gs[256 + lane] = c0; gs[320 + lane] = c1;
    }
    mlstm_v_store(lds, tid, vreg);
    __syncthreads();
    {
        LAS bf16_t* Kl = (LAS bf16_t*)(lds + ML_T2);
#pragma unroll
        for (int it = 0; it < 4; ++it) { const int ci = tid + 512 * it, row = ci >> 4, ch = ci & 15; const u32x4 a = kreg[it]; const float w = wS[row];
            u32x4 o; o.x = pk2(bflo(a.x) * w, bfhi(a.x) * w); o.y = pk2(bflo(a.y) * w, bfhi(a.y) * w); o.z = pk2(bflo(a.z) * w, bfhi(a.z) * w); o.w = pk2(bflo(a.w) * w, bfhi(a.w) * w);
            *(LAS u32x4*)(Kl + row * PKS + 8 * ch) = o; }
    }
    __syncthreads();
    const LAS bf16_t* Vl = (const LAS bf16_t*)lds; const LAS bf16_t* Kl = (const LAS bf16_t*)(lds + ML_T2);
    {
        LAS float* npart = (LAS float*)(lds + ML_SC + 512);
        const int d = tid & 127, part = tid >> 7; float sm = 0.f;
#pragma unroll 8
        for (int r = 0; r < 32; ++r) sm += bf2f(Kl[(32 * part + r) * PKS + d]);
        npart[part * 128 + d] = sm;
    }
    f32x4 acc[2][8];
#pragma unroll
    for (int i = 0; i < 2; ++i)
#pragma unroll
        for (int dt = 0; dt < 8; ++dt) acc[i][dt] = (f32x4){0.f, 0.f, 0.f, 0.f};
#pragma unroll
    for (int ks = 0; ks < 4; ++ks) {
        bf16x8 a[2];
#pragma unroll
        for (int i = 0; i < 2; ++i) { const LAS bf16_t* vp = Vl + (32 * ks + 8 * q + (lr >> 2)) * PV + 16 * (2 * wave + i) + 4 * (lr & 3);
            const s16x4 lo = tr_read(vp), hi = tr_read(vp + 4 * PV); a[i] = __builtin_shufflevector(lo, hi, 0, 1, 2, 3, 4, 5, 6, 7); }
#pragma unroll
        for (int dt = 0; dt < 8; ++dt) { const LAS bf16_t* kp = Kl + (32 * ks + 8 * q + (lr >> 2)) * PKS + 16 * dt + 4 * (lr & 3);
            const s16x4 lo = tr_read(kp), hi = tr_read(kp + 4 * PKS); const bf16x8 b = __builtin_shufflevector(lo, hi, 0, 1, 2, 3, 4, 5, 6, 7);
#pragma unroll
            for (int i = 0; i < 2; ++i) acc[i][dt] = MFMA16(b, a[i], acc[i][dt]); }
    }
    bf16_t* UP = (bf16_t*)(p.ws + WS_UP) + (size_t)(h * NCH + j) * 256 * 128;
#pragma unroll
    for (int i = 0; i < 2; ++i)
#pragma unroll
        for (int dt = 0; dt < 8; ++dt) { u32x2 w; w.x = f2bf_c(acc[i][dt][0]) | (f2bf_c(acc[i][dt][1]) << 16); w.y = f2bf_c(acc[i][dt][2]) | (f2bf_c(acc[i][dt][3]) << 16);
            *(u32x2*)(UP + (size_t)(16 * (2 * wave + i) + lr) * 128 + 16 * dt + 4 * q) = w; }
    __syncthreads();
    if (tid < 128) { const LAS float* npart = (const LAS float*)(lds + ML_SC + 512);
        ((float*)(p.ws + WS_NP))[(size_t)(h * NCH + j) * 128 + tid] = (npart[tid] + npart[128 + tid]) + (npart[256 + tid] + npart[384 + tid]); }
    __syncthreads();
}

DI void mlstm_small_item(const Params& p, LAS unsigned char* lds, int b, int h, int dry) {
    int tid_ = threadIdx.x; asm volatile("" : "+v"(tid_)); const int tid = tid_, lane = tid & 63, wave = tid >> 6;
    bf16_t* U = (bf16_t*)(p.ws + WS_U); const float* GATE = (const float*)(p.ws + WS_GATE);
    const bool meta = (b == 16); const int R0 = meta ? ROW_M : ROW_S + 16 * b;
    LAS float* qT = (LAS float*)lds; LAS float* kwT = (LAS float*)(lds + 8192); LAS float* kS = (LAS float*)(lds + 16384);
    LAS float* Wm = (LAS float*)(lds + 24832); LAS float* sc = (LAS float*)(lds + 25856); LAS float* red = (LAS float*)(lds + 26624);
    LAS float* am = sc, *cm = sc + 16, *bb = sc + 32, *wsS = sc + 48, *misc = sc + 64, *qnS = sc + 80;
    const float* Cin = p.sC + (size_t)(b * 8 + h) * 128 * 256; const float* nin = p.sn + (size_t)(b * 8 + h) * 128;
    float* Cout = meta ? (float*)(p.ws + WS_C0) + (size_t)h * 128 * 256 : p.out + O_CS + (size_t)(b * 8 + h) * 128 * 256;
    float* nout = meta ? (float*)(p.ws + WS_N0) + h * 128 : p.out + O_NS + (size_t)(b * 8 + h) * 128;
#pragma unroll
    for (int i = 0; i < 4; ++i) { const int idx = tid + 512 * i, t = idx >> 7, d = idx & 127;
        qT[d * 16 + t] = bf2f(U[uoff(R0 + t, QM + h * 128 + d)]); kS[t * 132 + d] = bf2f(U[uoff(R0 + t, KM + h * 128 + d)]); }
    if (tid >= 128 && tid < 256) red[tid - 128] = meta ? 0.f : nin[tid - 128];
    if (wave == 0) {
        const bool act = lane < 16; const int tl = act ? lane : 15;
        const float gi = GATE[(size_t)(R0 + tl) * 16 + h] + p.bi[h];
        const float lf = act ? logsigmoidf_(GATE[(size_t)(R0 + tl) * 16 + 8 + h] + p.bf[h]) : 0.f;
        const float c = scan_add(lf, lane); const float a = act ? gi - c : -3e38f; const float pm = scan_max(a, lane);
        const float mprev = meta ? 0.f : p.sm[b * 8 + h]; const float cmv = fmaxf(mprev, pm);
        const float b15 = __shfl(c, 15), cm15 = __shfl(cmv, 15); const float mnew = b15 + cm15;
        if (act) { am[lane] = a; cm[lane] = cmv; bb[lane] = c; wsS[lane] = __expf(b15 + a - mnew); }
        if (lane == 0) { misc[0] = __expf(b15 + mprev - mnew); misc[1] = mnew; misc[2] = mprev;
            if (meta) ((float*)(p.ws + WS_M0))[h] = mnew; else p.out[O_MS + b * 8 + h] = mnew; }
    }
    __syncthreads();
#pragma unroll
    for (int i = 0; i < 4; ++i) { const int idx = tid + 512 * i, s = idx >> 7, d = idx & 127; kwT[d * 16 + s] = kS[s * 132 + d] * wsS[s]; }
    if (tid < 256) { const int t = tid >> 4, s = tid & 15; float dot = 0.f;
        for (int d = 0; d < 128; ++d) dot += qT[d * 16 + t] * kS[s * 132 + d];
        Wm[t * 16 + s] = (s <= t) ? dot * __expf(am[s] - cm[t]) : 0.f;
    } else { const int t = (tid - 256) >> 4, part = tid & 15; float dot = 0.f;
#pragma unroll
        for (int i = 0; i < 8; ++i) dot += qT[(8 * part + i) * 16 + t] * red[8 * part + i];
        dot += __shfl_xor(dot, 1); dot += __shfl_xor(dot, 2); dot += __shfl_xor(dot, 4); dot += __shfl_xor(dot, 8);
        if (part == 0) qnS[t] = dot; }
    __syncthreads();
    const int e0 = tid & 127, dq = tid >> 7;
    float v0[16], v1[16];
#pragma unroll
    for (int s = 0; s < 16; ++s) { v0[s] = bf2f(U[uoff(R0 + s, VM + h * 256 + e0)]); v1[s] = bf2f(U[uoff(R0 + s, VM + h * 256 + e0 + 128)]); }
    float acc0[16], acc1[16];
#pragma unroll
    for (int t = 0; t < 16; ++t) { acc0[t] = 0.f; acc1[t] = 0.f; }
    const float alast = misc[0], mprev = misc[2];
    for (int d0 = dq * 32; d0 < dq * 32 + 32; d0 += 16) {
        float cb0[16], cb1[16];
#pragma unroll
        for (int dd = 0; dd < 16; ++dd) { cb0[dd] = meta ? 0.f : Cin[(size_t)(d0 + dd) * 256 + e0]; cb1[dd] = meta ? 0.f : Cin[(size_t)(d0 + dd) * 256 + e0 + 128]; }
#pragma unroll
        for (int dd = 0; dd < 16; ++dd) { const int d = d0 + dd; const float c0 = cb0[dd], c1 = cb1[dd];
            float cn0 = alast * c0, cn1 = alast * c1;
#pragma unroll
            for (int i = 0; i < 4; ++i) { const f32x4 q4 = *(const LAS f32x4*)(qT + d * 16 + 4 * i), k4 = *(const LAS f32x4*)(kwT + d * 16 + 4 * i);
#pragma unroll
                for (int jj = 0; jj < 4; ++jj) { acc0[4 * i + jj] += q4[jj] * c0; acc1[4 * i + jj] += q4[jj] * c1; cn0 += k4[jj] * v0[4 * i + jj]; cn1 += k4[jj] * v1[4 * i + jj]; } }
            Cout[(size_t)d * 256 + e0] = cn0; Cout[(size_t)d * 256 + e0 + 128] = cn1; }
    }
#pragma unroll
    for (int t = 0; t < 16; ++t) { red[(dq * 16 + t) * 256 + e0] = acc0[t]; red[(dq * 16 + t) * 256 + e0 + 128] = acc1[t]; }
    if (tid < 128) { float nn = alast * (meta ? 0.f : nin[tid]);
#pragma unroll
        for (int s = 0; s < 16; ++s) nn += kwT[tid * 16 + s];
        nout[tid] = nn; }
    __syncthreads();
    if (!meta) {
#pragma unroll
        for (int tl = 0; tl < 4; ++tl) { const int t = dq * 4 + tl; const float sc_t = __expf(mprev - cm[t]); const float mt = bb[t] + cm[t];
            float den = sc_t * qnS[t];
            float num0 = sc_t * ((red[t * 256 + e0] + red[(16 + t) * 256 + e0]) + (red[(32 + t) * 256 + e0] + red[(48 + t) * 256 + e0]));
            float num1 = sc_t * ((red[t * 256 + e0 + 128] + red[(16 + t) * 256 + e0 + 128]) + (red[(32 + t) * 256 + e0 + 128] + red[(48 + t) * 256 + e0 + 128]));
#pragma unroll
            for (int s = 0; s < 16; ++s) { const float w = Wm[t * 16 + s]; num0 += w * v0[s]; num1 += w * v1[s]; den += w; }
            const float inv = 1.0f / fmaxf(fabsf(den), __expf(-mt));
            red[t * 256 + e0] = num0 * inv; red[t * 256 + e0 + 128] = num1 * inv; }
    }
    __syncthreads();
    if (!meta) {
#pragma unroll
        for (int r = 0; r < 2; ++r) { const int t = 2 * wave + r; float hv[4]; float ss = 0.f;
#pragma unroll
            for (int i = 0; i < 4; ++i) { hv[i] = red[t * 256 + lane + 64 * i]; ss += hv[i] * hv[i]; }
            const float rstd = rsqrtf(wsum(ss) * (1.f / 256.f) + EPS);
            float ov[4], zv[4], gv[4];
#pragma unroll
            for (int i = 0; i < 4; ++i) { const int ee = lane + 64 * i; const size_t ro = (size_t)(R0 + t) * 256 + (size_t)h * UT + ee;
                ov[i] = bf2f(U[ro + (size_t)(OM >> 8) * UT]); zv[i] = bf2f(U[ro + (size_t)(ZM >> 8) * UT]); gv[i] = p.gmh[h * 256 + ee]; }
#pragma unroll
            for (int i = 0; i < 4; ++i) { const int ee = lane + 64 * i; const size_t ro = (size_t)(R0 + t) * 256 + (size_t)h * UT + ee;
                const float val = hv[i] * rstd * gv[i] * sigmoidf_(ov[i]) * siluf_(zv[i]);
                if (!dry) U[ro + (size_t)(OM >> 8) * UT] = (bf16_t)(pk2(val, 0.f) & 0xffffu); } }
    }
    __syncthreads();
}

DI void mlstm_scan(const Params& p, LAS unsigned char* lds) {
    const float* BS = (const float*)(p.ws + WS_BS); const float* MLv = (const float*)(p.ws + WS_ML); float* MS = (float*)(p.ws + WS_MS);
    const float* NPv = (const float*)(p.ws + WS_NP); float* NS = (float*)(p.ws + WS_NS);
    const float* C0 = (const float*)(p.ws + WS_C0); const float* N0 = (const float*)(p.ws + WS_N0); const float* M0 = (const float*)(p.ws + WS_M0);
    LAS float* tb = (LAS float*)lds, *tm = tb + 64, *ca = tb + 128, *cb = tb + 192, *cm = tb + 256;
    const int tid = threadIdx.x;
    for (int gid0 = blockIdx.x * 512; gid0 < 8 * 256 * 64; gid0 += gridDim.x * 512) {
        const int gid = gid0 + tid, h = gid0 >> 14, e = (gid >> 6) & 255, d = 2 * (gid & 63);
        const bf16_t* UP = (const bf16_t*)(p.ws + WS_UP) + (size_t)h * NCH * 256 * 128 + (size_t)e * 128 + d;
        unsigned u[64];
#pragma unroll
        for (int i = 0; i < 64; ++i) u[i] = *(const unsigned*)(UP + (size_t)i * 256 * 128);
        float cx = C0[((size_t)h * 128 + d) * 256 + e], cy = C0[((size_t)h * 128 + d + 1) * 256 + e];
        __syncthreads();
        if (tid < 64) { tb[tid] = BS[h * NCH + tid]; tm[tid] = MLv[h * NCH + tid]; }
        __syncthreads();
        if (tid == 0) { float m = M0[h];
            for (int k = 0; k < NCH; ++k) { const float bs = tb[k], ml = tm[k]; const float mn = fmaxf(bs + m, ml); ca[k] = __expf(bs + m - mn); cb[k] = __expf(ml - mn); cm[k] = m; m = mn; }
            cm[64] = m; }
        __syncthreads();
        unsigned* CS = (unsigned*)((bf16_t*)(p.ws + WS_CST) + (size_t)h * NCH * 256 * 128 + (size_t)e * 128 + d);
#pragma unroll
        for (int k = 0; k < NCH; ++k) { CS[(size_t)k * 256 * 64] = pk2(cx, cy); const float a = ca[k], b = cb[k]; cx = a * cx + b * bflo(u[k]); cy = a * cy + b * bfhi(u[k]); }
        p.out[O_CP + ((size_t)h * 128 + d) * 256 + e] = cx; p.out[O_CP + ((size_t)h * 128 + d + 1) * 256 + e] = cy;
        if ((gid0 & 16383) == 0) {
            if (tid < 128) { float nv[64];
#pragma unroll
                for (int k = 0; k < 64; ++k) nv[k] = NPv[(size_t)(h * NCH + k) * 128 + tid];
                float n = N0[h * 128 + tid];
#pragma unroll
                for (int k = 0; k < 64; ++k) { NS[(size_t)(h * NCH + k) * 128 + tid] = n; n = ca[k] * n + cb[k] * nv[k]; }
                p.out[O_NP + h * 128 + tid] = n; }
            else if (tid < 192) { MS[h * NCH + (tid - 128)] = cm[tid - 128]; if (tid == 128) p.out[O_MP + h] = cm[64]; }
        }
    }
    __syncthreads();
}

DI void mlstm_sw_tile(const LAS bf16_t* KN, const LAS float* aS, const bf16x8 (&qf)[4], int tT, int t, float cmt, int lr, int q, bf16x8 (&wf)[4], float& dsum) {
    dsum = 0.f;
#pragma unroll
    for (int u = 0; u < 4; ++u) {
        u32x4 w = (u32x4){0u, 0u, 0u, 0u};
#pragma unroll
        for (int hh = 0; hh < 2; ++hh) { const int st = 2 * u + hh;
            if (st <= tT) {
                f32x4 s4 = (f32x4){0.f, 0.f, 0.f, 0.f};
#pragma unroll
                for (int ks = 0; ks < 4; ++ks) { const bf16x8 a = *(const LAS bf16x8*)(KN + (16 * st + lr) * 136 + 32 * ks + 8 * q); s4 = MFMA16(a, qf[ks], s4); }
                float wv[4];
#pragma unroll
                for (int jj = 0; jj < 4; ++jj) { const int sx = 16 * st + 4 * q + jj; const float wg = (sx <= t) ? __expf(aS[sx] - cmt) : 0.f; wv[jj] = s4[jj] * wg; dsum += wv[jj]; }
                if (hh == 0) { w.x = pk2(wv[0], wv[1]); w.y = pk2(wv[2], wv[3]); } else { w.z = pk2(wv[0], wv[1]); w.w = pk2(wv[2], wv[3]); }
            } }
        wf[u] = __builtin_bit_cast(bf16x8, w);
    }
}
DI void mlstm_out_item(const Params& p, LAS unsigned char* lds, int h, int j, int dry) {
    int tid_ = threadIdx.x; asm volatile("" : "+v"(tid_)); const int tid = tid_, lane = tid & 63, wave = __builtin_amdgcn_readfirstlane(tid >> 6), lr = lane & 15, q = lane >> 4;
    const int g = wave >> 2, w = wave & 3, tA = w, tB = 7 - w;
    bf16_t* U = (bf16_t*)(p.ws + WS_U); const float* GATE = (const float*)(p.ws + WS_GATE);
    LAS float* aS = (LAS float*)(lds + ML_SC), *cmS = aS + 128, *bS = aS + 256, *nK = aS + 384, *ssx = aS + 512;
    const int R0 = 128 * j; const float mk = ((const float*)(p.ws + WS_MS))[h * NCH + j];
    u32x4 vreg[8], kn[4];
    mlstm_v_load(U, R0, h, tid, vreg);
#pragma unroll
    for (int it = 0; it < 4; ++it) { const int ci = tid + 512 * it, row = ci >> 4, ch = ci & 15; kn[it] = *(const u32x4*)(U + uoff(R0 + row, KM + h * 128 + 8 * ch)); }
    const int tokA = 16 * tA + lr, tokB = 16 * tB + lr;
    const size_t rowA = (size_t)(R0 + tokA) * 256, rowB = (size_t)(R0 + tokB) * 256;
    const size_t qoff = (size_t)((QM >> 8) + (h >> 1)) * UT + (h & 1) * 128 + 8 * q;
    bf16x8 qfA[4], qfB[4];
#pragma unroll
    for (int ks = 0; ks < 4; ++ks) { qfA[ks] = *(const bf16x8*)(U + rowA + qoff + 32 * ks); qfB[ks] = *(const bf16x8*)(U + rowB + qoff + 32 * ks); }
    if (tid < 128) { const float* gs = (const float*)(p.ws + WS_GS) + (size_t)(h * NCH + j) * 384;
        aS[tid] = gs[tid]; cmS[tid] = fmaxf(mk, gs[128 + tid]); bS[tid] = gs[256 + tid];
    } else if (tid < 256) { const int d = tid - 128; nK[d] = ((const float*)(p.ws + WS_NS))[(size_t)(h * NCH + j) * 128 + d]; }
    mlstm_v_store(lds, tid, vreg);
    {
        LAS bf16_t* KNw = (LAS bf16_t*)(lds + ML_T2);
#pragma unroll
        for (int it = 0; it < 4; ++it) { const int ci = tid + 512 * it, row = ci >> 4, ch = ci & 15; *(LAS u32x4*)(KNw + row * 136 + 8 * ch) = kn[it]; }
    }
    __syncthreads();
    const LAS bf16_t* VT = (const LAS bf16_t*)lds; const LAS bf16_t* KN = (const LAS bf16_t*)(lds + ML_T2);
    const float cmA = cmS[tokA], cmB = cmS[tokB];
    const float scaleA = __expf(mk - cmA), scaleB = __expf(mk - cmB), floA = __expf(-(bS[tokA] + cmA)), floB = __expf(-(bS[tokB] + cmB));
    float qnA = 0.f, qnB = 0.f;
#pragma unroll
    for (int ks = 0; ks < 4; ++ks)
#pragma unroll
        for (int i = 0; i < 8; ++i) { const float nv = nK[32 * ks + 8 * q + i]; qnA += bf2f((unsigned short)qfA[ks][i]) * nv; qnB += bf2f((unsigned short)qfB[ks][i]) * nv; }
    qnA += __shfl_xor(qnA, 16); qnA += __shfl_xor(qnA, 32); qnB += __shfl_xor(qnB, 16); qnB += __shfl_xor(qnB, 32);
    f32x4 accA[8], accB[8];
    const bf16_t* CS = (const bf16_t*)(p.ws + WS_CST) + (size_t)(h * NCH + j) * 256 * 128 + (size_t)(128 * g) * 128;
#pragma unroll
    for (int et = 0; et < 8; ++et) { accA[et] = (f32x4){0.f, 0.f, 0.f, 0.f}; accB[et] = accA[et]; }
#pragma unroll
    for (int ks = 0; ks < 4; ++ks) {
        bf16x8 ca[8];
#pragma unroll
        for (int et = 0; et < 8; ++et) ca[et] = *(const bf16x8*)(CS + (size_t)(16 * et + lr) * 128 + 32 * ks + 8 * q);
#pragma unroll
        for (int et = 0; et < 8; ++et) { accA[et] = MFMA16(ca[et], qfA[ks], accA[et]); accB[et] = MFMA16(ca[et], qfB[ks], accB[et]); }
    }
#pragma unroll
    for (int et = 0; et < 8; ++et) { accA[et] = accA[et] * scaleA; accB[et] = accB[et] * scaleB; }
    asm volatile("" ::: "memory");
    bf16x8 wfA[4], wfB[4]; float dsA, dsB;
    mlstm_sw_tile(KN, aS, qfA, tA, tokA, cmA, lr, q, wfA, dsA);
    mlstm_sw_tile(KN, aS, qfB, tB, tokB, cmB, lr, q, wfB, dsB);
#pragma unroll
    for (int u = 0; u < 4; ++u) {
        if (2 * u <= tB) {
#pragma unroll
            for (int et = 0; et < 8; ++et) { const LAS bf16_t* vp = VT + (32 * u + 4 * q + (lr >> 2)) * PV + 16 * (8 * g + et) + 4 * (lr & 3);
                const s16x4 lo = tr_read(vp), hi = tr_read(vp + 16 * PV); const bf16x8 vf = __builtin_shufflevector(lo, hi, 0, 1, 2, 3, 4, 5, 6, 7);
                accB[et] = MFMA16(vf, wfB[u], accB[et]);
                if (2 * u <= tA) accA[et] = MFMA16(vf, wfA[u], accA[et]); } }
    }
    asm volatile("" ::: "memory");
    dsA += __shfl_xor(dsA, 16); dsA += __shfl_xor(dsA, 32); dsB += __shfl_xor(dsB, 16); dsB += __shfl_xor(dsB, 32);
    const float invA = 1.0f / fmaxf(fabsf(scaleA * qnA + dsA), floA), invB = 1.0f / fmaxf(fabsf(scaleB * qnB + dsB), floB);
    float ssA = 0.f, ssB = 0.f;
#pragma unroll
    for (int et = 0; et < 8; ++et) { accA[et] = accA[et] * invA; accB[et] = accB[et] * invB;
        ssA += (accA[et][0] * accA[et][0] + accA[et][1] * accA[et][1]) + (accA[et][2] * accA[et][2] + accA[et][3] * accA[et][3]);
        ssB += (accB[et][0] * accB[et][0] + accB[et][1] * accB[et][1]) + (accB[et][2] * accB[et][2] + accB[et][3] * accB[et][3]); }
    ssA += __shfl_xor(ssA, 16); ssA += __shfl_xor(ssA, 32); ssB += __shfl_xor(ssB, 16); ssB += __shfl_xor(ssB, 32);
    if (q == 0) { ssx[((g * 4 + w) * 2 + 0) * 16 + lr] = ssA; ssx[((g * 4 + w) * 2 + 1) * 16 + lr] = ssB; }
    __syncthreads();
    const float rstdA = rsqrtf((ssA + ssx[(((g ^ 1) * 4 + w) * 2 + 0) * 16 + lr]) * (1.f / 256.f) + EPS);
    const float rstdB = rsqrtf((ssB + ssx[(((g ^ 1) * 4 + w) * 2 + 1) * 16 + lr]) * (1.f / 256.f) + EPS);
    const size_t ooff = (size_t)((OM >> 8) + h) * UT + 128 * g + 4 * q, zoff = (size_t)((ZM >> 8) + h) * UT + 128 * g + 4 * q;
#pragma unroll
    for (int T = 0; T < 2; ++T) {
        const size_t rowT = T ? rowB : rowA; const float rstd = T ? rstdB : rstdA; const int tok = T ? tokB : tokA;
        u32x2 ov[8], zv[8]; f32x4 gv[8];
#pragma unroll
        for (int et = 0; et < 8; ++et) { ov[et] = *(const u32x2*)(U + rowT + ooff + 16 * et); zv[et] = *(const u32x2*)(U + rowT + zoff + 16 * et); gv[et] = *(const f32x4*)(p.gmh + h * 256 + 128 * g + 16 * et + 4 * q); }
#pragma unroll
        for (int et = 0; et < 8; ++et) { const f32x4 a = T ? accB[et] : accA[et]; const u32x2 o = ov[et], z = zv[et]; const f32x4 gg = gv[et];
            u32x2 wv; wv.x = pk2(a[0] * rstd * gg[0] * sigmoidf_(bflo(o.x)) * siluf_(bflo(z.x)), a[1] * rstd * gg[1] * sigmoidf_(bfhi(o.x)) * siluf_(bfhi(z.x)));
            wv.y = pk2(a[2] * rstd * gg[2] * sigmoidf_(bflo(o.y)) * siluf_(bflo(z.y)), a[3] * rstd * gg[3] * sigmoidf_(bfhi(o.y)) * siluf_(bfhi(z.y)));
            if (dry) *(u32x2*)((bf16_t*)(p.ws + WS_XN) + (size_t)(R0 + tok) * DM + h * 256 + 128 * g + 16 * et + 4 * q) = wv; else *(u32x2*)(U + rowT + ooff + 16 * et) = wv; }
    }
    __syncthreads();
}

DI void skinny_core(f32x4 (&acc)[2][4], const bf16_t* A, size_t lda, size_t wstride, const bf16_t* Bt, int row0, int col0, int wave, int lr, int q) {
    const bf16_t* ap = A + (size_t)(row0 + lr) * lda + wstride * wave + 8 * q;
    const bf16_t* bp = Bt + (size_t)(col0 + lr) * 2048 + 256 * wave + 8 * q;
#pragma unroll 4
    for (int ks = 0; ks < 8; ++ks) {
        bf16x8 a[2], b[4];
#pragma unroll
        for (int rt = 0; rt < 2; ++rt) a[rt] = *(const bf16x8*)(ap + (size_t)rt * 16 * lda + 32 * ks);
#pragma unroll
        for (int ct = 0; ct < 4; ++ct) b[ct] = *(const bf16x8*)(bp + (size_t)ct * 16 * 2048 + 32 * ks);
#pragma unroll
        for (int rt = 0; rt < 2; ++rt)
#pragma unroll
            for (int ct = 0; ct < 4; ++ct) acc[rt][ct] = MFMA16(b[ct], a[rt], acc[rt][ct]);
    }
}
DI void skinny_put(LAS float* red, const f32x4 (&acc)[2][4], int slot, int lr, int q) {
#pragma unroll
    for (int rt = 0; rt < 2; ++rt)
#pragma unroll
        for (int ct = 0; ct < 4; ++ct) *(LAS f32x4*)(red + ((size_t)slot * 32 + 16 * rt + lr) * 64 + 16 * ct + 4 * q) = acc[rt][ct];
}
DI void skinny_merge(const Params& p, LAS unsigned char* lds) {
    const int tid = threadIdx.x, lane = tid & 63, wave = tid >> 6, lr = lane & 15, q = lane >> 4;
    const bf16_t* U = (const bf16_t*)(p.ws + WS_U); const bf16_t* WP = (const bf16_t*)(p.ws + WS_WP); bf16_t* MG = (bf16_t*)(p.ws + WS_XN);
    LAS float* red = (LAS float*)lds;
    for (int tile = blockIdx.x; tile < 256; tile += gridDim.x) {
        const int row0 = ROW_S + 32 * (tile >> 5), col0 = 64 * (tile & 31);
        f32x4 aa[2][4], am[2][4];
#pragma unroll
        for (int rt = 0; rt < 2; ++rt)
#pragma unroll
            for (int ct = 0; ct < 4; ++ct) { aa[rt][ct] = (f32x4){0.f, 0.f, 0.f, 0.f}; am[rt][ct] = (f32x4){0.f, 0.f, 0.f, 0.f}; }
        skinny_core(aa, U + (size_t)(QA >> 8) * UT, 256, UT, WP, row0, col0, wave, lr, q);
        skinny_core(am, U + (size_t)(OM >> 8) * UT, 256, UT, WP + (size_t)2048 * 2048, row0, col0, wave, lr, q);
        skinny_put(red, aa, wave * 2, lr, q); skinny_put(red, am, wave * 2 + 1, lr, q);
        __syncthreads();
        const int row = tid >> 4, c4 = (tid & 15) * 4;
        f32x4 ya = (f32x4){0.f, 0.f, 0.f, 0.f}, ym = ya;
#pragma unroll
        for (int w = 0; w < 8; ++w) { ya += *(const LAS f32x4*)(red + ((size_t)(2 * w) * 32 + row) * 64 + c4); ym += *(const LAS f32x4*)(red + ((size_t)(2 * w + 1) * 32 + row) * 64 + c4); }
        const size_t r = row0 + row; const int col = col0 + c4;
        const u32x2 ga = *(const u32x2*)(U + uoff((int)r, GA + col)), gm = *(const u32x2*)(U + uoff((int)r, GM + col));
        u32x2 w; w.x = pk2(sigmoidf_(bflo(ga.x)) * ya[0] + sigmoidf_(bflo(gm.x)) * ym[0], sigmoidf_(bfhi(ga.x)) * ya[1] + sigmoidf_(bfhi(gm.x)) * ym[1]);
        w.y = pk2(sigmoidf_(bflo(ga.y)) * ya[2] + sigmoidf_(bflo(gm.y)) * ym[2], sigmoidf_(bfhi(ga.y)) * ya[3] + sigmoidf_(bfhi(gm.y)) * ym[3]);
        *(u32x2*)(MG + r * DM + col) = w;
        __syncthreads();
    }
}
DI void skinny_out(const Params& p, LAS unsigned char* lds) {
    const int tid = threadIdx.x, lane = tid & 63, wave = tid >> 6, lr = lane & 15, q = lane >> 4;
    const bf16_t* MG = (const bf16_t*)(p.ws + WS_XN); const bf16_t* WO = (const bf16_t*)(p.ws + WS_WOUT); float* ssq = (float*)(p.ws + WS_SSQ);
    LAS float* red = (LAS float*)lds;
    for (int tile = blockIdx.x; tile < 256; tile += gridDim.x) {
        const int row0 = ROW_S + 32 * (tile >> 5), col0 = 64 * (tile & 31);
        f32x4 aa[2][4];
#pragma unroll
        for (int rt = 0; rt < 2; ++rt)
#pragma unroll
            for (int ct = 0; ct < 4; ++ct) aa[rt][ct] = (f32x4){0.f, 0.f, 0.f, 0.f};
        skinny_core(aa, MG, DM, 256, WO, row0, col0, wave, lr, q);
        skinny_put(red, aa, wave, lr, q);
        __syncthreads();
        const int row = tid >> 4, c4 = (tid & 15) * 4;
        f32x4 y = (f32x4){0.f, 0.f, 0.f, 0.f};
#pragma unroll
        for (int w = 0; w < 8; ++w) y += *(const LAS f32x4*)(red + ((size_t)w * 32 + row) * 64 + c4);
        const size_t r = row0 + row; const int col = col0 + c4;
        const f32x4 o = *(const f32x4*)(p.xs + (r - ROW_S) * DM + col) + y;
        { u32x2 w; w.x = pk2(o[0], o[1]); w.y = pk2(o[2], o[3]); *(u32x2*)((bf16_t*)(p.ws + WS_U) + uoff((int)r, col)) = w; }
        float ss = (o[0] * o[0] + o[1] * o[1]) + (o[2] * o[2] + o[3] * o[3]);
        ss += __shfl_xor(ss, 1); ss += __shfl_xor(ss, 2); ss += __shfl_xor(ss, 4); ss += __shfl_xor(ss, 8);
        if ((tid & 15) == 0) ssq[r * 32 + (tile & 31)] = ss;
        __syncthreads();
    }
}

DI void final_norm(const Params& p) {
    const int lane = threadIdx.x & 63, gw = blockIdx.x * 8 + (threadIdx.x >> 6), NGW = gridDim.x * 8;
    const float* ssq = (const float*)(p.ws + WS_SSQ); const bf16_t* X1 = (const bf16_t*)(p.ws + WS_U);
    for (int r = gw; r < MOUT; r += NGW) {
        u32x2 xv[8];
#pragma unroll
        for (int j = 0; j < 8; ++j) xv[j] = *(const u32x2*)(X1 + (size_t)j * UT + (size_t)r * 256 + 4 * lane);
        const float s = wsum(lane < 32 ? ssq[(size_t)r * 32 + lane] : 0.f);
        const float rstd = rsqrtf(s * (1.f / DM) + EPS);
        f32x4* o = (f32x4*)(p.out + (size_t)r * DM) + lane; const f32x4* g = (const f32x4*)p.gfinal + lane;
#pragma unroll
        for (int j = 0; j < 8; ++j) { const f32x4 gg = g[64 * j]; f32x4 v; v[0] = bflo(xv[j].x) * rstd * gg[0]; v[1] = bfhi(xv[j].x) * rstd * gg[1]; v[2] = bflo(xv[j].y) * rstd * gg[2]; v[3] = bfhi(xv[j].y) * rstd * gg[3]; o[64 * j] = v; }
    }
}

__global__ void __launch_bounds__(512, 2) mega(Params p) {
    extern __shared__ __attribute__((aligned(16))) unsigned char lds_raw[];
    LAS unsigned char* lds = (LAS unsigned char*)lds_raw;
    cg::grid_group grid = cg::this_grid();
    const int lo = p.ph_lo, hi = p.ph_hi;
#define IN(k) (lo <= (k) && (k) < hi)
#define STAMP(i) do { if (TPROBE >= 0 && blockIdx.x == 0 && threadIdx.x == 0) tsl[i] = __builtin_amdgcn_s_memrealtime(); } while (0)
#define SEAM(k) do { if (IN(k) && IN((k) + 1)) xcd_barrier(bar); STAMP((k) + 1); } while (0)
    volatile LAS unsigned long long* tsl = (volatile LAS unsigned long long*)(lds + 131072 + 1040);
    volatile LAS unsigned* bst = (volatile LAS unsigned*)(lds + 131072 + 1024);
    if (threadIdx.x < 2) bst[threadIdx.x] = 0u;
    __syncthreads();
    XcdBarrier bar = xcd_barrier_post((unsigned*)(p.ws + WS_BAR), bst);
    if (hi > 1000) grid.sync();
    bf16_t* U = (bf16_t*)(p.ws + WS_U);
    STAMP(0);
    if (IN(0)) for (int rep = 0; rep < REP0; ++rep) p0_prologue(p, lds);
    SEAM(0);
    if (IN(1)) for (int rep = 0; rep < REP1; ++rep) {
        pg8::Order S; S.init(MPAD / 256, NW / 256, gridDim.x, blockIdx.x, 0);
        S.A0 = S.A1 = (const char*)(p.ws + WS_XN); S.B0 = S.B1 = (const char*)(p.ws + WS_WIN); S.a_tstep = (size_t)256 * DM * 2; S.b_tstep = (size_t)256 * 2048 * 2;
        pg8::EpiU E{U, (float*)(p.ws + WS_GATE), p.out};
        pg8::gemm_phase<pg8::EpiU>(lds, 2048, DM, 512, S, E);
    }
    SEAM(1);
    if (IN(2)) {
        for (int rep = 0; rep < REP2; ++rep) { const int dry = rep + 1 < REP2;
        for (int it = blockIdx.x; it < 1224; it += gridDim.x) {
            if (it < 512) { if (!dry || (PSEL & 1)) attn_item(p, lds, 0, it >> 2, it & 3, dry); }
            else if (it < 576) { if (!dry || (PSEL & 1)) attn_item(p, lds, 1, (it - 512) >> 2, (it - 512) & 3, dry); }
            else if (it < 1088) { if (!dry || (PSEL & 2)) mlstm_sum_item(p, lds, (it - 576) & 7, (it - 576) >> 3); }
            else { if (!dry || (PSEL & 4)) mlstm_small_item(p, lds, (it - 1088) >> 3, (it - 1088) & 7, dry); }
        } }
    }
    SEAM(2);
    if (IN(3)) for (int rep = 0; rep < REP3; ++rep) mlstm_scan(p, lds);
    for (int rep = 0; rep < REPSYNC; ++rep) xcd_barrier(bar);
    SEAM(3);
    if (IN(4)) for (int rep = 0; rep < REP4; ++rep) { for (int it = blockIdx.x; it < 512; it += gridDim.x) mlstm_out_item(p, lds, it & 7, it >> 3, rep + 1 < REP4); }
    SEAM(4);
    if (IN(5)) for (int rep = 0; rep < REP56; ++rep) {
        pg8::Order S; S.init(ROW_S / 256, DM / 256, gridDim.x, blockIdx.x, 1);
        S.A0 = (const char*)(U + (size_t)(QA >> 8) * UT); S.A1 = (const char*)(U + (size_t)(OM >> 8) * UT); S.B0 = (const char*)(p.ws + WS_WP); S.B1 = S.B0 + (size_t)2048 * 2048 * 2;
        S.a_tstep = (size_t)256 * 256 * 2; S.b_tstep = (size_t)256 * 2048 * 2;
        pg8::EpiMerge E{U, (bf16_t*)(p.ws + WS_XN)};
        const bool skinny_first = (blockIdx.x >> 3) & 1;
        if (skinny_first) skinny_merge(p, lds);
        pg8::gemm_phase<pg8::EpiMerge>(lds, 2048, 256, UT * 2, S, E);
        if (!skinny_first) skinny_merge(p, lds);
    }
    SEAM(5);
    if (IN(6)) for (int rep = 0; rep < REP56; ++rep) {
        pg8::Order S; S.init(ROW_S / 256, DM / 256, gridDim.x, blockIdx.x, 0);
        S.A0 = S.A1 = (const char*)(p.ws + WS_XN); S.B0 = S.B1 = (const char*)(p.ws + WS_WOUT); S.a_tstep = (size_t)256 * DM * 2; S.b_tstep = (size_t)256 * 2048 * 2;
        pg8::EpiOut E{p.xp, p.xs, U, (float*)(p.ws + WS_SSQ)};
        const bool skinny_first = (blockIdx.x >> 3) & 1;
        if (skinny_first) skinny_out(p, lds);
        pg8::gemm_phase<pg8::EpiOut>(lds, 2048, DM, 512, S, E);
        if (!skinny_first) skinny_out(p, lds);
    }
    SEAM(6);
    if (IN(7)) final_norm(p);
    if (TPROBE >= 0 && blockIdx.x == 0 && threadIdx.x == 0) { const unsigned long long te = __builtin_amdgcn_s_memrealtime(); tsl[8] = te;
        const unsigned long long d = tsl[TPROBE + 1] - tsl[TPROBE]; while (__builtin_amdgcn_s_memrealtime() - te < 9ull * d) __builtin_amdgcn_s_sleep(8); }
#undef IN
#undef SEAM
}

extern "C" void kernel_launch(void* const* d_in, const int* in_sizes, int n_in, void* d_out, int out_size, void* d_ws, size_t ws_size, hipStream_t stream) {
    static int grid = 0;
    if (grid == 0) {
        if (n_in != 18 || out_size != 22889608 || ws_size < WS_END) { fprintf(stderr, "kernel_launch: unexpected shapes (n_in %d out %d ws %zu need %zu)\n", n_in, out_size, ws_size, (size_t)WS_END); grid = -1; return; }
        int dev = 0, cus = 0, per_cu = 0;
        hipGetDevice(&dev); hipDeviceGetAttribute(&cus, hipDeviceAttributeMultiprocessorCount, dev);
        if (hipFuncSetAttribute((const void*)mega, hipFuncAttributeMaxDynamicSharedMemorySize, LDS_BYTES) != hipSuccess) { fprintf(stderr, "kernel_launch: hipFuncSetAttribute failed\n"); grid = -1; return; }
        if (hipOccupancyMaxActiveBlocksPerMultiprocessor(&per_cu, (const void*)mega, 512, LDS_BYTES) != hipSuccess || per_cu < 1) { fprintf(stderr, "kernel_launch: occupancy query says %d\n", per_cu); (void)hipGetLastError(); }
        grid = cus > 0 ? cus : 256;
    }
    if (grid < 0) return;
    Params p{};
    p.xp = (const float*)d_in[0]; p.xs = (const float*)d_in[1]; p.ck = (const float*)d_in[2]; p.cv = (const float*)d_in[3];
    p.sC = (const float*)d_in[4]; p.sn = (const float*)d_in[5]; p.sm = (const float*)d_in[6]; p.meta = (const float*)d_in[7];
    p.gnorm = (const float*)d_in[8]; p.win = (const float*)d_in[9]; p.bi = (const float*)d_in[10]; p.bf = (const float*)d_in[11];
    p.sinks = (const float*)d_in[12]; p.gmh = (const float*)d_in[13]; p.wpa = (const float*)d_in[14]; p.wpm = (const float*)d_in[15];
    p.wout = (const float*)d_in[16]; p.gfinal = (const float*)d_in[17];
    p.out = (float*)d_out; p.ws = (unsigned char*)d_ws;
#if N_LAUNCH == 1
    p.ph_lo = 0; p.ph_hi = 8;
    if (hipMemsetAsync((char*)d_ws + WS_BAR, 0, 16384, stream) != hipSuccess) { fprintf(stderr, "kernel_launch: memset failed\n"); return; }
    void* args[] = {&p};
    hipError_t e = hipLaunchCooperativeKernel((const void*)mega, dim3(grid), dim3(512), args, LDS_BYTES, stream);
    if (e != hipSuccess) fprintf(stderr, "cooperative launch failed: %s (grid %d)\n", hipGetErrorString(e), grid);
#else
    for (int ph = 0; ph < 8; ++ph) { p.ph_lo = ph; p.ph_hi = ph + 1; hipLaunchKernelGGL(mega, dim3(grid), dim3(512), LDS_BYTES, stream, p); }
#endif
}
```
